# Optimizing an MI355X kernel written in HIP

```python
import jax, jax.numpy as jnp
from jax import lax
import numpy as np

D_MODEL = 1024
BATCH = 16
SEQ = 256
DEPTH = 1
DEC_BATCH = 8
DEC_SEQ = 1024
PAST_LEN = 256

GRID_W = 64
CHUNK = 128
EPS = 1e-6
SSD_WIDTH = D_MODEL
SSD_HEAD_DIM = 64
SSD_HEADS = SSD_WIDTH // SSD_HEAD_DIM
SSD_GROUPS = 4
SSD_STATE = 128
CONV_K = 3
CONV_CH = SSD_WIDTH + 2 * SSD_GROUPS * SSD_STATE
RET_HEADS = 8
RET_QK_DIM = 64
RET_V_DIM = 128
RET_QK_WIDTH = RET_HEADS * RET_QK_DIM
RET_V_WIDTH = RET_HEADS * RET_V_DIM
MIX_WIDTH = SSD_WIDTH + RET_V_WIDTH
ROPE_BASE = 10000.0
IN_COLS = SSD_WIDTH + CONV_CH + 2 * SSD_HEADS + 2 * RET_QK_WIDTH + 2 * RET_V_WIDTH

kernel_name = 'hybrid_ssd_retention_flow_step'


def _rms(x, w):
    xf = x.astype(jnp.float32)
    y = xf * lax.rsqrt(jnp.mean(xf * xf, axis=-1, keepdims=True) + EPS)
    return (y * w).astype(x.dtype)


def _dwconv(x, w, b):
    y = lax.conv_general_dilated(x, w[:, None, :].astype(x.dtype), (1,),
                                 [(CONV_K // 2, CONV_K // 2)],
                                 dimension_numbers=('NWC', 'WIO', 'NWC'),
                                 feature_group_count=x.shape[-1])
    return y + b.astype(x.dtype)


def _grid_angles(L):
    rows = L // GRID_W
    row = jnp.repeat(jnp.arange(rows, dtype=jnp.float32), GRID_W)
    col = jnp.tile(jnp.arange(GRID_W, dtype=jnp.float32), rows)
    half = RET_QK_DIM // 2
    inv = ROPE_BASE ** (-jnp.arange(0, half, 2, dtype=jnp.float32) / half)
    return row[:, None] * inv, col[:, None] * inv


def _rot(x, ang):
    x1, x2 = jnp.split(x, 2, axis=-1)
    c = jnp.cos(ang)[None, :, None, :]
    s = jnp.sin(ang)[None, :, None, :]
    return jnp.concatenate([x1 * c - x2 * s, x2 * c + x1 * s], axis=-1)


def _grid_rope(x, angles):
    xr, xc = jnp.split(x, 2, axis=-1)
    return jnp.concatenate([_rot(xr, angles[0]), _rot(xc, angles[1])], axis=-1)


def _chunk_scan(q, k, v, log_a, s0):
    Bsz, L, H, _ = q.shape
    P = v.shape[-1]
    nc = L // CHUNK

    def to_chunks(t):
        return jnp.moveaxis(t.reshape((Bsz, nc, CHUNK) + t.shape[2:]), 1, 0)

    causal = jnp.tril(jnp.ones((CHUNK, CHUNK), dtype=bool))[None, :, :, None]

    def step(s, inp):
        qi, ki, vi, ai = inp
        cum = jnp.cumsum(ai, axis=1)
        seg = cum[:, :, None, :] - cum[:, None, :, :]
        decay = jnp.where(causal, jnp.exp(jnp.where(causal, seg, 0.0)), 0.0)
        scores = jnp.einsum('bihn,bjhn->bijh', qi, ki) * decay
        y = (jnp.einsum('bijh,bjhp->bihp', scores, vi)
             + jnp.einsum('bihn,bhnp->bihp', qi, s) * jnp.exp(cum)[..., None])
        tail = jnp.exp(cum[:, -1:, :] - cum)
        s_new = (s * jnp.exp(cum[:, -1, :])[:, :, None, None]
                 + jnp.einsum('bjhn,bjhp,bjh->bhnp', ki, vi, tail))
        return s_new, y

    s_fin, ys = lax.scan(step, s0, (to_chunks(q), to_chunks(k), to_chunks(v), to_chunks(log_a)))
    y = jnp.moveaxis(ys, 0, 1).reshape(Bsz, L, H, P)
    return y, s_fin


def _bidir(q, k_f, k_b, v, la_f, la_b, s0_f, s0_b):
    y_f, s_f = _chunk_scan(q, k_f, v, la_f, s0_f)
    fl = lambda t: jnp.flip(t, axis=1)
    y_b, s_b = _chunk_scan(fl(q), fl(k_b), fl(v), fl(la_b), s0_b)
    return y_f + fl(y_b), s_f, s_b


def _mixer(h, s0_ssd, s0_ret, angles, w_in, conv_w, conv_b, A_log, dt_bias, D_skip,
           ssd_norm_w, ret_decay, ret_norm_w, w_out):
    f32 = jnp.float32
    Bsz, L, _ = h.shape
    u = h @ w_in
    sizes = [SSD_WIDTH, CONV_CH, 2 * SSD_HEADS, RET_QK_WIDTH, RET_QK_WIDTH, RET_V_WIDTH]
    z, xbc, dt_raw, q, k, v, g = jnp.split(u, [int(i) for i in np.cumsum(sizes)], axis=-1)

    xbc = jax.nn.silu(_dwconv(xbc, conv_w, conv_b))
    gn = SSD_GROUPS * SSD_STATE
    xs, Bm, Cm = jnp.split(xbc, [SSD_WIDTH, SSD_WIDTH + gn], axis=-1)
    xs = xs.reshape(Bsz, L, SSD_HEADS, SSD_HEAD_DIM).astype(f32)
    rep = SSD_HEADS // SSD_GROUPS
    Bm = jnp.repeat(Bm.reshape(Bsz, L, SSD_GROUPS, SSD_STATE).astype(f32), rep, axis=2)
    Cm = jnp.repeat(Cm.reshape(Bsz, L, SSD_GROUPS, SSD_STATE).astype(f32), rep, axis=2)
    dt = jax.nn.softplus(dt_raw.reshape(Bsz, L, 2, SSD_HEADS).astype(f32) + dt_bias.astype(f32))
    log_a = dt * (-jnp.exp(A_log.astype(f32)))
    k_dir = Bm[:, :, None] * dt[..., None]
    y_s, sf, sb = _bidir(Cm, k_dir[:, :, 0], k_dir[:, :, 1], xs, log_a[:, :, 0], log_a[:, :, 1],
                         s0_ssd[:, 0].astype(f32), s0_ssd[:, 1].astype(f32))
    y_s = (y_s + D_skip.astype(f32)[:, None] * xs).reshape(Bsz, L, SSD_WIDTH)
    y_s = _rms(y_s * jax.nn.silu(z.astype(f32)), ssd_norm_w)

    qr = q.reshape(Bsz, L, RET_HEADS, RET_QK_DIM).astype(f32)
    kr = k.reshape(Bsz, L, RET_HEADS, RET_QK_DIM).astype(f32) * (RET_QK_DIM ** -0.5)
    if angles is not None:
        qr = _grid_rope(qr, angles)
        kr = _grid_rope(kr, angles)
    vr = v.reshape(Bsz, L, RET_HEADS, RET_V_DIM).astype(f32)
    lam = -jnp.exp(ret_decay.astype(f32))
    la_f = jnp.broadcast_to(lam[0], (Bsz, L, RET_HEADS))
    la_b = jnp.broadcast_to(lam[1], (Bsz, L, RET_HEADS))
    y_r, rf, rb = _bidir(qr, kr, kr, vr, la_f, la_b,
                         s0_ret[:, 0].astype(f32), s0_ret[:, 1].astype(f32))
    mu = jnp.mean(y_r, axis=-1, keepdims=True)
    var = jnp.mean(jnp.square(y_r - mu), axis=-1, keepdims=True)
    y_r = ((y_r - mu) * lax.rsqrt(var + EPS)).reshape(Bsz, L, RET_V_WIDTH)
    y_r = y_r * ret_norm_w * jax.nn.silu(g.astype(f32))

    mix = jnp.concatenate([y_s, y_r], axis=-1).astype(h.dtype)
    out = mix @ w_out
    return out, jnp.stack([sf, sb], axis=1), jnp.stack([rf, rb], axis=1)


def _layer(x, cond, s0_ssd, s0_ret, angles, w_mod, b_mod, norm_pre_w, norm_post_w, w_in,
           conv_w, conv_b, A_log, dt_bias, D_skip, ssd_norm_w, ret_decay, ret_norm_w, w_out):
    mod = jax.nn.silu(cond) @ w_mod + b_mod
    shift, scale, gate = jnp.split(mod, 3, axis=-1)
    h = _rms(x, norm_pre_w) * (1 + scale[:, None, :]) + shift[:, None, :]
    out, s_ssd, s_ret = _mixer(h.astype(x.dtype), s0_ssd, s0_ret, angles, w_in, conv_w, conv_b,
                               A_log, dt_bias, D_skip, ssd_norm_w, ret_decay, ret_norm_w, w_out)
    y = x + gate[:, None, :] * _rms(out, norm_post_w)
    return y.astype(x.dtype), s_ssd, s_ret


def setup_inputs(seed: int = 0) -> dict:
    key = jax.random.key(seed)
    ks = jax.random.split(key, 20)
    f32 = jnp.float32
    nrm = lambda k, s: jax.random.normal(k, s, f32)
    dt = jnp.exp(jax.random.uniform(ks[12], (DEPTH, 2, SSD_HEADS), f32)
                 * (jnp.log(0.1) - jnp.log(0.001)) + jnp.log(0.001))
    gammas = 1.0 - 2.0 ** (-5.0 - jnp.arange(RET_HEADS, dtype=f32))
    ret_base = jnp.log(-jnp.log(gammas))
    return {
        'x_prompt': nrm(ks[0], (BATCH, SEQ, D_MODEL)),
        'x_sample': nrm(ks[1], (DEC_BATCH, DEC_SEQ, D_MODEL)),
        'state_ssd': 0.1 * nrm(ks[2], (DEC_BATCH, DEPTH, 2, SSD_HEADS, SSD_STATE, SSD_HEAD_DIM)),
        'state_ret': 0.1 * nrm(ks[3], (DEC_BATCH, DEPTH, 2, RET_HEADS, RET_QK_DIM, RET_V_DIM)),
        'c': nrm(ks[4], (DEC_BATCH, D_MODEL)),
        'c_ctx': nrm(ks[5], (D_MODEL,)),
        'w_mod': nrm(ks[6], (DEPTH, D_MODEL, 3 * D_MODEL)) * D_MODEL ** -0.5,
        'b_mod': 0.02 * nrm(ks[7], (DEPTH, 3 * D_MODEL)),
        'norm_pre_w': 1.0 + 0.02 * nrm(ks[8], (DEPTH, D_MODEL)),
        'norm_post_w': 1.0 + 0.02 * nrm(ks[9], (DEPTH, D_MODEL)),
        'w_in': nrm(ks[10], (DEPTH, D_MODEL, IN_COLS)) * D_MODEL ** -0.5,
        'conv_w': nrm(ks[11], (DEPTH, CONV_K, CONV_CH)) * CONV_K ** -0.5,
        'conv_b': 0.02 * nrm(ks[13], (DEPTH, CONV_CH)),
        'ssd_A_log': jnp.log(jax.random.uniform(ks[14], (DEPTH, 2, SSD_HEADS), f32, 1.0, 16.0)),
        'ssd_dt_bias': dt + jnp.log(-jnp.expm1(-dt)),
        'ssd_D': 1.0 + 0.02 * nrm(ks[15], (DEPTH, SSD_HEADS)),
        'ssd_norm_w': 1.0 + 0.02 * nrm(ks[16], (DEPTH, SSD_WIDTH)),
        'ret_decay': ret_base + 0.01 * nrm(ks[17], (DEPTH, 2, RET_HEADS)),
        'ret_norm_w': 1.0 + 0.02 * nrm(ks[18], (DEPTH, RET_V_WIDTH)),
        'w_out': nrm(ks[19], (DEPTH, MIX_WIDTH, D_MODEL)) * MIX_WIDTH ** -0.5,
    }


def reference(x_prompt, x_sample, state_ssd, state_ret, c, c_ctx, w_mod, b_mod, norm_pre_w,
              norm_post_w, w_in, conv_w, conv_b, ssd_A_log, ssd_dt_bias, ssd_D, ssd_norm_w,
              ret_decay, ret_norm_w, w_out):
    angles = _grid_angles(x_sample.shape[1])
    nb = x_prompt.shape[0]
    zeros_ssd = jnp.zeros((nb, 2, SSD_HEADS, SSD_STATE, SSD_HEAD_DIM), jnp.float32)
    zeros_ret = jnp.zeros((nb, 2, RET_HEADS, RET_QK_DIM, RET_V_DIM), jnp.float32)
    yp, ys = x_prompt, x_sample
    ssd_states, ret_states = [], []
    for l in range(DEPTH):
        p = (w_mod[l], b_mod[l], norm_pre_w[l], norm_post_w[l], w_in[l], conv_w[l], conv_b[l],
             ssd_A_log[l], ssd_dt_bias[l], ssd_D[l], ssd_norm_w[l], ret_decay[l], ret_norm_w[l],
             w_out[l])
        yp, s_ssd, s_ret = _layer(yp, c_ctx[None, :], zeros_ssd, zeros_ret, None, *p)
        ys, _, _ = _layer(ys, c, state_ssd[:, l], state_ret[:, l], angles, *p)
        ssd_states.append(s_ssd)
        ret_states.append(s_ret)
    new_state_ssd = jnp.stack(ssd_states, axis=1)
    new_state_ret = jnp.stack(ret_states, axis=1)
    return (yp, ys, new_state_ssd, new_state_ret)
```

```cpp
#include <hip/hip_runtime.h>
#include <hip/hip_cooperative_groups.h>
#include <cstdio>
namespace cg = cooperative_groups;

typedef unsigned short u16;
typedef __bf16 bf16v2 __attribute__((ext_vector_type(2)));
typedef float f32v2 __attribute__((ext_vector_type(2)));
typedef short s16x4 __attribute__((ext_vector_type(4)));
using bf16x8 = __attribute__((ext_vector_type(8))) short;
using f32x16 = __attribute__((ext_vector_type(16))) float;
using u32x4 = __attribute__((ext_vector_type(4))) unsigned;
#define DI __device__ __forceinline__
#define MFMA32(a, b, c) __builtin_amdgcn_mfma_f32_32x32x16_bf16((a), (b), (c), 0, 0, 0)

constexpr int NTOK = 12288;
constexpr int NPR = 4096;
constexpr int DM = 1024;
constexpr int INC = 6176;
constexpr int UC = 6144;
#ifndef PROBE
#define PROBE 0
#endif
constexpr int THREADS = 512;
constexpr int SMEM_BYTES = 152 * 1024;

constexpr size_t OFF_MOD = 0;
constexpr size_t OFF_ROPE = 131072;
constexpr size_t OFF_CTR = 393216;
constexpr size_t OFF_H = 524288;
constexpr size_t OFF_WTIN = OFF_H + 25165824;
constexpr size_t OFF_DUMP = OFF_H;
constexpr size_t OFF_WTOUT = OFF_WTIN + 13107200;
constexpr size_t OFF_U = OFF_WTOUT + 4194304;
constexpr size_t OFF_OUTB = OFF_U;
constexpr size_t OFF_DT = OFF_U + 150994944;
constexpr size_t OFF_MIX = OFF_DT + 1572864;
constexpr size_t OFF_SSQ = OFF_MIX + 50331648;
constexpr size_t OFF_SSQ2 = OFF_SSQ + 1572864;
constexpr size_t OFF_HALO = OFF_SSQ2 + 786432;

struct Params {
  const float *x_prompt, *x_sample, *state_ssd, *state_ret, *c, *c_ctx, *w_mod, *b_mod, *norm_pre_w, *norm_post_w,
      *w_in, *conv_w, *conv_b, *A_log, *dt_bias, *ssd_D, *ssd_norm_w, *ret_decay, *ret_norm_w, *w_out;
  float* out;
  char* ws;
};

DI float bf2f(u16 v) { return __uint_as_float(((unsigned)v) << 16); }
DI unsigned pack2(float a, float b) {
  f32v2 f = {a, b};
  bf16v2 r = __builtin_convertvector(f, bf16v2);
  return __builtin_bit_cast(unsigned, r);
}
DI u16 f2bf(float a) { return (u16)(pack2(a, 0.f) & 0xffffu); }
DI float lo_bf(unsigned v) { return __uint_as_float(v << 16); }
DI float hi_bf(unsigned v) { return __uint_as_float(v & 0xffff0000u); }
DI float silu_f(float v) { return v * __builtin_amdgcn_rcpf(1.f + __expf(-v)); }
DI int crow(int r, int h) { return (r & 3) + 8 * (r >> 2) + 4 * h; }
DI int otid() {
  int t = threadIdx.x;
  asm volatile("" : "+v"(t));
  return t;
}
DI s16x4 tr_read(const u16* p) {
  return __builtin_amdgcn_ds_read_tr16_b64_v4i16((s16x4 __attribute__((address_space(3)))*)(p));
}
DI bf16x8 cat8(s16x4 lo, s16x4 hi) { return __builtin_shufflevector(lo, hi, 0, 1, 2, 3, 4, 5, 6, 7); }
DI bf16x8 pack8(float a0, float a1, float a2, float a3, float a4, float a5, float a6, float a7) {
  uint4 v = make_uint4(pack2(a0, a1), pack2(a2, a3), pack2(a4, a5), pack2(a6, a7));
  return __builtin_bit_cast(bf16x8, v);
}


DI void grid_barrier(unsigned* bar, unsigned& epoch) {
  asm volatile("s_waitcnt vmcnt(0)" ::: "memory");
  __syncthreads();
  if (threadIdx.x == 0) {
    __builtin_amdgcn_fence(__ATOMIC_RELEASE, "agent");
    asm volatile("s_waitcnt vmcnt(0)" ::: "memory");
    const unsigned G = gridDim.x;
    const unsigned ng = (G % 8u == 0u) ? 8u : 1u;
    const unsigned gs = G / ng, g = blockIdx.x % ng, e1 = epoch + 1u;
    const unsigned old = __hip_atomic_fetch_add(&bar[64u * (1u + g)], 1u, __ATOMIC_RELAXED, __HIP_MEMORY_SCOPE_AGENT);
    if (old + 1u == gs * e1) {
      const unsigned o2 = __hip_atomic_fetch_add(&bar[0], 1u, __ATOMIC_RELAXED, __HIP_MEMORY_SCOPE_AGENT);
      if (o2 + 1u == ng * e1) __hip_atomic_fetch_add(&bar[64u * 16u], 1u, __ATOMIC_RELAXED, __HIP_MEMORY_SCOPE_AGENT);
    }
    while (__hip_atomic_load(&bar[64u * 16u], __ATOMIC_RELAXED, __HIP_MEMORY_SCOPE_AGENT) < e1) __builtin_amdgcn_s_sleep(1);
    __builtin_amdgcn_fence(__ATOMIC_ACQUIRE, "agent");
    asm volatile("s_waitcnt vmcnt(0)" ::: "memory");
  }
  __syncthreads();
  ++epoch;
}

__device__ __forceinline__ void p0_mod_item(const Params& p, char* smem, int it) {
  float* sc = (float*)smem;
  float* red = sc + 9 * 1024;
  const int tid = threadIdx.x, lane = tid & 63, w = tid >> 6;
  for (int idx = tid; idx < 9 * 1024; idx += THREADS) {
    int r = idx >> 10, k = idx & 1023;
    float v = (r == 0) ? p.c_ctx[k] : p.c[(r - 1) * 1024 + k];
    sc[idx] = v / (1.f + expf(-v));
  }
  __syncthreads();
  const int cg4 = tid & 7, kg = tid >> 3, n0 = it * 32;
  float acc[9][4];
#pragma unroll
  for (int r = 0; r < 9; ++r)
#pragma unroll
    for (int e = 0; e < 4; ++e) acc[r][e] = 0.f;
  float4 wv[16];
#pragma unroll
  for (int i = 0; i < 16; ++i) wv[i] = *(const float4*)(p.w_mod + (size_t)(kg * 16 + i) * 3072 + n0 + cg4 * 4);
#pragma unroll
  for (int i = 0; i < 16; ++i) {
#pragma unroll
    for (int r = 0; r < 9; ++r) {
      const float s = sc[r * 1024 + kg * 16 + i];
      acc[r][0] += s * wv[i].x; acc[r][1] += s * wv[i].y; acc[r][2] += s * wv[i].z; acc[r][3] += s * wv[i].w;
    }
  }
#pragma unroll
  for (int r = 0; r < 9; ++r)
#pragma unroll
    for (int e = 0; e < 4; ++e) {
      float v = acc[r][e];
      v += __shfl_xor(v, 8);
      v += __shfl_xor(v, 16);
      v += __shfl_xor(v, 32);
      acc[r][e] = v;
    }
  if (lane < 8) {
#pragma unroll
    for (int r = 0; r < 9; ++r)
#pragma unroll
      for (int e = 0; e < 4; ++e) red[(w * 9 + r) * 32 + lane * 4 + e] = acc[r][e];
  }
  __syncthreads();
  float* mod = (float*)(p.ws + OFF_MOD);
  if (tid < 9 * 32) {
    int r = tid >> 5, c2 = tid & 31;
    float s = p.b_mod[n0 + c2];
#pragma unroll
    for (int g = 0; g < 8; ++g) s += red[(g * 9 + r) * 32 + c2];
    mod[r * 3072 + n0 + c2] = s;
  }
  asm volatile("s_waitcnt vmcnt(0)" ::: "memory");
  __syncthreads();
  if (tid == 0) {
    __builtin_amdgcn_fence(__ATOMIC_RELEASE, "agent");
    asm volatile("s_waitcnt vmcnt(0)" ::: "memory");
    __hip_atomic_fetch_add((unsigned*)(p.ws + OFF_CTR) + 16, 1u, __ATOMIC_RELAXED, __HIP_MEMORY_SCOPE_AGENT);
  }
}

__device__ __forceinline__ void p0_transpose_item(const float* __restrict__ src, int lds_src, u16* __restrict__ dst, int ldk, int kt, int nt,
                                  int nvalid, bool permute, char* smem) {
  u16* T = (u16*)smem;
  const int tid = threadIdx.x, cc = tid & 63, kr = tid >> 6;
  const int n = nt * 64 + cc;
  int on = n;
  if (permute) on = (n < 3072) ? n : (n < 6144 ? n + 32 : n - 3072);
#pragma unroll
  for (int i = 0; i < 8; ++i) {
    int kk = kr + i * 8;
    float v = (n < nvalid) ? src[(size_t)(kt * 64 + kk) * lds_src + on] : 0.f;
    T[cc * 72 + kk] = f2bf(v);
  }
  __syncthreads();
  const int row = tid >> 3, c8 = tid & 7;
  uint4 v = *(const uint4*)(T + row * 72 + c8 * 8);
  *(uint4*)(dst + (size_t)(nt * 64 + row) * ldk + kt * 64 + c8 * 8) = v;
  __syncthreads();
}

__device__ __forceinline__ void phase0(const Params& p, char* smem) {
  const int tid = threadIdx.x;

  constexpr int N_MOD = 96, N_WIN = 1600, N_ROPE = 64;
  for (int it = blockIdx.x; it < N_MOD + N_WIN + N_ROPE; it += gridDim.x) {
    if (it < N_MOD) {
      p0_mod_item(p, smem, it);
    } else if (it < N_MOD + N_WIN) {
      int q = it - N_MOD;
      p0_transpose_item(p.w_in, INC, (u16*)(p.ws + OFF_WTIN), 1024, q / 100, q % 100, INC, true, smem);
    } else {
      int q = it - N_MOD - N_WIN;
      int idx = q * 512 + tid;
      int pos = idx >> 5, m = idx & 31, fm = m & 15;
      float inv = exp2f(-(float)(2 * fm) / 32.f * 13.287712379549449f);
      float coord = (float)((m < 16) ? (pos >> 6) : (pos & 63));
      float ang = coord * inv;
      float* tab = (float*)(p.ws + OFF_ROPE);
      tab[idx * 2] = __cosf(ang);
      tab[idx * 2 + 1] = __sinf(ang);
    }
  }
}

__device__ __forceinline__ void phase1(const Params& p) {
  if (threadIdx.x == 0) {
    unsigned* flag = (unsigned*)(p.ws + OFF_CTR) + 16;
    while (__hip_atomic_load(flag, __ATOMIC_RELAXED, __HIP_MEMORY_SCOPE_AGENT) < 96u) __builtin_amdgcn_s_sleep(1);
    __builtin_amdgcn_fence(__ATOMIC_ACQUIRE, "agent");
    asm volatile("s_waitcnt vmcnt(0)" ::: "memory");
  }
  __syncthreads();
  const int tid = otid(), lane = tid & 63, w = tid >> 6;
  const float* mod = (const float*)(p.ws + OFF_MOD);
  u16* hb = (u16*)(p.ws + OFF_H);
  float4 nw[4];
#pragma unroll
  for (int i = 0; i < 4; ++i) nw[i] = *(const float4*)(p.norm_pre_w + (i * 64 + lane) * 4);
  const int rstep = gridDim.x * 8;
#pragma unroll 1
  for (int row0 = blockIdx.x * 8 + w; row0 < NTOK; row0 += 2 * rstep) {
    float4 v[2][4], sh[2][4], sc[2][4];
    int rows[2];
#pragma unroll
    for (int j = 0; j < 2; ++j) {
      const int row = row0 + j * rstep;
      rows[j] = row;
      if (row < NTOK) {
        const float* xr = (row < NPR) ? p.x_prompt + (size_t)row * DM : p.x_sample + (size_t)(row - NPR) * DM;
        const int mr = (row < NPR) ? 0 : 1 + ((row - NPR) >> 10);
#pragma unroll
        for (int i = 0; i < 4; ++i) {
          const int k = (i * 64 + lane) * 4;
          v[j][i] = *(const float4*)(xr + k);
          sh[j][i] = *(const float4*)(mod + mr * 3072 + k);
          sc[j][i] = *(const float4*)(mod + mr * 3072 + 1024 + k);
        }
      }
    }
#pragma unroll
    for (int j = 0; j < 2; ++j) {
      if (rows[j] < NTOK) {
        float ss = 0.f;
#pragma unroll
        for (int i = 0; i < 4; ++i) ss += v[j][i].x * v[j][i].x + v[j][i].y * v[j][i].y + v[j][i].z * v[j][i].z + v[j][i].w * v[j][i].w;
#pragma unroll
        for (int m = 32; m >= 1; m >>= 1) ss += __shfl_xor(ss, m);
        const float rstd = rsqrtf(ss * (1.f / 1024.f) + 1e-6f);
#pragma unroll
        for (int i = 0; i < 4; ++i) {
          const int k = (i * 64 + lane) * 4;
          const float h0 = v[j][i].x * rstd * nw[i].x * (1.f + sc[j][i].x) + sh[j][i].x;
          const float h1 = v[j][i].y * rstd * nw[i].y * (1.f + sc[j][i].y) + sh[j][i].y;
          const float h2 = v[j][i].z * rstd * nw[i].z * (1.f + sc[j][i].z) + sh[j][i].z;
          const float h3 = v[j][i].w * rstd * nw[i].w * (1.f + sc[j][i].w) + sh[j][i].w;
          *(uint2*)(hb + (size_t)rows[j] * DM + k) = make_uint2(pack2(h0, h1), pack2(h2, h3));
        }
      }
    }
  }
}

template <int MODE, int MT>
__device__ __forceinline__ void gemm_tile(const Params& p, const u16* __restrict__ A, const u16* __restrict__ B, const int K, const int mt,
                          const int nt, char* smem) {
  constexpr int LDT = 72;
  constexpr int STAGE = 2 * 256 * LDT;
  u16* sm = (u16*)smem;
  int tid_ = threadIdx.x;
  asm volatile("" : "+v"(tid_));
  const int tid = tid_, lane = tid & 63, w = tid >> 6, wm = w >> 2, wn = w & 3, l31 = lane & 31, h = lane >> 5;
  constexpr int AROWS = 64 * MT;
  f32x16 acc[MT][2];
#pragma unroll
  for (int mi = 0; mi < MT; ++mi)
#pragma unroll
    for (int ni = 0; ni < 2; ++ni)
#pragma unroll
      for (int r = 0; r < 16; ++r) acc[mi][ni][r] = 0.f;
  const int srow = tid >> 3, sc8 = tid & 7;
  const u16* Ag = A + (size_t)(mt * AROWS + srow) * K + sc8 * 8;
  const u16* Bg = B + (size_t)(nt * 256 + srow) * K + sc8 * 8;
  u32x4 ra0[MT], rb0[4];
  const int nk = K / 64;
#define GLOAD(RA, RB, KT)                                                                                   \
  do {                                                                                                      \
    _Pragma("unroll") for (int i = 0; i < MT; ++i) RA[i] = *(const u32x4*)(Ag + (size_t)(i * 64) * K + (KT) * 64); \
    _Pragma("unroll") for (int i = 0; i < 4; ++i) RB[i] = *(const u32x4*)(Bg + (size_t)(i * 64) * K + (KT) * 64);  \
  } while (0)
#define SSTORE(RA, RB, ST)                                                                                  \
  do {                                                                                                      \
    u16* Ad = sm + (ST) * STAGE;                                                                            \
    _Pragma("unroll") for (int i = 0; i < MT; ++i) *(u32x4*)(Ad + (srow + i * 64) * LDT + sc8 * 8) = RA[i]; \
    _Pragma("unroll") for (int i = 0; i < 4; ++i) *(u32x4*)(Ad + 256 * LDT + (srow + i * 64) * LDT + sc8 * 8) = RB[i]; \
  } while (0)
#define LDFRAG(AF, BF, KS)                                                                                  \
  do {                                                                                                      \
    _Pragma("unroll") for (int mi = 0; mi < MT; ++mi) AF[mi] = *(const bf16x8*)(Abase + mi * 32 * LDT + (KS) * 16); \
    _Pragma("unroll") for (int ni = 0; ni < 2; ++ni) BF[ni] = *(const bf16x8*)(Bbase + ni * 32 * LDT + (KS) * 16);  \
  } while (0)
#define MMA(AF, BF)                                                                                         \
  do {                                                                                                      \
    _Pragma("unroll") for (int mi = 0; mi < MT; ++mi)                                                       \
    _Pragma("unroll") for (int ni = 0; ni < 2; ++ni) acc[mi][ni] = MFMA32(BF[ni], AF[mi], acc[mi][ni]);     \
  } while (0)
  auto compute = [&](const int st, const int kt) {
    const u16* Abase = sm + st * STAGE + (wm * (MT * 32) + l31) * LDT + h * 8;
    const u16* Bbase = sm + st * STAGE + 256 * LDT + (wn * 64 + l31) * LDT + h * 8;
    bf16x8 af0[MT], bf0[2], af1[MT], bf1[2];
    LDFRAG(af0, bf0, 0);
    __builtin_amdgcn_sched_barrier(0);
    LDFRAG(af1, bf1, 1);
    __builtin_amdgcn_sched_barrier(0);
    MMA(af0, bf0);
    __builtin_amdgcn_sched_barrier(0);
    LDFRAG(af0, bf0, 2);
    __builtin_amdgcn_sched_barrier(0);
    if (kt + 1 < nk) SSTORE(ra0, rb0, st ^ 1);
    __builtin_amdgcn_sched_barrier(0);
    MMA(af1, bf1);
    __builtin_amdgcn_sched_barrier(0);
    if (kt + 2 < nk) GLOAD(ra0, rb0, kt + 2);
    __builtin_amdgcn_sched_barrier(0);
    LDFRAG(af1, bf1, 3);
    __builtin_amdgcn_sched_barrier(0);
    MMA(af0, bf0);
    __builtin_amdgcn_sched_barrier(0);
    MMA(af1, bf1);
  };
  auto rowscale = [&]() {
    const float* ssq = (const float*)(p.ws + OFF_SSQ);
#pragma unroll
    for (int mi = 0; mi < MT; ++mi) {
      const int m = mt * AROWS + wm * (MT * 32) + mi * 32 + l31;
      float s = 0.f;
#pragma unroll
      for (int q = 0; q < 4; ++q) {
        float4 t = *(const float4*)(ssq + (size_t)m * 16 + q * 4);
        s += t.x + t.y + t.z + t.w;
      }
      const float rs = rsqrtf(s * (1.f / 1024.f) + 1e-6f);
#pragma unroll
      for (int ni = 0; ni < 2; ++ni)
#pragma unroll
        for (int r = 0; r < 16; ++r) acc[mi][ni][r] *= rs;
    }
  };
  GLOAD(ra0, rb0, 0);
  SSTORE(ra0, rb0, 0);
  GLOAD(ra0, rb0, 1);
  __syncthreads();
#pragma unroll 1
  for (int kt = 0; kt < nk; ++kt) {
    compute(kt & 1, kt);
    if (MODE == 1 && kt == 15) rowscale();
    __syncthreads();
  }
#undef GLOAD
#undef SSTORE
#undef LDFRAG
#undef MMA
  if (MODE == 0) {
    if (nt < 24) {
      u16* u = (u16*)(p.ws + OFF_U);
      u16* cst = sm + w * (128 * 72);
#pragma unroll
      for (int mi = 0; mi < MT; ++mi) {
        const int m = mt * AROWS + wm * (MT * 32) + mi * 32 + l31;
#pragma unroll
        for (int ni = 0; ni < 2; ++ni)
#pragma unroll
          for (int g = 0; g < 4; ++g) {
            const int n = nt * 256 + wn * 64 + ni * 32 + 8 * g + 4 * h;
            const uint2 pk =
                make_uint2(pack2(acc[mi][ni][4 * g], acc[mi][ni][4 * g + 1]), pack2(acc[mi][ni][4 * g + 2], acc[mi][ni][4 * g + 3]));
            *(uint2*)(cst + (mi * 32 + l31) * 72 + ni * 32 + 8 * g + 4 * h) = pk;
            if (MT == 4 && nt >= 4 && nt < 12 && ((mi == 0 && l31 == 0) || (mi == 3 && l31 == 31)))
              *(uint2*)((u16*)(p.ws + OFF_HALO) + ((size_t)(m >> 7) * 2 + (mi == 3 ? 1 : 0)) * 2048 + (n - 1024)) = pk;
          }
      }
      {
        const int rr = lane >> 3, c8 = lane & 7;
        u16* ug = u + (size_t)(mt * AROWS + wm * (MT * 32) + rr) * UC + nt * 256 + wn * 64 + c8 * 8;
#pragma unroll
        for (int i = 0; i < MT * 4; ++i) {
          const u32x4 v = *(const u32x4*)(cst + (i * 8 + rr) * 72 + c8 * 8);
          *(u32x4*)(ug + (size_t)(i * 8) * UC) = v;
        }
      }
      __syncthreads();
    } else if (wn == 0) {
      float* dt = (float*)(p.ws + OFF_DT);
#pragma unroll
      for (int mi = 0; mi < MT; ++mi) {
        const int m = mt * AROWS + wm * (MT * 32) + mi * 32 + l31;
#pragma unroll
        for (int g = 0; g < 4; ++g)
          *(float4*)(dt + (size_t)m * 32 + 8 * g + 4 * h) =
              make_float4(acc[mi][0][4 * g], acc[mi][0][4 * g + 1], acc[mi][0][4 * g + 2], acc[mi][0][4 * g + 3]);
      }
    }
  } else {
    float* ob = (float*)(p.ws + OFF_OUTB);
    float* ssq2 = (float*)(p.ws + OFF_SSQ2);
    float* cst = (float*)smem + w * (MT * 32 * 36);
    float ssum[MT];
#pragma unroll
    for (int mi = 0; mi < MT; ++mi) ssum[mi] = 0.f;
#pragma unroll
    for (int ni = 0; ni < 2; ++ni) {
#pragma unroll
      for (int mi = 0; mi < MT; ++mi)
#pragma unroll
        for (int g = 0; g < 4; ++g) {
          const float4 v = make_float4(acc[mi][ni][4 * g], acc[mi][ni][4 * g + 1], acc[mi][ni][4 * g + 2], acc[mi][ni][4 * g + 3]);
          ssum[mi] += v.x * v.x + v.y * v.y + v.z * v.z + v.w * v.w;
          *(float4*)(cst + (mi * 32 + l31) * 36 + 8 * g + 4 * h) = v;
        }
      const int rr = lane >> 3, c4 = lane & 7;
      float* og = ob + (size_t)(mt * AROWS + wm * (MT * 32) + rr) * DM + nt * 256 + wn * 64 + ni * 32 + c4 * 4;
#pragma unroll
      for (int i = 0; i < MT * 4; ++i) {
        const float4 v = *(const float4*)(cst + (i * 8 + rr) * 36 + c4 * 4);
        *(float4*)(og + (size_t)(i * 8) * DM) = v;
      }
    }
#pragma unroll
    for (int mi = 0; mi < MT; ++mi) {
      const int m = mt * AROWS + wm * (MT * 32) + mi * 32 + l31;
      float s = ssum[mi];
      s += __shfl_xor(s, 32);
      if (h == 0) ssq2[(size_t)m * 16 + nt * 4 + wn] = s;
    }
    __syncthreads();
  }
}

__device__ __forceinline__ void phase_conv(const Params& p) {
  const int tid = otid();
  const int c8 = tid & 15, rg = tid >> 4;
  u16* u = (u16*)(p.ws + OFF_U);
  const u16* halo = (const u16*)(p.ws + OFF_HALO);
#pragma unroll 1
  for (int id = blockIdx.x; id < 96 * 16; id += gridDim.x) {
    const int c = id >> 4, strip = id & 15;
    const bool first = (c < 32) ? ((c & 1) == 0) : (((c - 32) & 7) == 0);
    const bool last = (c < 32) ? ((c & 1) == 1) : (((c - 32) & 7) == 7);
    const int ch = strip * 128 + c8 * 8;
    u16* up = u + (size_t)(c * 128 + rg * 4) * UC + 1024 + ch;
    u32x4 r[6];
    const u32x4 z4 = {0u, 0u, 0u, 0u};
#pragma unroll
    for (int i = 1; i < 5; ++i) r[i] = *(const u32x4*)(up + (ptrdiff_t)(i - 1) * UC);
    if (rg > 0) r[0] = *(const u32x4*)(up - UC);
    else r[0] = first ? z4 : *(const u32x4*)(halo + ((size_t)(c - 1) * 2 + 1) * 2048 + ch);
    if (rg < 31) r[5] = *(const u32x4*)(up + 4 * UC);
    else r[5] = last ? z4 : *(const u32x4*)(halo + ((size_t)(c + 1) * 2) * 2048 + ch);
    float w0[8], w1[8], w2[8], bs[8];
#pragma unroll
    for (int e = 0; e < 8; e += 4) {
      const float4 a = *(const float4*)(p.conv_w + ch + e), b = *(const float4*)(p.conv_w + 2048 + ch + e),
                   cc = *(const float4*)(p.conv_w + 4096 + ch + e), d = *(const float4*)(p.conv_b + ch + e);
      w0[e] = a.x; w0[e + 1] = a.y; w0[e + 2] = a.z; w0[e + 3] = a.w;
      w1[e] = b.x; w1[e + 1] = b.y; w1[e + 2] = b.z; w1[e + 3] = b.w;
      w2[e] = cc.x; w2[e + 1] = cc.y; w2[e + 2] = cc.z; w2[e + 3] = cc.w;
      bs[e] = d.x; bs[e + 1] = d.y; bs[e + 2] = d.z; bs[e + 3] = d.w;
    }
    u32x4 o[4];
#pragma unroll
    for (int i = 0; i < 4; ++i) {
      const unsigned pu[4] = {r[i][0], r[i][1], r[i][2], r[i][3]}, cu[4] = {r[i + 1][0], r[i + 1][1], r[i + 1][2], r[i + 1][3]},
                     nu[4] = {r[i + 2][0], r[i + 2][1], r[i + 2][2], r[i + 2][3]};
      unsigned ov[4];
#pragma unroll
      for (int e2 = 0; e2 < 4; ++e2) {
        const float v0 = w0[2 * e2] * lo_bf(pu[e2]) + w1[2 * e2] * lo_bf(cu[e2]) + w2[2 * e2] * lo_bf(nu[e2]) + bs[2 * e2];
        const float v1 = w0[2 * e2 + 1] * hi_bf(pu[e2]) + w1[2 * e2 + 1] * hi_bf(cu[e2]) + w2[2 * e2 + 1] * hi_bf(nu[e2]) + bs[2 * e2 + 1];
        ov[e2] = pack2(silu_f(v0), silu_f(v1));
      }
      o[i] = u32x4{ov[0], ov[1], ov[2], ov[3]};
    }
    __syncthreads();
#pragma unroll
    for (int i = 0; i < 4; ++i) *(u32x4*)(up + (ptrdiff_t)i * UC) = o[i];
  }
}

constexpr int SC_ARR = 143360;
constexpr int SC_ITEM = SC_ARR + 5632;
constexpr int SC_CW = SC_ARR + 6144;

template <int W>
DI void issue_rows(const u16* __restrict__ u, u32x4* r, const int ucol, const int tok0) {
  constexpr int PC = W / 8, RS = THREADS / PC, NI = 128 / RS;
  const int tid = otid();
  const int c8 = tid % PC, r0 = tid / PC;
  const u16* base = u + (size_t)(tok0 + r0) * UC + ucol + c8 * 8;
#pragma unroll
  for (int i = 0; i < NI; ++i) r[i] = *(const u32x4*)(base + (size_t)i * (RS * UC));
}
template <int W, bool WITHV, bool WITHW>
DI void finish_rows(const u32x4* r, u16* dst, u16* dstw, const int ld, const float* wgt) {
  constexpr int PC = W / 8, RS = THREADS / PC, NI = 128 / RS;
  const int tid = otid();
  const int c8 = tid % PC, r0 = tid / PC;
#pragma unroll
  for (int i = 0; i < NI; ++i) {
    const int row = r0 + RS * i;
    if (WITHV) *(u32x4*)(dst + row * ld + c8 * 8) = r[i];
    if (WITHW) {
      const float wg = wgt[row];
      const unsigned xu[4] = {r[i][0], r[i][1], r[i][2], r[i][3]};
      unsigned o[4];
#pragma unroll
      for (int e = 0; e < 4; ++e) o[e] = pack2(lo_bf(xu[e]) * wg, hi_bf(xu[e]) * wg);
      *(uint4*)(dstw + row * ld + c8 * 8) = make_uint4(o[0], o[1], o[2], o[3]);
    }
  }
}
DI void issue_qk(const u16* __restrict__ u, u32x4* r, const int ucol, const int tok0) {
  const int tid = otid();
  const int row = tid >> 2, pp = tid & 3;
  const int pa = (pp & 1) + (pp >> 1) * 4;
  const u16* up = u + (size_t)(tok0 + row) * UC + ucol;
  r[0] = *(const u32x4*)(up + pa * 8);
  r[1] = *(const u32x4*)(up + pa * 8 + 16);
}
DI void finish_qk(const u32x4* r, const float4* tb, u16* dst, const int ld, const bool rope, const float scale) {
  const int tid = otid();
  const int row = tid >> 2, pp = tid & 3;
  const int pa = (pp & 1) + (pp >> 1) * 4, pb = pa + 2;
  const unsigned au[4] = {r[0][0], r[0][1], r[0][2], r[0][3]}, bu[4] = {r[1][0], r[1][1], r[1][2], r[1][3]};
  const float tf[16] = {tb[0].x, tb[0].y, tb[0].z, tb[0].w, tb[1].x, tb[1].y, tb[1].z, tb[1].w,
                        tb[2].x, tb[2].y, tb[2].z, tb[2].w, tb[3].x, tb[3].y, tb[3].z, tb[3].w};
  float o1[8], o2[8];
#pragma unroll
  for (int e = 0; e < 8; ++e) {
    const float x1 = (e & 1) ? hi_bf(au[e >> 1]) : lo_bf(au[e >> 1]);
    const float x2 = (e & 1) ? hi_bf(bu[e >> 1]) : lo_bf(bu[e >> 1]);
    const float cs = rope ? tf[2 * e] : 1.f, sn = rope ? tf[2 * e + 1] : 0.f;
    o1[e] = (x1 * cs - x2 * sn) * scale;
    o2[e] = (x2 * cs + x1 * sn) * scale;
  }
  *(uint4*)(dst + row * ld + pa * 8) = make_uint4(pack2(o1[0], o1[1]), pack2(o1[2], o1[3]), pack2(o1[4], o1[5]), pack2(o1[6], o1[7]));
  *(uint4*)(dst + row * ld + pb * 8) = make_uint4(pack2(o2[0], o2[1]), pack2(o2[2], o2[3]), pack2(o2[4], o2[5]), pack2(o2[6], o2[7]));
}
template <int N, int P, bool SSD>
__device__ __forceinline__ void scan_item(const Params& p, char* smem, const int stream, const int b, const int hd, const int unit0, int* qctr, int* s_item) {
  constexpr int LQ = N + 8, LV = P + 8;
  constexpr int PT = P / 64, NKS = N / 16, NT = N / 32;
  constexpr int NQ = SSD ? 4 : 2;
  u16* Qs = (u16*)smem;
  u16* Ks = Qs + 128 * LQ;
  u16* Vs = Ks + 128 * LQ;
  u16* Vw = Vs + 128 * LV;
  u16* SfT = Vw + 128 * LV;
  u16* SbT = SfT + P * LQ;
  float* dtf = (float*)(smem + SC_ARR);
  float* dtb = dtf + 128;
  float* cumf = dtb + 128;
  float* cumb = cumf + 128;
  float* ecf = cumb + 128;
  float* ecb = ecf + 128;
  float* wgt = ecb + 128;
  float* fct = (float*)(smem + SC_CW);

  int tid_ = threadIdx.x;
  asm volatile("" : "+v"(tid_));
  const int tid = tid_, lane = tid & 63, w = __builtin_amdgcn_readfirstlane(tid >> 6), l31 = lane & 31, h = lane >> 5;
  const int strip = w & 3, half = w >> 2;
  const int ntile = w % NT, ptile = w / NT;
  const int q4 = (lane & 15) >> 2, p4 = lane & 3, blk = (lane >> 4) & 1;
  const int L = stream ? 1024 : 256, nc = L / 128;
  const int seqbase = stream ? NPR + b * 1024 : b * 256;
  char* wsb = p.ws;
  asm volatile("" : "+s"(wsb));
  const u16* u = (const u16*)(wsb + OFF_U);
  const float* dtraw = (const float*)(wsb + OFF_DT);
  u16* mix = (u16*)(wsb + OFF_MIX);
  float* ssq = (float*)(wsb + OFF_SSQ);
  uint2* dump = (uint2*)(wsb + OFF_DUMP);
  const float4* ropetab = (const float4*)(wsb + OFF_ROPE);

  float Dh = 0.f, lamf = 0.f, lamb = 0.f, bias_d = 0.f, A_d = 0.f;
  const int grp = hd >> 2;
  if (SSD) {
    Dh = p.ssd_D[hd];
    const int d = w & 1;
    bias_d = p.dt_bias[d * 16 + hd];
    A_d = expf(p.A_log[d * 16 + hd]);
  } else {
    lamf = -expf(p.ret_decay[hd]);
    lamb = -expf(p.ret_decay[8 + hd]);
  }

  u32x4 rq[NQ], rk[NQ], rx[4];
  uint2 rdump[4];
  float4 rt[4];
  float rd0 = 0.f, rd1 = 0.f;

  auto issue_loads = [&](const int c, const int sweep) {
    const int tok0 = seqbase + c * 128, t0 = c * 128;
    if (sweep) {
      const uint2* dp = dump + ((size_t)(unit0 + c) * 8 + w) * 256;
#pragma unroll
      for (int g = 0; g < 4; ++g) rdump[g] = dp[g * 64 + lane];
    }
    if (SSD) {
      if (sweep) issue_rows<128>(u, rq, 2560 + grp * 128, tok0);
      issue_rows<128>(u, rk, 2048 + grp * 128, tok0);
      issue_rows<64>(u, rx, 1024 + hd * 64, tok0);
      if (w < 2) {
        const int ol = otid() & 63;
        const int sj0 = (w & 1) ? 127 - 2 * ol : 2 * ol, sj1 = (w & 1) ? 126 - 2 * ol : 2 * ol + 1;
        rd0 = dtraw[(size_t)(tok0 + sj0) * 32 + w * 16 + hd];
        rd1 = dtraw[(size_t)(tok0 + sj1) * 32 + w * 16 + hd];
      }
    } else {
      if (sweep) issue_qk(u, rq, 3072 + hd * 64, tok0);
      issue_qk(u, rk, 3584 + hd * 64, tok0);
      issue_rows<128>(u, rx, 4096 + hd * 128, tok0);
      if (stream) {
        const int ot = otid();
        const int row = ot >> 2, pp = ot & 3;
        const float4* tp = ropetab + ((size_t)(t0 + row) * 32 + (pp >> 1) * 16 + (pp & 1) * 8) / 2;
#pragma unroll
        for (int i = 0; i < 4; ++i) rt[i] = tp[i];
      }
    }
  };

  auto finish_loads = [&](const int c, const int sweep) {
    if (SSD) {
      if (w < 2) {
        const int ol = otid() & 63;
        const int sj0 = (w & 1) ? 127 - 2 * ol : 2 * ol, sj1 = (w & 1) ? 126 - 2 * ol : 2 * ol + 1;
        const float raw0 = rd0 + bias_d, raw1 = rd1 + bias_d;
        const float dt0 = fmaxf(raw0, 0.f) + __logf(1.f + __expf(-fabsf(raw0)));
        const float dt1 = fmaxf(raw1, 0.f) + __logf(1.f + __expf(-fabsf(raw1)));
        const float la0 = -dt0 * A_d, la1 = -dt1 * A_d;
        float s = la0 + la1;
#pragma unroll
        for (int d = 1; d < 64; d <<= 1) {
          const float t = __shfl_up(s, d);
          if (lane >= d) s += t;
        }
        const float tot = __shfl(s, 63);
        const float c1 = s, c0 = s - la1;
        float* dta = w ? dtb : dtf;
        float* cua = w ? cumb : cumf;
        float* eca = w ? ecb : ecf;
        dta[sj0] = dt0; dta[sj1] = dt1;
        cua[sj0] = c0; cua[sj1] = c1;
        eca[sj0] = __expf(c0); eca[sj1] = __expf(c1);
        if (w == sweep) {
          wgt[sj0] = dt0 * __expf(tot - c0);
          wgt[sj1] = dt1 * __expf(tot - c1);
        }
      }
    } else {
      if (tid < 128) {
        const float cf = (float)(tid + 1) * lamf, cb = (float)(128 - tid) * lamb;
        dtf[tid] = 1.f; dtb[tid] = 1.f;
        cumf[tid] = cf; cumb[tid] = cb;
        ecf[tid] = __expf(cf); ecb[tid] = __expf(cb);
        wgt[tid] = sweep ? __expf((float)tid * lamb) : __expf((float)(127 - tid) * lamf);
      }
    }
    __syncthreads();
    if (sweep) {
      const int ot = otid();
      const int s = ot >> 7, j = ot & 127;
      float val = 0.f;
      if (j < s * 32) val = dtf[j] * __expf(cumf[s * 32 - 1] - cumf[j]);
      else if (j >= s * 32 + 32) val = dtb[j] * __expf(cumb[s * 32 + 32] - cumb[j]);
      fct[ot] = val;
    }
    if (SSD) {
      if (sweep) finish_rows<128, true, false>(rq, Qs, nullptr, LQ, nullptr);
      finish_rows<128, true, false>(rk, Ks, nullptr, LQ, nullptr);
      if (sweep) finish_rows<64, true, true>(rx, Vs, Vw, LV, wgt);
      else finish_rows<64, false, true>(rx, Vs, Vw, LV, wgt);
    } else {
      if (sweep) finish_qk(rq, rt, Qs, LQ, stream != 0, 1.f);
      finish_qk(rk, rt, Ks, LQ, stream != 0, 0.125f);
      if (sweep) finish_rows<128, true, true>(rx, Vs, Vw, LV, wgt);
      else finish_rows<128, false, true>(rx, Vs, Vw, LV, wgt);
    }
    if (sweep) {
#pragma unroll
      for (int g = 0; g < 4; ++g) *(uint2*)(SfT + (ptile * 32 + l31) * LQ + ntile * 32 + 8 * g + 4 * h) = rdump[g];
    }
    __syncthreads();
  };

  auto state_update = [&](f32x16& S, const float dec) {
#pragma unroll
    for (int r = 0; r < 16; ++r) S[r] *= dec;
    const u16* ka0 = Ks + (8 * h + q4) * LQ + ntile * 32 + 16 * blk + 4 * p4;
    const u16* vb0 = Vw + (8 * h + q4) * LV + ptile * 32 + 16 * blk + 4 * p4;
    s16x4 ta[8][2], tb[8][2];
#pragma unroll
    for (int ks = 0; ks < 8; ++ks) {
      ta[ks][0] = tr_read(ka0 + ks * 16 * LQ);
      ta[ks][1] = tr_read(ka0 + ks * 16 * LQ + 4 * LQ);
      tb[ks][0] = tr_read(vb0 + ks * 16 * LV);
      tb[ks][1] = tr_read(vb0 + ks * 16 * LV + 4 * LV);
    }
    __builtin_amdgcn_sched_barrier(0);
#pragma unroll
    for (int ks = 0; ks < 8; ++ks) S = MFMA32(cat8(ta[ks][0], ta[ks][1]), cat8(tb[ks][0], tb[ks][1]), S);
    __builtin_amdgcn_sched_barrier(0);
  };

  auto load_state = [&](f32x16& S, const int dir) {
    if (stream) {
      const float* sp = SSD ? p.state_ssd + ((size_t)((b * 2 + dir) * 16 + hd)) * 128 * 64
                            : p.state_ret + ((size_t)((b * 2 + dir) * 8 + hd)) * 64 * 128;
#pragma unroll
      for (int r = 0; r < 16; ++r) S[r] = sp[(ntile * 32 + crow(r, h)) * P + ptile * 32 + l31];
    } else {
#pragma unroll
      for (int r = 0; r < 16; ++r) S[r] = 0.f;
    }
  };
  auto store_state = [&](const f32x16& S, const int dir) {
    if (!stream) {
      float* op = SSD ? p.out + (size_t)NTOK * DM + ((size_t)((b * 2 + dir) * 16 + hd)) * 128 * 64
                      : p.out + (size_t)NTOK * DM + (size_t)16 * 2 * 16 * 128 * 64 + ((size_t)((b * 2 + dir) * 8 + hd)) * 64 * 128;
#pragma unroll
      for (int r = 0; r < 16; ++r) op[(ntile * 32 + crow(r, h)) * P + ptile * 32 + l31] = S[r];
    }
  };

  f32x16 S;
  issue_loads(0, 0);
  load_state(S, 0);
#pragma unroll 1
  for (int c = 0; c < nc; ++c) {
    finish_loads(c, 0);
    {
      uint2* dp = dump + ((size_t)(unit0 + c) * 8 + w) * 256;
#pragma unroll
      for (int g = 0; g < 4; ++g) dp[g * 64 + lane] = make_uint2(pack2(S[4 * g], S[4 * g + 1]), pack2(S[4 * g + 2], S[4 * g + 3]));
    }
    if (c + 1 < nc) issue_loads(c + 1, 0);
    else {
      issue_loads(nc - 1, 1);
#pragma unroll
      for (int g = 0; g < 4; ++g) rdump[g] = make_uint2(pack2(S[4 * g], S[4 * g + 1]), pack2(S[4 * g + 2], S[4 * g + 3]));
    }
    state_update(S, __expf(cumf[127]));
    __syncthreads();
  }
  store_state(S, 0);

  load_state(S, 1);
#pragma unroll
  for (int g = 0; g < 4; ++g)
    *(uint2*)(SbT + (ptile * 32 + l31) * LQ + ntile * 32 + 8 * g + 4 * h) =
        make_uint2(pack2(S[4 * g], S[4 * g + 1]), pack2(S[4 * g + 2], S[4 * g + 3]));
  int nextq = 0;
#pragma unroll 1
  for (int c = nc - 1; c >= 0; --c) {
    const int tok0 = seqbase + c * 128;
    finish_loads(c, 1);
    if (c == 0 && threadIdx.x == 0) nextq = atomicAdd(qctr, 1);
    if (c > 0) issue_loads(c - 1, 1);

    const u16* qrow = Qs + (strip * 32 + l31) * LQ + h * 8;
    f32x16 Y[PT];
#pragma unroll
    for (int pt = 0; pt < PT; ++pt) {
      const int prow = (half * PT + pt) * 32 + l31;
      bf16x8 fq[NKS], fs[NKS];
      {
#pragma unroll
        for (int ks = 0; ks < NKS; ++ks) {
          fq[ks] = *(const bf16x8*)(qrow + ks * 16);
          fs[ks] = *(const bf16x8*)(SfT + prow * LQ + ks * 16 + h * 8);
        }
        __builtin_amdgcn_sched_barrier(0);
        f32x16 a1;
#pragma unroll
        for (int r = 0; r < 16; ++r) a1[r] = 0.f;
#pragma unroll
        for (int ks = 0; ks < NKS; ++ks) a1 = MFMA32(fq[ks], fs[ks], a1);
        __builtin_amdgcn_sched_barrier(0);
#pragma unroll
        for (int ks = 0; ks < NKS; ++ks) fs[ks] = *(const bf16x8*)(SbT + prow * LQ + ks * 16 + h * 8);
#pragma unroll
        for (int g = 0; g < 4; ++g) {
          const float4 ef = *(const float4*)(ecf + strip * 32 + 8 * g + 4 * h);
          Y[pt][4 * g + 0] = ef.x * a1[4 * g + 0];
          Y[pt][4 * g + 1] = ef.y * a1[4 * g + 1];
          Y[pt][4 * g + 2] = ef.z * a1[4 * g + 2];
          Y[pt][4 * g + 3] = ef.w * a1[4 * g + 3];
        }
      }
      {
        __builtin_amdgcn_sched_barrier(0);
        f32x16 a2;
#pragma unroll
        for (int r = 0; r < 16; ++r) a2[r] = 0.f;
#pragma unroll
        for (int ks = 0; ks < NKS; ++ks) a2 = MFMA32(fq[ks], fs[ks], a2);
        __builtin_amdgcn_sched_barrier(0);
#pragma unroll
        for (int g = 0; g < 4; ++g) {
          const float4 eb = *(const float4*)(ecb + strip * 32 + 8 * g + 4 * h);
          Y[pt][4 * g + 0] += eb.x * a2[4 * g + 0];
          Y[pt][4 * g + 1] += eb.y * a2[4 * g + 1];
          Y[pt][4 * g + 2] += eb.z * a2[4 * g + 2];
          Y[pt][4 * g + 3] += eb.w * a2[4 * g + 3];
        }
      }
    }
    const int ii = strip * 32 + l31;
    const float cfi = cumf[ii], cbi = cumb[ii];

#pragma unroll 1
    for (int jt = 0; jt < 4; ++jt) {
      f32x16 G;
#pragma unroll
      for (int r = 0; r < 16; ++r) G[r] = 0.f;
      s16x4 tv[PT][4];
      {
        bf16x8 fk[NKS], fq[NKS];
#pragma unroll
        for (int ks = 0; ks < NKS; ++ks) {
          fk[ks] = *(const bf16x8*)(Ks + (jt * 32 + l31) * LQ + ks * 16 + h * 8);
          fq[ks] = *(const bf16x8*)(qrow + ks * 16);
        }
        __builtin_amdgcn_sched_barrier(0);
#pragma unroll
        for (int ks = 0; ks < NKS; ++ks) G = MFMA32(fk[ks], fq[ks], G);
        __builtin_amdgcn_sched_barrier(0);
#pragma unroll
        for (int pt = 0; pt < PT; ++pt) {
          const u16* vp = Vs + (jt * 32 + 4 * h + q4) * LV + (half * PT + pt) * 32 + 16 * blk + 4 * p4;
          tv[pt][0] = tr_read(vp);
          tv[pt][1] = tr_read(vp + 8 * LV);
          tv[pt][2] = tr_read(vp + 16 * LV);
          tv[pt][3] = tr_read(vp + 24 * LV);
        }
        __builtin_amdgcn_sched_barrier(0);
      }
      if (jt == strip) {
#pragma unroll
        for (int g = 0; g < 4; ++g) {
          const int jb = jt * 32 + 8 * g + 4 * h;
          const float4 cf4 = *(const float4*)(cumf + jb), cb4 = *(const float4*)(cumb + jb);
          const float4 df4 = *(const float4*)(dtf + jb), db4 = *(const float4*)(dtb + jb);
          const float cfa[4] = {cf4.x, cf4.y, cf4.z, cf4.w}, cba[4] = {cb4.x, cb4.y, cb4.z, cb4.w};
          const float dfa[4] = {df4.x, df4.y, df4.z, df4.w}, dba[4] = {db4.x, db4.y, db4.z, db4.w};
#pragma unroll
          for (int e = 0; e < 4; ++e) {
            const int j = jb + e;
            const float tf = __expf(cfi - cfa[e]) * dfa[e];
            const float tb = __expf(cbi - cba[e]) * dba[e];
            const float m = ((ii >= j) ? tf : 0.f) + ((ii <= j) ? tb : 0.f);
            float pv = G[4 * g + e] * m;
            if (SSD && ii == j) pv += Dh;
            G[4 * g + e] = pv;
          }
        }
      } else {
        const float ei = (jt < strip) ? __expf(cfi - cumf[strip * 32 - 1]) : __expf(cbi - cumb[strip * 32 + 32]);
#pragma unroll
        for (int g = 0; g < 4; ++g) {
          const float4 f4 = *(const float4*)(fct + strip * 128 + jt * 32 + 8 * g + 4 * h);
          G[4 * g + 0] *= ei * f4.x;
          G[4 * g + 1] *= ei * f4.y;
          G[4 * g + 2] *= ei * f4.z;
          G[4 * g + 3] *= ei * f4.w;
        }
      }
      const bf16x8 pf0 = pack8(G[0], G[1], G[2], G[3], G[4], G[5], G[6], G[7]);
      const bf16x8 pf1 = pack8(G[8], G[9], G[10], G[11], G[12], G[13], G[14], G[15]);
#pragma unroll
      for (int pt = 0; pt < PT; ++pt) {
        Y[pt] = MFMA32(pf0, cat8(tv[pt][0], tv[pt][1]), Y[pt]);
        Y[pt] = MFMA32(pf1, cat8(tv[pt][2], tv[pt][3]), Y[pt]);
      }
    }
    state_update(S, __expf(cumb[0]));
    constexpr int CPR = P / 8, NIT = 128 * CPR / THREADS;
    const int ec8 = tid % CPR, er0 = tid / CPR;
    const int ecol = SSD ? hd * 64 + ec8 * 8 : hd * 128 + ec8 * 8;
    uint4 gz[NIT];
#pragma unroll
    for (int i = 0; i < NIT; ++i)
      gz[i] = *(const uint4*)(u + (size_t)(tok0 + er0 + i * (THREADS / CPR)) * UC + (SSD ? 0 : 5120) + ecol);
    const float* nwp = SSD ? p.ssd_norm_w + ecol : p.ret_norm_w + ecol;
    const float4 n0 = *(const float4*)nwp, n1 = *(const float4*)(nwp + 4);
    const float nw[8] = {n0.x, n0.y, n0.z, n0.w, n1.x, n1.y, n1.z, n1.w};
    __syncthreads();
#pragma unroll
    for (int g = 0; g < 4; ++g)
      *(uint2*)(SbT + (ptile * 32 + l31) * LQ + ntile * 32 + 8 * g + 4 * h) =
          make_uint2(pack2(S[4 * g], S[4 * g + 1]), pack2(S[4 * g + 2], S[4 * g + 3]));
    constexpr int LY = P + 4;
    float* Yst = (float*)smem;
#pragma unroll
    for (int pt = 0; pt < PT; ++pt)
#pragma unroll
      for (int r = 0; r < 16; ++r) Yst[(strip * 32 + crow(r, h)) * LY + (half * PT + pt) * 32 + l31] = Y[pt][r];
    __syncthreads();
#pragma unroll
    for (int i = 0; i < NIT; ++i) {
      const int row = er0 + i * (THREADS / CPR);
      const float* yp = Yst + row * LY + ec8 * 8;
      const float4 y0 = *(const float4*)yp, y1 = *(const float4*)(yp + 4);
      float v[8] = {y0.x, y0.y, y0.z, y0.w, y1.x, y1.y, y1.z, y1.w};
      const size_t tok = (size_t)(tok0 + row);
      const unsigned zu[4] = {gz[i].x, gz[i].y, gz[i].z, gz[i].w};
      if (SSD) {
        float sq = 0.f;
#pragma unroll
        for (int e = 0; e < 8; ++e) {
          const float z = (e & 1) ? hi_bf(zu[e >> 1]) : lo_bf(zu[e >> 1]);
          v[e] *= silu_f(z);
          sq += v[e] * v[e];
        }
        sq += __shfl_xor(sq, 1);
        sq += __shfl_xor(sq, 2);
        sq += __shfl_xor(sq, 4);
        if (ec8 == 0) ssq[tok * 16 + hd] = sq;
        *(uint4*)(mix + tok * 2048 + ecol) = make_uint4(pack2(v[0] * nw[0], v[1] * nw[1]), pack2(v[2] * nw[2], v[3] * nw[3]),
                                                        pack2(v[4] * nw[4], v[5] * nw[5]), pack2(v[6] * nw[6], v[7] * nw[7]));
      } else {
        float s = 0.f;
#pragma unroll
        for (int e = 0; e < 8; ++e) s += v[e];
        s += __shfl_xor(s, 1);
        s += __shfl_xor(s, 2);
        s += __shfl_xor(s, 4);
        s += __shfl_xor(s, 8);
        const float mean = s * (1.f / 128.f);
        float s2 = 0.f;
#pragma unroll
        for (int e = 0; e < 8; ++e) {
          v[e] -= mean;
          s2 += v[e] * v[e];
        }
        s2 += __shfl_xor(s2, 1);
        s2 += __shfl_xor(s2, 2);
        s2 += __shfl_xor(s2, 4);
        s2 += __shfl_xor(s2, 8);
        const float rstd = rsqrtf(s2 * (1.f / 128.f) + 1e-6f);
#pragma unroll
        for (int e = 0; e < 8; ++e) {
          const float gv = (e & 1) ? hi_bf(zu[e >> 1]) : lo_bf(zu[e >> 1]);
          v[e] = v[e] * rstd * nw[e] * silu_f(gv);
        }
        *(uint4*)(mix + tok * 2048 + 1024 + ecol) =
            make_uint4(pack2(v[0], v[1]), pack2(v[2], v[3]), pack2(v[4], v[5]), pack2(v[6], v[7]));
      }
    }
  }
  store_state(S, 1);
  if (threadIdx.x == 0) *s_item = nextq;
}

__device__ __forceinline__ void phase3(const Params& p, char* smem, const int ctr_idx) {
  int* s_item = (int*)(smem + SC_ITEM);
  int* ctr = (int*)(p.ws + OFF_CTR) + ctr_idx;
  if (threadIdx.x == 0) *s_item = atomicAdd(ctr, 1);
  __syncthreads();
#pragma unroll 1
  for (;;) {
    const int q = *s_item;
    __syncthreads();
    if (q >= 576) break;
    int kind, stream, bb, hd, unit0;
    if (q < 128) { kind = 0; stream = 1; bb = q >> 4; hd = q & 15; unit0 = q * 8; }
    else if (q < 192) { kind = 1; stream = 1; bb = (q - 128) >> 3; hd = (q - 128) & 7; unit0 = 1024 + (q - 128) * 8; }
    else if (q < 448) { kind = 0; stream = 0; bb = (q - 192) >> 4; hd = (q - 192) & 15; unit0 = 1536 + (q - 192) * 2; }
    else { kind = 1; stream = 0; bb = (q - 448) >> 3; hd = (q - 448) & 7; unit0 = 2048 + (q - 448) * 2; }
    if (kind == 0) scan_item<128, 64, true>(p, smem, stream, bb, hd, unit0, ctr, s_item);
    else scan_item<64, 128, false>(p, smem, stream, bb, hd, unit0, ctr, s_item);
    __syncthreads();
  }
}

__device__ __forceinline__ void phase5(const Params& p) {
  const int tid = otid(), lane = tid & 63, w = tid >> 6;
  const float* mod = (const float*)(p.ws + OFF_MOD);
  const float* ob = (const float*)(p.ws + OFF_OUTB);
  const float* ssq2 = (const float*)(p.ws + OFF_SSQ2);
  for (int row = blockIdx.x * 8 + w; row < NTOK; row += gridDim.x * 8) {
    const float* xr = (row < NPR) ? p.x_prompt + (size_t)row * DM : p.x_sample + (size_t)(row - NPR) * DM;
    const int mr = (row < NPR) ? 0 : 1 + ((row - NPR) >> 10);
    float s = (lane < 16) ? ssq2[(size_t)row * 16 + lane] : 0.f;
#pragma unroll
    for (int m = 8; m >= 1; m >>= 1) s += __shfl_xor(s, m);
    s = __shfl(s, 0);
    const float rstd = rsqrtf(s * (1.f / 1024.f) + 1e-6f);
#pragma unroll
    for (int i = 0; i < 4; ++i) {
      const int k = (i * 64 + lane) * 4;
      const float4 xv = *(const float4*)(xr + k);
      const float4 ov = *(const float4*)(ob + (size_t)row * DM + k);
      const float4 nw = *(const float4*)(p.norm_post_w + k);
      const float4 gt = *(const float4*)(mod + mr * 3072 + 2048 + k);
      float4 y;
      y.x = xv.x + gt.x * ov.x * rstd * nw.x;
      y.y = xv.y + gt.y * ov.y * rstd * nw.y;
      y.z = xv.z + gt.z * ov.z * rstd * nw.z;
      y.w = xv.w + gt.w * ov.w * rstd * nw.w;
      *(float4*)(p.out + (size_t)row * DM + k) = y;
    }
  }
}

__global__ void __launch_bounds__(THREADS) fwd_megakernel(Params p) {
  extern __shared__ __attribute__((aligned(16))) char smem[];
  cg::grid_group grid = cg::this_grid();
  const int G = gridDim.x;
  const int bx = blockIdx.x;
  const int rb = (G % 8 == 0) ? (bx % 8) * (G / 8) + bx / 8 : bx;

  unsigned* gbar = (unsigned*)(p.ws + OFF_CTR + 1024);
  unsigned epoch = 0u;
  if (p.ws == nullptr) grid.sync();
  phase0(p, smem);
#if PROBE == 5
  phase0(p, smem);
  grid_barrier(gbar, epoch);
#endif
#if PROBE == 4
  for (int i = 0; i < 10; ++i) grid_barrier(gbar, epoch);
#endif
  phase1(p);
  grid_barrier(gbar, epoch);
#if PROBE == 6
  phase1(p);
  grid_barrier(gbar, epoch);
#endif
  for (int id = rb; id < 48 * 25; id += G) {
    const int band = id / 200, rem = id % 200;
    gemm_tile<0, 4>(p, (const u16*)(p.ws + OFF_H), (const u16*)(p.ws + OFF_WTIN), 1024, band * 8 + (rem & 7), rem >> 3, smem);
  }
  {
    const int nfull = (48 * 25) % G;
    const int nhelp = (nfull > 0) ? G - nfull : G;
    const int hb = (nfull > 0) ? rb - nfull : rb;
    if (hb >= 0)
      for (int q = hb; q < 512; q += nhelp)
        p0_transpose_item(p.w_out, 1024, (u16*)(p.ws + OFF_WTOUT), 2048, q / 16, q % 16, 1024, false, smem);
  }
  grid_barrier(gbar, epoch);
#if PROBE == 1
  for (int id = rb; id < 48 * 25; id += G) {
    const int band = id / 200, rem = id % 200;
    gemm_tile<0, 4>(p, (const u16*)(p.ws + OFF_H), (const u16*)(p.ws + OFF_WTIN), 1024, band * 8 + (rem & 7), rem >> 3, smem);
  }
  grid_barrier(gbar, epoch);
#endif
  phase_conv(p);
  grid_barrier(gbar, epoch);
  phase3(p, smem, 0);
#if PROBE == 2
  phase3(p, smem, 1);
#endif
  grid_barrier(gbar, epoch);
#if PROBE == 3
  for (int id = rb; id < 64 * 4; id += G)
    gemm_tile<1, 3>(p, (const u16*)(p.ws + OFF_MIX), (const u16*)(p.ws + OFF_WTOUT), 2048, id >> 2, id & 3, smem);
  grid_barrier(gbar, epoch);
#endif
  for (int id = rb; id < 64 * 4; id += G)
    gemm_tile<1, 3>(p, (const u16*)(p.ws + OFF_MIX), (const u16*)(p.ws + OFF_WTOUT), 2048, id >> 2, id & 3, smem);
  grid_barrier(gbar, epoch);
  phase5(p);
#if PROBE == 7
  phase5(p);
#endif
}

extern "C" void kernel_launch(void* const* d_in, const int* in_sizes, int n_in, void* d_out, int out_size, void* d_ws,
                              size_t ws_size, hipStream_t stream) {
  static int grid_blocks = 0;
  if (!grid_blocks) {
    int dev = 0, cus = 0, per_cu = 0;
    hipGetDevice(&dev);
    hipDeviceGetAttribute(&cus, hipDeviceAttributeMultiprocessorCount, dev);
    hipFuncSetAttribute((const void*)fwd_megakernel, hipFuncAttributeMaxDynamicSharedMemorySize, SMEM_BYTES);
    hipOccupancyMaxActiveBlocksPerMultiprocessor(&per_cu, fwd_megakernel, THREADS, SMEM_BYTES);
    if (per_cu < 1) per_cu = 1;
    grid_blocks = cus * per_cu;
  }
  Params p{};
  const float* const* in = (const float* const*)d_in;
  p.x_prompt = in[0]; p.x_sample = in[1]; p.state_ssd = in[2]; p.state_ret = in[3]; p.c = in[4]; p.c_ctx = in[5];
  p.w_mod = in[6]; p.b_mod = in[7]; p.norm_pre_w = in[8]; p.norm_post_w = in[9]; p.w_in = in[10]; p.conv_w = in[11];
  p.conv_b = in[12]; p.A_log = in[13]; p.dt_bias = in[14]; p.ssd_D = in[15]; p.ssd_norm_w = in[16]; p.ret_decay = in[17];
  p.ret_norm_w = in[18]; p.w_out = in[19];
  p.out = (float*)d_out;
  p.ws = (char*)d_ws;
  hipMemsetAsync((char*)d_ws + OFF_CTR, 0, 8192, stream);
  void* args[] = {&p};
  hipError_t e = hipLaunchCooperativeKernel((void*)fwd_megakernel, dim3(grid_blocks), dim3(THREADS), args, SMEM_BYTES, stream);
  if (e != hipSuccess) fprintf(stderr, "cooperative launch failed: %s (grid %d)\n", hipGetErrorString(e), grid_blocks);
}
```

```cpp
#include <hip/hip_runtime.h>
#include <hip/hip_cooperative_groups.h>
#include <cstdio>
namespace cg = cooperative_groups;

typedef unsigned short u16;
typedef __bf16 bf16v2 __attribute__((ext_vector_type(2)));
typedef float f32v2 __attribute__((ext_vector_type(2)));
typedef short s16x4 __attribute__((ext_vector_type(4)));
using bf16x8 = __attribute__((ext_vector_type(8))) short;
using f32x16 = __attribute__((ext_vector_type(16))) float;
using u32x4 = __attribute__((ext_vector_type(4))) unsigned;
#define DI __device__ __forceinline__
#define MFMA32(a, b, c) __builtin_amdgcn_mfma_f32_32x32x16_bf16((a), (b), (c), 0, 0, 0)

constexpr int NTOK = 12288;
constexpr int NPR = 4096;
constexpr int DM = 1024;
constexpr int INC = 6176;
constexpr int UC = 6144;
#ifndef PROBE
#define PROBE 0
#endif
constexpr int THREADS = 512;
constexpr int SMEM_BYTES = 152 * 1024;

constexpr size_t OFF_MOD = 0;
constexpr size_t OFF_ROPE = 131072;
constexpr size_t OFF_CTR = 393216;
constexpr size_t OFF_H = 524288;
constexpr size_t OFF_WTIN = OFF_H + 25165824;
constexpr size_t OFF_DUMP = OFF_H;
constexpr size_t OFF_WTOUT = OFF_WTIN + 13107200;
constexpr size_t OFF_U = OFF_WTOUT + 4194304;
constexpr size_t OFF_OUTB = OFF_U;
constexpr size_t OFF_DT = OFF_U + 150994944;
constexpr size_t OFF_MIX = OFF_DT + 1572864;
constexpr size_t OFF_SSQ = OFF_MIX + 50331648;
constexpr size_t OFF_SSQ2 = OFF_SSQ + 1572864;
constexpr size_t OFF_HALO = OFF_SSQ2 + 786432;

struct Params {
  const float *x_prompt, *x_sample, *state_ssd, *state_ret, *c, *c_ctx, *w_mod, *b_mod, *norm_pre_w, *norm_post_w,
      *w_in, *conv_w, *conv_b, *A_log, *dt_bias, *ssd_D, *ssd_norm_w, *ret_decay, *ret_norm_w, *w_out;
  float* out;
  char* ws;
};

DI float bf2f(u16 v) { return __uint_as_float(((unsigned)v) << 16); }
DI unsigned pack2(float a, float b) {
  f32v2 f = {a, b};
  bf16v2 r = __builtin_convertvector(f, bf16v2);
  return __builtin_bit_cast(unsigned, r);
}
DI u16 f2bf(float a) { return (u16)(pack2(a, 0.f) & 0xffffu); }
DI float lo_bf(unsigned v) { return __uint_as_float(v << 16); }
DI float hi_bf(unsigned v) { return __uint_as_float(v & 0xffff0000u); }
DI float silu_f(float v) { return v * __builtin_amdgcn_rcpf(1.f + __expf(-v)); }
DI int crow(int r, int h) { return (r & 3) + 8 * (r >> 2) + 4 * h; }
DI int otid() {
  int t = threadIdx.x;
  asm volatile("" : "+v"(t));
  return t;
}
DI s16x4 tr_read(const u16* p) {
  return __builtin_amdgcn_ds_read_tr16_b64_v4i16((s16x4 __attribute__((address_space(3)))*)(p));
}
DI bf16x8 cat8(s16x4 lo, s16x4 hi) { return __builtin_shufflevector(lo, hi, 0, 1, 2, 3, 4, 5, 6, 7); }
DI bf16x8 pack8(float a0, float a1, float a2, float a3, float a4, float a5, float a6, float a7) {
  uint4 v = make_uint4(pack2(a0, a1), pack2(a2, a3), pack2(a4, a5), pack2(a6, a7));
  return __builtin_bit_cast(bf16x8, v);
}


DI void grid_barrier(unsigned* bar, unsigned& epoch) {
  asm volatile("s_waitcnt vmcnt(0)" ::: "memory");
  __syncthreads();
  if (threadIdx.x == 0) {
    __builtin_amdgcn_fence(__ATOMIC_RELEASE, "agent");
    asm volatile("s_waitcnt vmcnt(0)" ::: "memory");
    const unsigned G = gridDim.x;
    const unsigned ng = (G % 8u == 0u) ? 8u : 1u;
    const unsigned gs = G / ng, g = blockIdx.x % ng, e1 = epoch + 1u;
    const unsigned old = __hip_atomic_fetch_add(&bar[64u * (1u + g)], 1u, __ATOMIC_RELAXED, __HIP_MEMORY_SCOPE_AGENT);
    if (old + 1u == gs * e1) {
      const unsigned o2 = __hip_atomic_fetch_add(&bar[0], 1u, __ATOMIC_RELAXED, __HIP_MEMORY_SCOPE_AGENT);
      if (o2 + 1u == ng * e1) __hip_atomic_fetch_add(&bar[64u * 16u], 1u, __ATOMIC_RELAXED, __HIP_MEMORY_SCOPE_AGENT);
    }
    while (__hip_atomic_load(&bar[64u * 16u], __ATOMIC_RELAXED, __HIP_MEMORY_SCOPE_AGENT) < e1) __builtin_amdgcn_s_sleep(1);
    __builtin_amdgcn_fence(__ATOMIC_ACQUIRE, "agent");
    asm volatile("s_waitcnt vmcnt(0)" ::: "memory");
  }
  __syncthreads();
  ++epoch;
}

__device__ __forceinline__ void p0_mod_item(const Params& p, char* smem, int it) {
  float* sc = (float*)smem;
  float* red = sc + 9 * 1024;
  const int tid = threadIdx.x, lane = tid & 63, w = tid >> 6;
  for (int idx = tid; idx < 9 * 1024; idx += THREADS) {
    int r = idx >> 10, k = idx & 1023;
    float v = (r == 0) ? p.c_ctx[k] : p.c[(r - 1) * 1024 + k];
    sc[idx] = v / (1.f + expf(-v));
  }
  __syncthreads();
  const int cg4 = tid & 7, kg = tid >> 3, n0 = it * 32;
  float acc[9][4];
#pragma unroll
  for (int r = 0; r < 9; ++r)
#pragma unroll
    for (int e = 0; e < 4; ++e) acc[r][e] = 0.f;
  float4 wv[16];
#pragma unroll
  for (int i = 0; i < 16; ++i) wv[i] = *(const float4*)(p.w_mod + (size_t)(kg * 16 + i) * 3072 + n0 + cg4 * 4);
#pragma unroll
  for (int i = 0; i < 16; ++i) {
#pragma unroll
    for (int r = 0; r < 9; ++r) {
      const float s = sc[r * 1024 + kg * 16 + i];
      acc[r][0] += s * wv[i].x; acc[r][1] += s * wv[i].y; acc[r][2] += s * wv[i].z; acc[r][3] += s * wv[i].w;
    }
  }
#pragma unroll
  for (int r = 0; r < 9; ++r)
#pragma unroll
    for (int e = 0; e < 4; ++e) {
      float v = acc[r][e];
      v += __shfl_xor(v, 8);
      v += __shfl_xor(v, 16);
      v += __shfl_xor(v, 32);
      acc[r][e] = v;
    }
  if (lane < 8) {
#pragma unroll
    for (int r = 0; r < 9; ++r)
#pragma unroll
      for (int e = 0; e < 4; ++e) red[(w * 9 + r) * 32 + lane * 4 + e] = acc[r][e];
  }
  __syncthreads();
  float* mod = (float*)(p.ws + OFF_MOD);
  if (tid < 9 * 32) {
    int r = tid >> 5, c2 = tid & 31;
    float s = p.b_mod[n0 + c2];
#pragma unroll
    for (int g = 0; g < 8; ++g) s += red[(g * 9 + r) * 32 + c2];
    mod[r * 3072 + n0 + c2] = s;
  }
  asm volatile("s_waitcnt vmcnt(0)" ::: "memory");
  __syncthreads();
  if (tid == 0) {
    __builtin_amdgcn_fence(__ATOMIC_RELEASE, "agent");
    asm volatile("s_waitcnt vmcnt(0)" ::: "memory");
    __hip_atomic_fetch_add((unsigned*)(p.ws + OFF_CTR) + 16, 1u, __ATOMIC_RELAXED, __HIP_MEMORY_SCOPE_AGENT);
  }
}

__device__ __forceinline__ void p0_transpose_item(const float* __restrict__ src, int lds_src, u16* __restrict__ dst, int ldk, int kt, int nt,
                                  int nvalid, bool permute, char* smem) {
  u16* T = (u16*)smem;
  const int tid = threadIdx.x, cc = tid & 63, kr = tid >> 6;
  const int n = nt * 64 + cc;
  int on = n;
  if (permute) on = (n < 3072) ? n : (n < 6144 ? n + 32 : n - 3072);
#pragma unroll
  for (int i = 0; i < 8; ++i) {
    int kk = kr + i * 8;
    float v = (n < nvalid) ? src[(size_t)(kt * 64 + kk) * lds_src + on] : 0.f;
    T[cc * 72 + kk] = f2bf(v);
  }
  __syncthreads();
  const int row = tid >> 3, c8 = tid & 7;
  uint4 v = *(const uint4*)(T + row * 72 + c8 * 8);
  *(uint4*)(dst + (size_t)(nt * 64 + row) * ldk + kt * 64 + c8 * 8) = v;
  __syncthreads();
}

__device__ __forceinline__ void phase0(const Params& p, char* smem) {
  const int tid = threadIdx.x;

  constexpr int N_MOD = 96, N_WIN = 1600, N_ROPE = 64;
  for (int it = blockIdx.x; it < N_MOD + N_WIN + N_ROPE; it += gridDim.x) {
    if (it < N_MOD) {
      p0_mod_item(p, smem, it);
    } else if (it < N_MOD + N_WIN) {
      int q = it - N_MOD;
      p0_transpose_item(p.w_in, INC, (u16*)(p.ws + OFF_WTIN), 1024, q / 100, q % 100, INC, true, smem);
    } else {
      int q = it - N_MOD - N_WIN;
      int idx = q * 512 + tid;
      int pos = idx >> 5, m = idx & 31, fm = m & 15;
      float inv = exp2f(-(float)(2 * fm) / 32.f * 13.287712379549449f);
      float coord = (float)((m < 16) ? (pos >> 6) : (pos & 63));
      float ang = coord * inv;
      float* tab = (float*)(p.ws + OFF_ROPE);
      tab[idx * 2] = __cosf(ang);
      tab[idx * 2 + 1] = __sinf(ang);
    }
  }
}

__device__ __forceinline__ void phase1(const Params& p) {
  if (threadIdx.x == 0) {
    unsigned* flag = (unsigned*)(p.ws + OFF_CTR) + 16;
    while (__hip_atomic_load(flag, __ATOMIC_RELAXED, __HIP_MEMORY_SCOPE_AGENT) < 96u) __builtin_amdgcn_s_sleep(1);
    __builtin_amdgcn_fence(__ATOMIC_ACQUIRE, "agent");
    asm volatile("s_waitcnt vmcnt(0)" ::: "memory");
  }
  __syncthreads();
  const int tid = otid(), lane = tid & 63, w = tid >> 6;
  const float* mod = (const float*)(p.ws + OFF_MOD);
  u16* hb = (u16*)(p.ws + OFF_H);
  float4 nw[4];
#pragma unroll
  for (int i = 0; i < 4; ++i) nw[i] = *(const float4*)(p.norm_pre_w + (i * 64 + lane) * 4);
  const int rstep = gridDim.x * 8;
#pragma unroll 1
  for (int row0 = blockIdx.x * 8 + w; row0 < NTOK; row0 += 2 * rstep) {
    float4 v[2][4], sh[2][4], sc[2][4];
    int rows[2];
#pragma unroll
    for (int j = 0; j < 2; ++j) {
      const int row = row0 + j * rstep;
      rows[j] = row;
      if (row < NTOK) {
        const float* xr = (row < NPR) ? p.x_prompt + (size_t)row * DM : p.x_sample + (size_t)(row - NPR) * DM;
        const int mr = (row < NPR) ? 0 : 1 + ((row - NPR) >> 10);
#pragma unroll
        for (int i = 0; i < 4; ++i) {
          const int k = (i * 64 + lane) * 4;
          v[j][i] = *(const float4*)(xr + k);
          sh[j][i] = *(const float4*)(mod + mr * 3072 + k);
          sc[j][i] = *(const float4*)(mod + mr * 3072 + 1024 + k);
        }
      }
    }
#pragma unroll
    for (int j = 0; j < 2; ++j) {
      if (rows[j] < NTOK) {
        float ss = 0.f;
#pragma unroll
        for (int i = 0; i < 4; ++i) ss += v[j][i].x * v[j][i].x + v[j][i].y * v[j][i].y + v[j][i].z * v[j][i].z + v[j][i].w * v[j][i].w;
#pragma unroll
        for (int m = 32; m >= 1; m >>= 1) ss += __shfl_xor(ss, m);
        const float rstd = rsqrtf(ss * (1.f / 1024.f) + 1e-6f);
#pragma unroll
        for (int i = 0; i < 4; ++i) {
          const int k = (i * 64 + lane) * 4;
          const float h0 = v[j][i].x * rstd * nw[i].x * (1.f + sc[j][i].x) + sh[j][i].x;
          const float h1 = v[j][i].y * rstd * nw[i].y * (1.f + sc[j][i].y) + sh[j][i].y;
          const float h2 = v[j][i].z * rstd * nw[i].z * (1.f + sc[j][i].z) + sh[j][i].z;
          const float h3 = v[j][i].w * rstd * nw[i].w * (1.f + sc[j][i].w) + sh[j][i].w;
          *(uint2*)(hb + (size_t)rows[j] * DM + k) = make_uint2(pack2(h0, h1), pack2(h2, h3));
        }
      }
    }
  }
}

template <int MODE, int MT>
__device__ __forceinline__ void gemm_tile(const Params& p, const u16* __restrict__ A, const u16* __restrict__ B, const int K, const int mt,
                          const int nt, char* smem, u32x4 (&ra0)[MT], u32x4 (&rb0)[4], const bool have0, const bool has_next,
                          const int mt_next, const int nt_next) {
  constexpr int LDT = 72;
  constexpr int STAGE = 2 * 256 * LDT;
  u16* sm = (u16*)smem;
  int tid_ = threadIdx.x;
  asm volatile("" : "+v"(tid_));
  const int tid = tid_, lane = tid & 63, w = tid >> 6, wm = w >> 2, wn = w & 3, l31 = lane & 31, h = lane >> 5;
  constexpr int AROWS = 64 * MT;
  f32x16 acc[MT][2];
#pragma unroll
  for (int mi = 0; mi < MT; ++mi)
#pragma unroll
    for (int ni = 0; ni < 2; ++ni)
#pragma unroll
      for (int r = 0; r < 16; ++r) acc[mi][ni][r] = 0.f;
  const int srow = tid >> 3, sc8 = tid & 7;
  const u16* Ag = A + (size_t)(mt * AROWS + srow) * K + sc8 * 8;
  const u16* Bg = B + (size_t)(nt * 256 + srow) * K + sc8 * 8;
  const int nk = K / 64;
#define GLOAD(RA, RB, KT)                                                                                   \
  do {                                                                                                      \
    _Pragma("unroll") for (int i = 0; i < MT; ++i) RA[i] = *(const u32x4*)(Ag + (size_t)(i * 64) * K + (KT) * 64); \
    _Pragma("unroll") for (int i = 0; i < 4; ++i) RB[i] = *(const u32x4*)(Bg + (size_t)(i * 64) * K + (KT) * 64);  \
  } while (0)
#define SSTORE(RA, RB, ST)                                                                                  \
  do {                                                                                                      \
    u16* Ad = sm + (ST) * STAGE;                                                                            \
    _Pragma("unroll") for (int i = 0; i < MT; ++i) *(u32x4*)(Ad + (srow + i * 64) * LDT + sc8 * 8) = RA[i]; \
    _Pragma("unroll") for (int i = 0; i < 4; ++i) *(u32x4*)(Ad + 256 * LDT + (srow + i * 64) * LDT + sc8 * 8) = RB[i]; \
  } while (0)
#define LDFRAG(AF, BF, KS)                                                                                  \
  do {                                                                                                      \
    _Pragma("unroll") for (int mi = 0; mi < MT; ++mi) AF[mi] = *(const bf16x8*)(Abase + mi * 32 * LDT + (KS) * 16); \
    _Pragma("unroll") for (int ni = 0; ni < 2; ++ni) BF[ni] = *(const bf16x8*)(Bbase + ni * 32 * LDT + (KS) * 16);  \
  } while (0)
#define MMA(AF, BF)                                                                                         \
  do {                                                                                                      \
    _Pragma("unroll") for (int mi = 0; mi < MT; ++mi)                                                       \
    _Pragma("unroll") for (int ni = 0; ni < 2; ++ni) acc[mi][ni] = MFMA32(BF[ni], AF[mi], acc[mi][ni]);     \
  } while (0)
  auto compute = [&](const int st, const int kt) {
    const u16* Abase = sm + st * STAGE + (wm * (MT * 32) + l31) * LDT + h * 8;
    const u16* Bbase = sm + st * STAGE + 256 * LDT + (wn * 64 + l31) * LDT + h * 8;
    bf16x8 af0[MT], bf0[2], af1[MT], bf1[2];
    LDFRAG(af0, bf0, 0);
    __builtin_amdgcn_sched_barrier(0);
    LDFRAG(af1, bf1, 1);
    __builtin_amdgcn_sched_barrier(0);
    MMA(af0, bf0);
    __builtin_amdgcn_sched_barrier(0);
    LDFRAG(af0, bf0, 2);
    __builtin_amdgcn_sched_barrier(0);
    if (kt + 1 < nk) SSTORE(ra0, rb0, st ^ 1);
    __builtin_amdgcn_sched_barrier(0);
    MMA(af1, bf1);
    __builtin_amdgcn_sched_barrier(0);
    if (kt + 2 < nk) GLOAD(ra0, rb0, kt + 2);
    __builtin_amdgcn_sched_barrier(0);
    LDFRAG(af1, bf1, 3);
    __builtin_amdgcn_sched_barrier(0);
    MMA(af0, bf0);
    __builtin_amdgcn_sched_barrier(0);
    MMA(af1, bf1);
  };
  auto rowscale = [&]() {
    const float* ssq = (const float*)(p.ws + OFF_SSQ);
#pragma unroll
    for (int mi = 0; mi < MT; ++mi) {
      const int m = mt * AROWS + wm * (MT * 32) + mi * 32 + l31;
      float s = 0.f;
#pragma unroll
      for (int q = 0; q < 4; ++q) {
        float4 t = *(const float4*)(ssq + (size_t)m * 16 + q * 4);
        s += t.x + t.y + t.z + t.w;
      }
      const float rs = rsqrtf(s * (1.f / 1024.f) + 1e-6f);
#pragma unroll
      for (int ni = 0; ni < 2; ++ni)
#pragma unroll
        for (int r = 0; r < 16; ++r) acc[mi][ni][r] *= rs;
    }
  };
  if (!have0) GLOAD(ra0, rb0, 0);
  SSTORE(ra0, rb0, 0);
  GLOAD(ra0, rb0, 1);
  __syncthreads();
#pragma unroll 1
  for (int kt = 0; kt < nk; ++kt) {
    compute(kt & 1, kt);
    if (MODE == 1 && kt == 15) rowscale();
    __syncthreads();
  }
  if (has_next) {
    const u16* Ag2 = A + (size_t)(mt_next * AROWS + srow) * K + sc8 * 8;
    const u16* Bg2 = B + (size_t)(nt_next * 256 + srow) * K + sc8 * 8;
#pragma unroll
    for (int i = 0; i < MT; ++i) ra0[i] = *(const u32x4*)(Ag2 + (size_t)(i * 64) * K);
#pragma unroll
    for (int i = 0; i < 4; ++i) rb0[i] = *(const u32x4*)(Bg2 + (size_t)(i * 64) * K);
  }
#undef GLOAD
#undef SSTORE
#undef LDFRAG
#undef MMA
  if (MODE == 0) {
    if (nt < 24) {
      u16* u = (u16*)(p.ws + OFF_U);
      u16* cst = sm + w * (128 * 72);
#pragma unroll
      for (int mi = 0; mi < MT; ++mi) {
        const int m = mt * AROWS + wm * (MT * 32) + mi * 32 + l31;
#pragma unroll
        for (int ni = 0; ni < 2; ++ni)
#pragma unroll
          for (int g = 0; g < 4; ++g) {
            const int n = nt * 256 + wn * 64 + ni * 32 + 8 * g + 4 * h;
            const uint2 pk =
                make_uint2(pack2(acc[mi][ni][4 * g], acc[mi][ni][4 * g + 1]), pack2(acc[mi][ni][4 * g + 2], acc[mi][ni][4 * g + 3]));
            *(uint2*)(cst + (mi * 32 + l31) * 72 + ni * 32 + 8 * g + 4 * h) = pk;
            if (MT == 4 && nt >= 4 && nt < 12 && ((mi == 0 && l31 == 0) || (mi == 3 && l31 == 31)))
              *(uint2*)((u16*)(p.ws + OFF_HALO) + ((size_t)(m >> 7) * 2 + (mi == 3 ? 1 : 0)) * 2048 + (n - 1024)) = pk;
          }
      }
      {
        const int rr = lane >> 3, c8 = lane & 7;
        u16* ug = u + (size_t)(mt * AROWS + wm * (MT * 32) + rr) * UC + nt * 256 + wn * 64 + c8 * 8;
#pragma unroll
        for (int i = 0; i < MT * 4; ++i) {
          const u32x4 v = *(const u32x4*)(cst + (i * 8 + rr) * 72 + c8 * 8);
          *(u32x4*)(ug + (size_t)(i * 8) * UC) = v;
        }
      }
      __syncthreads();
    } else if (wn == 0) {
      float* dt = (float*)(p.ws + OFF_DT);
#pragma unroll
      for (int mi = 0; mi < MT; ++mi) {
        const int m = mt * AROWS + wm * (MT * 32) + mi * 32 + l31;
#pragma unroll
        for (int g = 0; g < 4; ++g)
          *(float4*)(dt + (size_t)m * 32 + 8 * g + 4 * h) =
              make_float4(acc[mi][0][4 * g], acc[mi][0][4 * g + 1], acc[mi][0][4 * g + 2], acc[mi][0][4 * g + 3]);
      }
    }
  } else {
    float* ob = (float*)(p.ws + OFF_OUTB);
    float* ssq2 = (float*)(p.ws + OFF_SSQ2);
    float* cst = (float*)smem + w * (MT * 32 * 36);
    float ssum[MT];
#pragma unroll
    for (int mi = 0; mi < MT; ++mi) ssum[mi] = 0.f;
#pragma unroll
    for (int ni = 0; ni < 2; ++ni) {
#pragma unroll
      for (int mi = 0; mi < MT; ++mi)
#pragma unroll
        for (int g = 0; g < 4; ++g) {
          const float4 v = make_float4(acc[mi][ni][4 * g], acc[mi][ni][4 * g + 1], acc[mi][ni][4 * g + 2], acc[mi][ni][4 * g + 3]);
          ssum[mi] += v.x * v.x + v.y * v.y + v.z * v.z + v.w * v.w;
          *(float4*)(cst + (mi * 32 + l31) * 36 + 8 * g + 4 * h) = v;
        }
      const int rr = lane >> 3, c4 = lane & 7;
      float* og = ob + (size_t)(mt * AROWS + wm * (MT * 32) + rr) * DM + nt * 256 + wn * 64 + ni * 32 + c4 * 4;
#pragma unroll
      for (int i = 0; i < MT * 4; ++i) {
        const float4 v = *(const float4*)(cst + (i * 8 + rr) * 36 + c4 * 4);
        *(float4*)(og + (size_t)(i * 8) * DM) = v;
      }
    }
#pragma unroll
    for (int mi = 0; mi < MT; ++mi) {
      const int m = mt * AROWS + wm * (MT * 32) + mi * 32 + l31;
      float s = ssum[mi];
      s += __shfl_xor(s, 32);
      if (h == 0) ssq2[(size_t)m * 16 + nt * 4 + wn] = s;
    }
    __syncthreads();
  }
}

__device__ __forceinline__ void phase_conv(const Params& p) {
  const int tid = otid();
  const int c8 = tid & 15, rg = tid >> 4;
  u16* u = (u16*)(p.ws + OFF_U);
  const u16* halo = (const u16*)(p.ws + OFF_HALO);
#pragma unroll 1
  for (int id = blockIdx.x; id < 96 * 16; id += gridDim.x) {
    const int c = id >> 4, strip = id & 15;
    const bool first = (c < 32) ? ((c & 1) == 0) : (((c - 32) & 7) == 0);
    const bool last = (c < 32) ? ((c & 1) == 1) : (((c - 32) & 7) == 7);
    const int ch = strip * 128 + c8 * 8;
    u16* up = u + (size_t)(c * 128 + rg * 4) * UC + 1024 + ch;
    u32x4 r[6];
    const u32x4 z4 = {0u, 0u, 0u, 0u};
#pragma unroll
    for (int i = 1; i < 5; ++i) r[i] = *(const u32x4*)(up + (ptrdiff_t)(i - 1) * UC);
    if (rg > 0) r[0] = *(const u32x4*)(up - UC);
    else r[0] = first ? z4 : *(const u32x4*)(halo + ((size_t)(c - 1) * 2 + 1) * 2048 + ch);
    if (rg < 31) r[5] = *(const u32x4*)(up + 4 * UC);
    else r[5] = last ? z4 : *(const u32x4*)(halo + ((size_t)(c + 1) * 2) * 2048 + ch);
    float w0[8], w1[8], w2[8], bs[8];
#pragma unroll
    for (int e = 0; e < 8; e += 4) {
      const float4 a = *(const float4*)(p.conv_w + ch + e), b = *(const float4*)(p.conv_w + 2048 + ch + e),
                   cc = *(const float4*)(p.conv_w + 4096 + ch + e), d = *(const float4*)(p.conv_b + ch + e);
      w0[e] = a.x; w0[e + 1] = a.y; w0[e + 2] = a.z; w0[e + 3] = a.w;
      w1[e] = b.x; w1[e + 1] = b.y; w1[e + 2] = b.z; w1[e + 3] = b.w;
      w2[e] = cc.x; w2[e + 1] = cc.y; w2[e + 2] = cc.z; w2[e + 3] = cc.w;
      bs[e] = d.x; bs[e + 1] = d.y; bs[e + 2] = d.z; bs[e + 3] = d.w;
    }
    u32x4 o[4];
#pragma unroll
    for (int i = 0; i < 4; ++i) {
      const unsigned pu[4] = {r[i][0], r[i][1], r[i][2], r[i][3]}, cu[4] = {r[i + 1][0], r[i + 1][1], r[i + 1][2], r[i + 1][3]},
                     nu[4] = {r[i + 2][0], r[i + 2][1], r[i + 2][2], r[i + 2][3]};
      unsigned ov[4];
#pragma unroll
      for (int e2 = 0; e2 < 4; ++e2) {
        const float v0 = w0[2 * e2] * lo_bf(pu[e2]) + w1[2 * e2] * lo_bf(cu[e2]) + w2[2 * e2] * lo_bf(nu[e2]) + bs[2 * e2];
        const float v1 = w0[2 * e2 + 1] * hi_bf(pu[e2]) + w1[2 * e2 + 1] * hi_bf(cu[e2]) + w2[2 * e2 + 1] * hi_bf(nu[e2]) + bs[2 * e2 + 1];
        ov[e2] = pack2(silu_f(v0), silu_f(v1));
      }
      o[i] = u32x4{ov[0], ov[1], ov[2], ov[3]};
    }
    __syncthreads();
#pragma unroll
    for (int i = 0; i < 4; ++i) *(u32x4*)(up + (ptrdiff_t)i * UC) = o[i];
  }
}

constexpr int SC_ARR = 143360;
constexpr int SC_ITEM = SC_ARR + 5632;
constexpr int SC_CW = SC_ARR + 6144;

template <int W>
DI void issue_rows(const u16* __restrict__ u, u32x4* r, const int ucol, const int tok0) {
  constexpr int PC = W / 8, RS = THREADS / PC, NI = 128 / RS;
  const int tid = otid();
  const int c8 = tid % PC, r0 = tid / PC;
  const u16* base = u + (size_t)(tok0 + r0) * UC + ucol + c8 * 8;
#pragma unroll
  for (int i = 0; i < NI; ++i) r[i] = *(const u32x4*)(base + (size_t)i * (RS * UC));
}
template <int W, bool WITHV, bool WITHW>
DI void finish_rows(const u32x4* r, u16* dst, u16* dstw, const int ld, const float* wgt) {
  constexpr int PC = W / 8, RS = THREADS / PC, NI = 128 / RS;
  const int tid = otid();
  const int c8 = tid % PC, r0 = tid / PC;
#pragma unroll
  for (int i = 0; i < NI; ++i) {
    const int row = r0 + RS * i;
    if (WITHV) *(u32x4*)(dst + row * ld + c8 * 8) = r[i];
    if (WITHW) {
      const float wg = wgt[row];
      const unsigned xu[4] = {r[i][0], r[i][1], r[i][2], r[i][3]};
      unsigned o[4];
#pragma unroll
      for (int e = 0; e < 4; ++e) o[e] = pack2(lo_bf(xu[e]) * wg, hi_bf(xu[e]) * wg);
      *(uint4*)(dstw + row * ld + c8 * 8) = make_uint4(o[0], o[1], o[2], o[3]);
    }
  }
}
DI void issue_qk(const u16* __restrict__ u, u32x4* r, const int ucol, const int tok0) {
  const int tid = otid();
  const int row = tid >> 2, pp = tid & 3;
  const int pa = (pp & 1) + (pp >> 1) * 4;
  const u16* up = u + (size_t)(tok0 + row) * UC + ucol;
  r[0] = *(const u32x4*)(up + pa * 8);
  r[1] = *(const u32x4*)(up + pa * 8 + 16);
}
DI void finish_qk(const u32x4* r, const float4* tb, u16* dst, const int ld, const bool rope, const float scale) {
  const int tid = otid();
  const int row = tid >> 2, pp = tid & 3;
  const int pa = (pp & 1) + (pp >> 1) * 4, pb = pa + 2;
  const unsigned au[4] = {r[0][0], r[0][1], r[0][2], r[0][3]}, bu[4] = {r[1][0], r[1][1], r[1][2], r[1][3]};
  const float tf[16] = {tb[0].x, tb[0].y, tb[0].z, tb[0].w, tb[1].x, tb[1].y, tb[1].z, tb[1].w,
                        tb[2].x, tb[2].y, tb[2].z, tb[2].w, tb[3].x, tb[3].y, tb[3].z, tb[3].w};
  float o1[8], o2[8];
#pragma unroll
  for (int e = 0; e < 8; ++e) {
    const float x1 = (e & 1) ? hi_bf(au[e >> 1]) : lo_bf(au[e >> 1]);
    const float x2 = (e & 1) ? hi_bf(bu[e >> 1]) : lo_bf(bu[e >> 1]);
    const float cs = rope ? tf[2 * e] : 1.f, sn = rope ? tf[2 * e + 1] : 0.f;
    o1[e] = (x1 * cs - x2 * sn) * scale;
    o2[e] = (x2 * cs + x1 * sn) * scale;
  }
  *(uint4*)(dst + row * ld + pa * 8) = make_uint4(pack2(o1[0], o1[1]), pack2(o1[2], o1[3]), pack2(o1[4], o1[5]), pack2(o1[6], o1[7]));
  *(uint4*)(dst + row * ld + pb * 8) = make_uint4(pack2(o2[0], o2[1]), pack2(o2[2], o2[3]), pack2(o2[4], o2[5]), pack2(o2[6], o2[7]));
}
template <int N, int P, bool SSD>
__device__ __forceinline__ void scan_item(const Params& p, char* smem, const int stream, const int b, const int hd, const int unit0, int* qctr, int* s_item) {
  constexpr int LQ = N + 8, LV = P + 8;
  constexpr int PT = P / 64, NKS = N / 16, NT = N / 32;
  constexpr int NQ = SSD ? 4 : 2;
  u16* Qs = (u16*)smem;
  u16* Ks = Qs + 128 * LQ;
  u16* Vs = Ks + 128 * LQ;
  u16* Vw = Vs + 128 * LV;
  u16* SfT = Vw + 128 * LV;
  u16* SbT = SfT + P * LQ;
  float* dtf = (float*)(smem + SC_ARR);
  float* dtb = dtf + 128;
  float* cumf = dtb + 128;
  float* cumb = cumf + 128;
  float* ecf = cumb + 128;
  float* ecb = ecf + 128;
  float* wgt = ecb + 128;
  float* fct = (float*)(smem + SC_CW);

  int tid_ = threadIdx.x;
  asm volatile("" : "+v"(tid_));
  const int tid = tid_, lane = tid & 63, w = __builtin_amdgcn_readfirstlane(tid >> 6), l31 = lane & 31, h = lane >> 5;
  const int strip = w & 3, half = w >> 2;
  const int ntile = w % NT, ptile = w / NT;
  const int q4 = (lane & 15) >> 2, p4 = lane & 3, blk = (lane >> 4) & 1;
  const int L = stream ? 1024 : 256, nc = L / 128;
  const int seqbase = stream ? NPR + b * 1024 : b * 256;
  char* wsb = p.ws;
  asm volatile("" : "+s"(wsb));
  const u16* u = (const u16*)(wsb + OFF_U);
  const float* dtraw = (const float*)(wsb + OFF_DT);
  u16* mix = (u16*)(wsb + OFF_MIX);
  float* ssq = (float*)(wsb + OFF_SSQ);
  uint2* dump = (uint2*)(wsb + OFF_DUMP);
  const float4* ropetab = (const float4*)(wsb + OFF_ROPE);

  float Dh = 0.f, lamf = 0.f, lamb = 0.f, bias_d = 0.f, A_d = 0.f;
  const int grp = hd >> 2;
  if (SSD) {
    Dh = p.ssd_D[hd];
    const int d = w & 1;
    bias_d = p.dt_bias[d * 16 + hd];
    A_d = expf(p.A_log[d * 16 + hd]);
  } else {
    lamf = -expf(p.ret_decay[hd]);
    lamb = -expf(p.ret_decay[8 + hd]);
  }

  u32x4 rq[NQ], rk[NQ], rx[4];
  uint2 rdump[4];
  float4 rt[4];
  float rd0 = 0.f, rd1 = 0.f;

  auto issue_loads = [&](const int c, const int sweep) {
    const int tok0 = seqbase + c * 128, t0 = c * 128;
    if (sweep) {
      const uint2* dp = dump + ((size_t)(unit0 + c) * 8 + w) * 256;
#pragma unroll
      for (int g = 0; g < 4; ++g) rdump[g] = dp[g * 64 + lane];
    }
    if (SSD) {
      if (sweep) issue_rows<128>(u, rq, 2560 + grp * 128, tok0);
      issue_rows<128>(u, rk, 2048 + grp * 128, tok0);
      issue_rows<64>(u, rx, 1024 + hd * 64, tok0);
      if (w < 2) {
        const int ol = otid() & 63;
        const int sj0 = (w & 1) ? 127 - 2 * ol : 2 * ol, sj1 = (w & 1) ? 126 - 2 * ol : 2 * ol + 1;
        rd0 = dtraw[(size_t)(tok0 + sj0) * 32 + w * 16 + hd];
        rd1 = dtraw[(size_t)(tok0 + sj1) * 32 + w * 16 + hd];
      }
    } else {
      if (sweep) issue_qk(u, rq, 3072 + hd * 64, tok0);
      issue_qk(u, rk, 3584 + hd * 64, tok0);
      issue_rows<128>(u, rx, 4096 + hd * 128, tok0);
      if (stream) {
        const int ot = otid();
        const int row = ot >> 2, pp = ot & 3;
        const float4* tp = ropetab + ((size_t)(t0 + row) * 32 + (pp >> 1) * 16 + (pp & 1) * 8) / 2;
#pragma unroll
        for (int i = 0; i < 4; ++i) rt[i] = tp[i];
      }
    }
  };

  auto finish_loads = [&](const int c, const int sweep) {
    if (SSD) {
      if (w < 2) {
        const int ol = otid() & 63;
        const int sj0 = (w & 1) ? 127 - 2 * ol : 2 * ol, sj1 = (w & 1) ? 126 - 2 * ol : 2 * ol + 1;
        const float raw0 = rd0 + bias_d, raw1 = rd1 + bias_d;
        const float dt0 = fmaxf(raw0, 0.f) + __logf(1.f + __expf(-fabsf(raw0)));
        const float dt1 = fmaxf(raw1, 0.f) + __logf(1.f + __expf(-fabsf(raw1)));
        const float la0 = -dt0 * A_d, la1 = -dt1 * A_d;
        float s = la0 + la1;
#pragma unroll
        for (int d = 1; d < 64; d <<= 1) {
          const float t = __shfl_up(s, d);
          if (lane >= d) s += t;
        }
        const float tot = __shfl(s, 63);
        const float c1 = s, c0 = s - la1;
        float* dta = w ? dtb : dtf;
        float* cua = w ? cumb : cumf;
        float* eca = w ? ecb : ecf;
        dta[sj0] = dt0; dta[sj1] = dt1;
        cua[sj0] = c0; cua[sj1] = c1;
        eca[sj0] = __expf(c0); eca[sj1] = __expf(c1);
        if (w == sweep) {
          wgt[sj0] = dt0 * __expf(tot - c0);
          wgt[sj1] = dt1 * __expf(tot - c1);
        }
      }
    } else {
      if (tid < 128) {
        const float cf = (float)(tid + 1) * lamf, cb = (float)(128 - tid) * lamb;
        dtf[tid] = 1.f; dtb[tid] = 1.f;
        cumf[tid] = cf; cumb[tid] = cb;
        ecf[tid] = __expf(cf); ecb[tid] = __expf(cb);
        wgt[tid] = sweep ? __expf((float)tid * lamb) : __expf((float)(127 - tid) * lamf);
      }
    }
    __syncthreads();
    if (sweep) {
      const int ot = otid();
      const int s = ot >> 7, j = ot & 127;
      float val = 0.f;
      if (j < s * 32) val = dtf[j] * __expf(cumf[s * 32 - 1] - cumf[j]);
      else if (j >= s * 32 + 32) val = dtb[j] * __expf(cumb[s * 32 + 32] - cumb[j]);
      fct[ot] = val;
    }
    if (SSD) {
      if (sweep) finish_rows<128, true, false>(rq, Qs, nullptr, LQ, nullptr);
      finish_rows<128, true, false>(rk, Ks, nullptr, LQ, nullptr);
      if (sweep) finish_rows<64, true, true>(rx, Vs, Vw, LV, wgt);
      else finish_rows<64, false, true>(rx, Vs, Vw, LV, wgt);
    } else {
      if (sweep) finish_qk(rq, rt, Qs, LQ, stream != 0, 1.f);
      finish_qk(rk, rt, Ks, LQ, stream != 0, 0.125f);
      if (sweep) finish_rows<128, true, true>(rx, Vs, Vw, LV, wgt);
      else finish_rows<128, false, true>(rx, Vs, Vw, LV, wgt);
    }
    if (sweep) {
#pragma unroll
      for (int g = 0; g < 4; ++g) *(uint2*)(SfT + (ptile * 32 + l31) * LQ + ntile * 32 + 8 * g + 4 * h) = rdump[g];
    }
    __syncthreads();
  };

  auto state_update = [&](f32x16& S, const float dec) {
#pragma unroll
    for (int r = 0; r < 16; ++r) S[r] *= dec;
    const u16* ka0 = Ks + (8 * h + q4) * LQ + ntile * 32 + 16 * blk + 4 * p4;
    const u16* vb0 = Vw + (8 * h + q4) * LV + ptile * 32 + 16 * blk + 4 * p4;
    s16x4 ta[8][2], tb[8][2];
#pragma unroll
    for (int ks = 0; ks < 8; ++ks) {
      ta[ks][0] = tr_read(ka0 + ks * 16 * LQ);
      ta[ks][1] = tr_read(ka0 + ks * 16 * LQ + 4 * LQ);
      tb[ks][0] = tr_read(vb0 + ks * 16 * LV);
      tb[ks][1] = tr_read(vb0 + ks * 16 * LV + 4 * LV);
    }
    __builtin_amdgcn_sched_barrier(0);
#pragma unroll
    for (int ks = 0; ks < 8; ++ks) S = MFMA32(cat8(ta[ks][0], ta[ks][1]), cat8(tb[ks][0], tb[ks][1]), S);
    __builtin_amdgcn_sched_barrier(0);
  };

  auto load_state = [&](f32x16& S, const int dir) {
    if (stream) {
      const float* sp = SSD ? p.state_ssd + ((size_t)((b * 2 + dir) * 16 + hd)) * 128 * 64
                            : p.state_ret + ((size_t)((b * 2 + dir) * 8 + hd)) * 64 * 128;
#pragma unroll
      for (int r = 0; r < 16; ++r) S[r] = sp[(ntile * 32 + crow(r, h)) * P + ptile * 32 + l31];
    } else {
#pragma unroll
      for (int r = 0; r < 16; ++r) S[r] = 0.f;
    }
  };
  auto store_state = [&](const f32x16& S, const int dir) {
    if (!stream) {
      float* op = SSD ? p.out + (size_t)NTOK * DM + ((size_t)((b * 2 + dir) * 16 + hd)) * 128 * 64
                      : p.out + (size_t)NTOK * DM + (size_t)16 * 2 * 16 * 128 * 64 + ((size_t)((b * 2 + dir) * 8 + hd)) * 64 * 128;
#pragma unroll
      for (int r = 0; r < 16; ++r) op[(ntile * 32 + crow(r, h)) * P + ptile * 32 + l31] = S[r];
    }
  };

  f32x16 S;
  issue_loads(0, 0);
  load_state(S, 0);
#pragma unroll 1
  for (int c = 0; c < nc; ++c) {
    finish_loads(c, 0);
    {
      uint2* dp = dump + ((size_t)(unit0 + c) * 8 + w) * 256;
#pragma unroll
      for (int g = 0; g < 4; ++g) dp[g * 64 + lane] = make_uint2(pack2(S[4 * g], S[4 * g + 1]), pack2(S[4 * g + 2], S[4 * g + 3]));
    }
    if (c + 1 < nc) issue_loads(c + 1, 0);
    else {
      issue_loads(nc - 1, 1);
#pragma unroll
      for (int g = 0; g < 4; ++g) rdump[g] = make_uint2(pack2(S[4 * g], S[4 * g + 1]), pack2(S[4 * g + 2], S[4 * g + 3]));
    }
    state_update(S, __expf(cumf[127]));
    __syncthreads();
  }
  store_state(S, 0);

  load_state(S, 1);
#pragma unroll
  for (int g = 0; g < 4; ++g)
    *(uint2*)(SbT + (ptile * 32 + l31) * LQ + ntile * 32 + 8 * g + 4 * h) =
        make_uint2(pack2(S[4 * g], S[4 * g + 1]), pack2(S[4 * g + 2], S[4 * g + 3]));
  int nextq = 0;
#pragma unroll 1
  for (int c = nc - 1; c >= 0; --c) {
    const int tok0 = seqbase + c * 128;
    finish_loads(c, 1);
    if (c == 0 && threadIdx.x == 0) nextq = atomicAdd(qctr, 1);
    if (c > 0) issue_loads(c - 1, 1);

    const u16* qrow = Qs + (strip * 32 + l31) * LQ + h * 8;
    f32x16 Y[PT];
#pragma unroll
    for (int pt = 0; pt < PT; ++pt) {
      const int prow = (half * PT + pt) * 32 + l31;
      bf16x8 fq[NKS], fs[NKS];
      {
#pragma unroll
        for (int ks = 0; ks < NKS; ++ks) {
          fq[ks] = *(const bf16x8*)(qrow + ks * 16);
          fs[ks] = *(const bf16x8*)(SfT + prow * LQ + ks * 16 + h * 8);
        }
        __builtin_amdgcn_sched_barrier(0);
        f32x16 a1;
#pragma unroll
        for (int r = 0; r < 16; ++r) a1[r] = 0.f;
#pragma unroll
        for (int ks = 0; ks < NKS; ++ks) a1 = MFMA32(fq[ks], fs[ks], a1);
        __builtin_amdgcn_sched_barrier(0);
#pragma unroll
        for (int ks = 0; ks < NKS; ++ks) fs[ks] = *(const bf16x8*)(SbT + prow * LQ + ks * 16 + h * 8);
#pragma unroll
        for (int g = 0; g < 4; ++g) {
          const float4 ef = *(const float4*)(ecf + strip * 32 + 8 * g + 4 * h);
          Y[pt][4 * g + 0] = ef.x * a1[4 * g + 0];
          Y[pt][4 * g + 1] = ef.y * a1[4 * g + 1];
          Y[pt][4 * g + 2] = ef.z * a1[4 * g + 2];
          Y[pt][4 * g + 3] = ef.w * a1[4 * g + 3];
        }
      }
      {
        __builtin_amdgcn_sched_barrier(0);
        f32x16 a2;
#pragma unroll
        for (int r = 0; r < 16; ++r) a2[r] = 0.f;
#pragma unroll
        for (int ks = 0; ks < NKS; ++ks) a2 = MFMA32(fq[ks], fs[ks], a2);
        __builtin_amdgcn_sched_barrier(0);
#pragma unroll
        for (int g = 0; g < 4; ++g) {
          const float4 eb = *(const float4*)(ecb + strip * 32 + 8 * g + 4 * h);
          Y[pt][4 * g + 0] += eb.x * a2[4 * g + 0];
          Y[pt][4 * g + 1] += eb.y * a2[4 * g + 1];
          Y[pt][4 * g + 2] += eb.z * a2[4 * g + 2];
          Y[pt][4 * g + 3] += eb.w * a2[4 * g + 3];
        }
      }
    }
    const int ii = strip * 32 + l31;
    const float cfi = cumf[ii], cbi = cumb[ii];

#pragma unroll 1
    for (int jt = 0; jt < 4; ++jt) {
      f32x16 G;
#pragma unroll
      for (int r = 0; r < 16; ++r) G[r] = 0.f;
      s16x4 tv[PT][4];
      {
        bf16x8 fk[NKS], fq[NKS];
#pragma unroll
        for (int ks = 0; ks < NKS; ++ks) {
          fk[ks] = *(const bf16x8*)(Ks + (jt * 32 + l31) * LQ + ks * 16 + h * 8);
          fq[ks] = *(const bf16x8*)(qrow + ks * 16);
        }
        __builtin_amdgcn_sched_barrier(0);
#pragma unroll
        for (int ks = 0; ks < NKS; ++ks) G = MFMA32(fk[ks], fq[ks], G);
        __builtin_amdgcn_sched_barrier(0);
#pragma unroll
        for (int pt = 0; pt < PT; ++pt) {
          const u16* vp = Vs + (jt * 32 + 4 * h + q4) * LV + (half * PT + pt) * 32 + 16 * blk + 4 * p4;
          tv[pt][0] = tr_read(vp);
          tv[pt][1] = tr_read(vp + 8 * LV);
          tv[pt][2] = tr_read(vp + 16 * LV);
          tv[pt][3] = tr_read(vp + 24 * LV);
        }
        __builtin_amdgcn_sched_barrier(0);
      }
      if (jt == strip) {
#pragma unroll
        for (int g = 0; g < 4; ++g) {
          const int jb = jt * 32 + 8 * g + 4 * h;
          const float4 cf4 = *(const float4*)(cumf + jb), cb4 = *(const float4*)(cumb + jb);
          const float4 df4 = *(const float4*)(dtf + jb), db4 = *(const float4*)(dtb + jb);
          const float cfa[4] = {cf4.x, cf4.y, cf4.z, cf4.w}, cba[4] = {cb4.x, cb4.y, cb4.z, cb4.w};
          const float dfa[4] = {df4.x, df4.y, df4.z, df4.w}, dba[4] = {db4.x, db4.y, db4.z, db4.w};
#pragma unroll
          for (int e = 0; e < 4; ++e) {
            const int j = jb + e;
            const float tf = __expf(cfi - cfa[e]) * dfa[e];
            const float tb = __expf(cbi - cba[e]) * dba[e];
            const float m = ((ii >= j) ? tf : 0.f) + ((ii <= j) ? tb : 0.f);
            float pv = G[4 * g + e] * m;
            if (SSD && ii == j) pv += Dh;
            G[4 * g + e] = pv;
          }
        }
      } else {
        const float ei = (jt < strip) ? __expf(cfi - cumf[strip * 32 - 1]) : __expf(cbi - cumb[strip * 32 + 32]);
#pragma unroll
        for (int g = 0; g < 4; ++g) {
          const float4 f4 = *(const float4*)(fct + strip * 128 + jt * 32 + 8 * g + 4 * h);
          G[4 * g + 0] *= ei * f4.x;
          G[4 * g + 1] *= ei * f4.y;
          G[4 * g + 2] *= ei * f4.z;
          G[4 * g + 3] *= ei * f4.w;
        }
      }
      const bf16x8 pf0 = pack8(G[0], G[1], G[2], G[3], G[4], G[5], G[6], G[7]);
      const bf16x8 pf1 = pack8(G[8], G[9], G[10], G[11], G[12], G[13], G[14], G[15]);
#pragma unroll
      for (int pt = 0; pt < PT; ++pt) {
        Y[pt] = MFMA32(pf0, cat8(tv[pt][0], tv[pt][1]), Y[pt]);
        Y[pt] = MFMA32(pf1, cat8(tv[pt][2], tv[pt][3]), Y[pt]);
      }
    }
    state_update(S, __expf(cumb[0]));
    constexpr int CPR = P / 8, NIT = 128 * CPR / THREADS;
    const int ec8 = tid % CPR, er0 = tid / CPR;
    const int ecol = SSD ? hd * 64 + ec8 * 8 : hd * 128 + ec8 * 8;
    uint4 gz[NIT];
#pragma unroll
    for (int i = 0; i < NIT; ++i)
      gz[i] = *(const uint4*)(u + (size_t)(tok0 + er0 + i * (THREADS / CPR)) * UC + (SSD ? 0 : 5120) + ecol);
    const float* nwp = SSD ? p.ssd_norm_w + ecol : p.ret_norm_w + ecol;
    const float4 n0 = *(const float4*)nwp, n1 = *(const float4*)(nwp + 4);
    const float nw[8] = {n0.x, n0.y, n0.z, n0.w, n1.x, n1.y, n1.z, n1.w};
    __syncthreads();
#pragma unroll
    for (int g = 0; g < 4; ++g)
      *(uint2*)(SbT + (ptile * 32 + l31) * LQ + ntile * 32 + 8 * g + 4 * h) =
          make_uint2(pack2(S[4 * g], S[4 * g + 1]), pack2(S[4 * g + 2], S[4 * g + 3]));
    constexpr int LY = P + 4;
    float* Yst = (float*)smem;
#pragma unroll
    for (int pt = 0; pt < PT; ++pt)
#pragma unroll
      for (int r = 0; r < 16; ++r) Yst[(strip * 32 + crow(r, h)) * LY + (half * PT + pt) * 32 + l31] = Y[pt][r];
    __syncthreads();
#pragma unroll
    for (int i = 0; i < NIT; ++i) {
      const int row = er0 + i * (THREADS / CPR);
      const float* yp = Yst + row * LY + ec8 * 8;
      const float4 y0 = *(const float4*)yp, y1 = *(const float4*)(yp + 4);
      float v[8] = {y0.x, y0.y, y0.z, y0.w, y1.x, y1.y, y1.z, y1.w};
      const size_t tok = (size_t)(tok0 + row);
      const unsigned zu[4] = {gz[i].x, gz[i].y, gz[i].z, gz[i].w};
      if (SSD) {
        float sq = 0.f;
#pragma unroll
        for (int e = 0; e < 8; ++e) {
          const float z = (e & 1) ? hi_bf(zu[e >> 1]) : lo_bf(zu[e >> 1]);
          v[e] *= silu_f(z);
          sq += v[e] * v[e];
        }
        sq += __shfl_xor(sq, 1);
        sq += __shfl_xor(sq, 2);
        sq += __shfl_xor(sq, 4);
        if (ec8 == 0) ssq[tok * 16 + hd] = sq;
        *(uint4*)(mix + tok * 2048 + ecol) = make_uint4(pack2(v[0] * nw[0], v[1] * nw[1]), pack2(v[2] * nw[2], v[3] * nw[3]),
                                                        pack2(v[4] * nw[4], v[5] * nw[5]), pack2(v[6] * nw[6], v[7] * nw[7]));
      } else {
        float s = 0.f;
#pragma unroll
        for (int e = 0; e < 8; ++e) s += v[e];
        s += __shfl_xor(s, 1);
        s += __shfl_xor(s, 2);
        s += __shfl_xor(s, 4);
        s += __shfl_xor(s, 8);
        const float mean = s * (1.f / 128.f);
        float s2 = 0.f;
#pragma unroll
        for (int e = 0; e < 8; ++e) {
          v[e] -= mean;
          s2 += v[e] * v[e];
        }
        s2 += __shfl_xor(s2, 1);
        s2 += __shfl_xor(s2, 2);
        s2 += __shfl_xor(s2, 4);
        s2 += __shfl_xor(s2, 8);
        const float rstd = rsqrtf(s2 * (1.f / 128.f) + 1e-6f);
#pragma unroll
        for (int e = 0; e < 8; ++e) {
          const float gv = (e & 1) ? hi_bf(zu[e >> 1]) : lo_bf(zu[e >> 1]);
          v[e] = v[e] * rstd * nw[e] * silu_f(gv);
        }
        *(uint4*)(mix + tok * 2048 + 1024 + ecol) =
            make_uint4(pack2(v[0], v[1]), pack2(v[2], v[3]), pack2(v[4], v[5]), pack2(v[6], v[7]));
      }
    }
  }
  store_state(S, 1);
  if (threadIdx.x == 0) *s_item = nextq;
}

__device__ __forceinline__ void phase3(const Params& p, char* smem, const int ctr_idx) {
  int* s_item = (int*)(smem + SC_ITEM);
  int* ctr = (int*)(p.ws + OFF_CTR) + ctr_idx;
  if (threadIdx.x == 0) *s_item = atomicAdd(ctr, 1);
  __syncthreads();
#pragma unroll 1
  for (;;) {
    const int q = *s_item;
    __syncthreads();
    if (q >= 576) break;
    int kind, stream, bb, hd, unit0;
    if (q < 128) { kind = 0; stream = 1; bb = q >> 4; hd = q & 15; unit0 = q * 8; }
    else if (q < 192) { kind = 1; stream = 1; bb = (q - 128) >> 3; hd = (q - 128) & 7; unit0 = 1024 + (q - 128) * 8; }
    else if (q < 448) { kind = 0; stream = 0; bb = (q - 192) >> 4; hd = (q - 192) & 15; unit0 = 1536 + (q - 192) * 2; }
    else { kind = 1; stream = 0; bb = (q - 448) >> 3; hd = (q - 448) & 7; unit0 = 2048 + (q - 448) * 2; }
    if (kind == 0) scan_item<128, 64, true>(p, smem, stream, bb, hd, unit0, ctr, s_item);
    else scan_item<64, 128, false>(p, smem, stream, bb, hd, unit0, ctr, s_item);
    __syncthreads();
  }
}

__device__ __forceinline__ void phase5(const Params& p) {
  const int tid = otid(), lane = tid & 63, w = tid >> 6;
  const float* mod = (const float*)(p.ws + OFF_MOD);
  const float* ob = (const float*)(p.ws + OFF_OUTB);
  const float* ssq2 = (const float*)(p.ws + OFF_SSQ2);
  for (int row = blockIdx.x * 8 + w; row < NTOK; row += gridDim.x * 8) {
    const float* xr = (row < NPR) ? p.x_prompt + (size_t)row * DM : p.x_sample + (size_t)(row - NPR) * DM;
    const int mr = (row < NPR) ? 0 : 1 + ((row - NPR) >> 10);
    float s = (lane < 16) ? ssq2[(size_t)row * 16 + lane] : 0.f;
#pragma unroll
    for (int m = 8; m >= 1; m >>= 1) s += __shfl_xor(s, m);
    s = __shfl(s, 0);
    const float rstd = rsqrtf(s * (1.f / 1024.f) + 1e-6f);
#pragma unroll
    for (int i = 0; i < 4; ++i) {
      const int k = (i * 64 + lane) * 4;
      const float4 xv = *(const float4*)(xr + k);
      const float4 ov = *(const float4*)(ob + (size_t)row * DM + k);
      const float4 nw = *(const float4*)(p.norm_post_w + k);
      const float4 gt = *(const float4*)(mod + mr * 3072 + 2048 + k);
      float4 y;
      y.x = xv.x + gt.x * ov.x * rstd * nw.x;
      y.y = xv.y + gt.y * ov.y * rstd * nw.y;
      y.z = xv.z + gt.z * ov.z * rstd * nw.z;
      y.w = xv.w + gt.w * ov.w * rstd * nw.w;
      *(float4*)(p.out + (size_t)row * DM + k) = y;
    }
  }
}

__global__ void __launch_bounds__(THREADS) fwd_megakernel(Params p) {
  extern __shared__ __attribute__((aligned(16))) char smem[];
  cg::grid_group grid = cg::this_grid();
  const int G = gridDim.x;
  const int bx = blockIdx.x;
  const int rb = (G % 8 == 0) ? (bx % 8) * (G / 8) + bx / 8 : bx;

  unsigned* gbar = (unsigned*)(p.ws + OFF_CTR + 1024);
  unsigned epoch = 0u;
  if (p.ws == nullptr) grid.sync();
  phase0(p, smem);
#if PROBE == 5
  phase0(p, smem);
  grid_barrier(gbar, epoch);
#endif
#if PROBE == 4
  for (int i = 0; i < 10; ++i) grid_barrier(gbar, epoch);
#endif
  phase1(p);
  grid_barrier(gbar, epoch);
#if PROBE == 6
  phase1(p);
  grid_barrier(gbar, epoch);
#endif
  {
    u32x4 sra[4], srb[4];
    bool have0 = false;
    for (int id = rb; id < 48 * 25; id += G) {
      const int band = id / 200, rem = id % 200;
      const int id2 = id + G;
      const bool has2 = id2 < 48 * 25;
      const int band2 = id2 / 200, rem2 = id2 % 200;
      gemm_tile<0, 4>(p, (const u16*)(p.ws + OFF_H), (const u16*)(p.ws + OFF_WTIN), 1024, band * 8 + (rem & 7), rem >> 3, smem, sra, srb,
                      have0, has2, band2 * 8 + (rem2 & 7), rem2 >> 3);
      have0 = has2;
    }
  }
  {
    const int nfull = (48 * 25) % G;
    const int nhelp = (nfull > 0) ? G - nfull : G;
    const int hb = (nfull > 0) ? rb - nfull : rb;
    if (hb >= 0)
      for (int q = hb; q < 512; q += nhelp)
        p0_transpose_item(p.w_out, 1024, (u16*)(p.ws + OFF_WTOUT), 2048, q / 16, q % 16, 1024, false, smem);
  }
  grid_barrier(gbar, epoch);
#if PROBE == 1
  for (int id = rb; id < 48 * 25; id += G) {
    const int band = id / 200, rem = id % 200;
    u32x4 sra[4], srb[4];
    gemm_tile<0, 4>(p, (const u16*)(p.ws + OFF_H), (const u16*)(p.ws + OFF_WTIN), 1024, band * 8 + (rem & 7), rem >> 3, smem, sra, srb, false, false, 0, 0);
  }
  grid_barrier(gbar, epoch);
#endif
  phase_conv(p);
  grid_barrier(gbar, epoch);
  phase3(p, smem, 0);
#if PROBE == 2
  phase3(p, smem, 1);
#endif
  grid_barrier(gbar, epoch);
#if PROBE == 3
  for (int id = rb; id < 64 * 4; id += G)
  {
    u32x4 sra[3], srb[4];
    gemm_tile<1, 3>(p, (const u16*)(p.ws + OFF_MIX), (const u16*)(p.ws + OFF_WTOUT), 2048, id >> 2, id & 3, smem, sra, srb, false, false, 0, 0);
  }
  grid_barrier(gbar, epoch);
#endif
  for (int id = rb; id < 64 * 4; id += G)
  {
    u32x4 sra[3], srb[4];
    gemm_tile<1, 3>(p, (const u16*)(p.ws + OFF_MIX), (const u16*)(p.ws + OFF_WTOUT), 2048, id >> 2, id & 3, smem, sra, srb, false, false, 0, 0);
  }
  grid_barrier(gbar, epoch);
  phase5(p);
#if PROBE == 7
  phase5(p);
#endif
}

extern "C" void kernel_launch(void* const* d_in, const int* in_sizes, int n_in, void* d_out, int out_size, void* d_ws,
                              size_t ws_size, hipStream_t stream) {
  static int grid_blocks = 0;
  if (!grid_blocks) {
    int dev = 0, cus = 0, per_cu = 0;
    hipGetDevice(&dev);
    hipDeviceGetAttribute(&cus, hipDeviceAttributeMultiprocessorCount, dev);
    hipFuncSetAttribute((const void*)fwd_megakernel, hipFuncAttributeMaxDynamicSharedMemorySize, SMEM_BYTES);
    hipOccupancyMaxActiveBlocksPerMultiprocessor(&per_cu, fwd_megakernel, THREADS, SMEM_BYTES);
    if (per_cu < 1) per_cu = 1;
    grid_blocks = cus * per_cu;
  }
  Params p{};
  const float* const* in = (const float* const*)d_in;
  p.x_prompt = in[0]; p.x_sample = in[1]; p.state_ssd = in[2]; p.state_ret = in[3]; p.c = in[4]; p.c_ctx = in[5];
  p.w_mod = in[6]; p.b_mod = in[7]; p.norm_pre_w = in[8]; p.norm_post_w = in[9]; p.w_in = in[10]; p.conv_w = in[11];
  p.conv_b = in[12]; p.A_log = in[13]; p.dt_bias = in[14]; p.ssd_D = in[15]; p.ssd_norm_w = in[16]; p.ret_decay = in[17];
  p.ret_norm_w = in[18]; p.w_out = in[19];
  p.out = (float*)d_out;
  p.ws = (char*)d_ws;
  hipMemsetAsync((char*)d_ws + OFF_CTR, 0, 8192, stream);
  void* args[] = {&p};
  hipError_t e = hipLaunchCooperativeKernel((void*)fwd_megakernel, dim3(grid_blocks), dim3(THREADS), args, SMEM_BYTES, stream);
  if (e != hipSuccess) fprintf(stderr, "cooperative launch failed: %s (grid %d)\n", hipGetErrorString(e), grid_blocks);
}
```

```cpp
#include <hip/hip_runtime.h>
#include <hip/hip_cooperative_groups.h>
#include <cstdio>
namespace cg = cooperative_groups;

typedef unsigned short u16;
typedef __bf16 bf16v2 __attribute__((ext_vector_type(2)));
typedef float f32v2 __attribute__((ext_vector_type(2)));
typedef short s16x4 __attribute__((ext_vector_type(4)));
using bf16x8 = __attribute__((ext_vector_type(8))) short;
using f32x16 = __attribute__((ext_vector_type(16))) float;
using u32x4 = __attribute__((ext_vector_type(4))) unsigned;
#define DI __device__ __forceinline__
#define MFMA32(a, b, c) __builtin_amdgcn_mfma_f32_32x32x16_bf16((a), (b), (c), 0, 0, 0)

constexpr int NTOK = 12288;
constexpr int NPR = 4096;
constexpr int DM = 1024;
constexpr int INC = 6176;
constexpr int UC = 6144;
#ifndef PROBE
#define PROBE 0
#endif
constexpr int THREADS = 512;
constexpr int SMEM_BYTES = 152 * 1024;

constexpr size_t OFF_MOD = 0;
constexpr size_t OFF_ROPE = 131072;
constexpr size_t OFF_CTR = 393216;
constexpr size_t OFF_H = 524288;
constexpr size_t OFF_WTIN = OFF_H + 25165824;
constexpr size_t OFF_DUMP = OFF_H;
constexpr size_t OFF_WTOUT = OFF_WTIN + 13107200;
constexpr size_t OFF_U = OFF_WTOUT + 4194304;
constexpr size_t OFF_OUTB = OFF_U;
constexpr size_t OFF_DT = OFF_U + 150994944;
constexpr size_t OFF_MIX = OFF_DT + 1572864;
constexpr size_t OFF_SSQ = OFF_MIX + 50331648;
constexpr size_t OFF_SSQ2 = OFF_SSQ + 1572864;
constexpr size_t OFF_HALO = OFF_SSQ2 + 786432;

struct Params {
  const float *x_prompt, *x_sample, *state_ssd, *state_ret, *c, *c_ctx, *w_mod, *b_mod, *norm_pre_w, *norm_post_w,
      *w_in, *conv_w, *conv_b, *A_log, *dt_bias, *ssd_D, *ssd_norm_w, *ret_decay, *ret_norm_w, *w_out;
  float* out;
  char* ws;
};

DI float bf2f(u16 v) { return __uint_as_float(((unsigned)v) << 16); }
DI unsigned pack2(float a, float b) {
  f32v2 f = {a, b};
  bf16v2 r = __builtin_convertvector(f, bf16v2);
  return __builtin_bit_cast(unsigned, r);
}
DI u16 f2bf(float a) { return (u16)(pack2(a, 0.f) & 0xffffu); }
DI float lo_bf(unsigned v) { return __uint_as_float(v << 16); }
DI float hi_bf(unsigned v) { return __uint_as_float(v & 0xffff0000u); }
DI float silu_f(float v) { return v * __builtin_amdgcn_rcpf(1.f + __expf(-v)); }
DI int crow(int r, int h) { return (r & 3) + 8 * (r >> 2) + 4 * h; }
DI int otid() {
  int t = threadIdx.x;
  asm volatile("" : "+v"(t));
  return t;
}
DI s16x4 tr_read(const u16* p) {
  return __builtin_amdgcn_ds_read_tr16_b64_v4i16((s16x4 __attribute__((address_space(3)))*)(p));
}
DI bf16x8 cat8(s16x4 lo, s16x4 hi) { return __builtin_shufflevector(lo, hi, 0, 1, 2, 3, 4, 5, 6, 7); }
DI bf16x8 pack8(float a0, float a1, float a2, float a3, float a4, float a5, float a6, float a7) {
  uint4 v = make_uint4(pack2(a0, a1), pack2(a2, a3), pack2(a4, a5), pack2(a6, a7));
  return __builtin_bit_cast(bf16x8, v);
}


DI void grid_barrier(unsigned* bar, unsigned& epoch) {
  asm volatile("s_waitcnt vmcnt(0)" ::: "memory");
  __syncthreads();
  if (threadIdx.x == 0) {
    __builtin_amdgcn_fence(__ATOMIC_RELEASE, "agent");
    asm volatile("s_waitcnt vmcnt(0)" ::: "memory");
    const unsigned G = gridDim.x;
    const unsigned ng = (G % 8u == 0u) ? 8u : 1u;
    const unsigned gs = G / ng, g = blockIdx.x % ng, e1 = epoch + 1u;
    const unsigned old = __hip_atomic_fetch_add(&bar[64u * (1u + g)], 1u, __ATOMIC_RELAXED, __HIP_MEMORY_SCOPE_AGENT);
    if (old + 1u == gs * e1) {
      const unsigned o2 = __hip_atomic_fetch_add(&bar[0], 1u, __ATOMIC_RELAXED, __HIP_MEMORY_SCOPE_AGENT);
      if (o2 + 1u == ng * e1) __hip_atomic_fetch_add(&bar[64u * 16u], 1u, __ATOMIC_RELAXED, __HIP_MEMORY_SCOPE_AGENT);
    }
    while (__hip_atomic_load(&bar[64u * 16u], __ATOMIC_RELAXED, __HIP_MEMORY_SCOPE_AGENT) < e1) __builtin_amdgcn_s_sleep(1);
    __builtin_amdgcn_fence(__ATOMIC_ACQUIRE, "agent");
    asm volatile("s_waitcnt vmcnt(0)" ::: "memory");
  }
  __syncthreads();
  ++epoch;
}

__device__ __forceinline__ void p0_mod_item(const Params& p, char* smem, int it) {
  float* sc = (float*)smem;
  float* red = sc + 9 * 1024;
  const int tid = threadIdx.x, lane = tid & 63, w = tid >> 6;
  for (int idx = tid; idx < 9 * 1024; idx += THREADS) {
    int r = idx >> 10, k = idx & 1023;
    float v = (r == 0) ? p.c_ctx[k] : p.c[(r - 1) * 1024 + k];
    sc[idx] = v / (1.f + expf(-v));
  }
  __syncthreads();
  const int cg4 = tid & 7, kg = tid >> 3, n0 = it * 32;
  float acc[9][4];
#pragma unroll
  for (int r = 0; r < 9; ++r)
#pragma unroll
    for (int e = 0; e < 4; ++e) acc[r][e] = 0.f;
  float4 wv[16];
#pragma unroll
  for (int i = 0; i < 16; ++i) wv[i] = *(const float4*)(p.w_mod + (size_t)(kg * 16 + i) * 3072 + n0 + cg4 * 4);
#pragma unroll
  for (int i = 0; i < 16; ++i) {
#pragma unroll
    for (int r = 0; r < 9; ++r) {
      const float s = sc[r * 1024 + kg * 16 + i];
      acc[r][0] += s * wv[i].x; acc[r][1] += s * wv[i].y; acc[r][2] += s * wv[i].z; acc[r][3] += s * wv[i].w;
    }
  }
#pragma unroll
  for (int r = 0; r < 9; ++r)
#pragma unroll
    for (int e = 0; e < 4; ++e) {
      float v = acc[r][e];
      v += __shfl_xor(v, 8);
      v += __shfl_xor(v, 16);
      v += __shfl_xor(v, 32);
      acc[r][e] = v;
    }
  if (lane < 8) {
#pragma unroll
    for (int r = 0; r < 9; ++r)
#pragma unroll
      for (int e = 0; e < 4; ++e) red[(w * 9 + r) * 32 + lane * 4 + e] = acc[r][e];
  }
  __syncthreads();
  float* mod = (float*)(p.ws + OFF_MOD);
  if (tid < 9 * 32) {
    int r = tid >> 5, c2 = tid & 31;
    float s = p.b_mod[n0 + c2];
#pragma unroll
    for (int g = 0; g < 8; ++g) s += red[(g * 9 + r) * 32 + c2];
    mod[r * 3072 + n0 + c2] = s;
  }
  asm volatile("s_waitcnt vmcnt(0)" ::: "memory");
  __syncthreads();
  if (tid == 0) {
    __builtin_amdgcn_fence(__ATOMIC_RELEASE, "agent");
    asm volatile("s_waitcnt vmcnt(0)" ::: "memory");
    __hip_atomic_fetch_add((unsigned*)(p.ws + OFF_CTR) + 16, 1u, __ATOMIC_RELAXED, __HIP_MEMORY_SCOPE_AGENT);
  }
}

__device__ __forceinline__ void p0_transpose_item(const float* __restrict__ src, int lds_src, u16* __restrict__ dst, int ldk, int kt, int nt,
                                  int nvalid, bool permute, char* smem) {
  u16* T = (u16*)smem;
  const int tid = threadIdx.x, cc = tid & 63, kr = tid >> 6;
  const int n = nt * 64 + cc;
  int on = n;
  if (permute) on = (n < 3072) ? n : (n < 6144 ? n + 32 : n - 3072);
#pragma unroll
  for (int i = 0; i < 8; ++i) {
    int kk = kr + i * 8;
    float v = (n < nvalid) ? src[(size_t)(kt * 64 + kk) * lds_src + on] : 0.f;
    T[cc * 72 + kk] = f2bf(v);
  }
  __syncthreads();
  const int row = tid >> 3, c8 = tid & 7;
  uint4 v = *(const uint4*)(T + row * 72 + c8 * 8);
  *(uint4*)(dst + (size_t)(nt * 64 + row) * ldk + kt * 64 + c8 * 8) = v;
  __syncthreads();
}

__device__ __forceinline__ void phase0(const Params& p, char* smem) {
  const int tid = threadIdx.x;

  constexpr int N_MOD = 96, N_WIN = 1600, N_ROPE = 64;
  for (int it = blockIdx.x; it < N_MOD + N_WIN + N_ROPE; it += gridDim.x) {
    if (it < N_MOD) {
      p0_mod_item(p, smem, it);
    } else if (it < N_MOD + N_WIN) {
      int q = it - N_MOD;
      p0_transpose_item(p.w_in, INC, (u16*)(p.ws + OFF_WTIN), 1024, q / 100, q % 100, INC, true, smem);
    } else {
      int q = it - N_MOD - N_WIN;
      int idx = q * 512 + tid;
      int pos = idx >> 5, m = idx & 31, fm = m & 15;
      float inv = exp2f(-(float)(2 * fm) / 32.f * 13.287712379549449f);
      float coord = (float)((m < 16) ? (pos >> 6) : (pos & 63));
      float ang = coord * inv;
      float* tab = (float*)(p.ws + OFF_ROPE);
      tab[idx * 2] = __cosf(ang);
      tab[idx * 2 + 1] = __sinf(ang);
    }
  }
}

__device__ __forceinline__ void phase1(const Params& p) {
  if (threadIdx.x == 0) {
    unsigned* flag = (unsigned*)(p.ws + OFF_CTR) + 16;
    while (__hip_atomic_load(flag, __ATOMIC_RELAXED, __HIP_MEMORY_SCOPE_AGENT) < 96u) __builtin_amdgcn_s_sleep(1);
    __builtin_amdgcn_fence(__ATOMIC_ACQUIRE, "agent");
    asm volatile("s_waitcnt vmcnt(0)" ::: "memory");
  }
  __syncthreads();
  const int tid = otid(), lane = tid & 63, w = tid >> 6;
  const float* mod = (const float*)(p.ws + OFF_MOD);
  u16* hb = (u16*)(p.ws + OFF_H);
  float4 nw[4];
#pragma unroll
  for (int i = 0; i < 4; ++i) nw[i] = *(const float4*)(p.norm_pre_w + (i * 64 + lane) * 4);
  const int rstep = gridDim.x * 8;
#pragma unroll 1
  for (int row0 = blockIdx.x * 8 + w; row0 < NTOK; row0 += 2 * rstep) {
    float4 v[2][4], sh[2][4], sc[2][4];
    int rows[2];
#pragma unroll
    for (int j = 0; j < 2; ++j) {
      const int row = row0 + j * rstep;
      rows[j] = row;
      if (row < NTOK) {
        const float* xr = (row < NPR) ? p.x_prompt + (size_t)row * DM : p.x_sample + (size_t)(row - NPR) * DM;
        const int mr = (row < NPR) ? 0 : 1 + ((row - NPR) >> 10);
#pragma unroll
        for (int i = 0; i < 4; ++i) {
          const int k = (i * 64 + lane) * 4;
          v[j][i] = *(const float4*)(xr + k);
          sh[j][i] = *(const float4*)(mod + mr * 3072 + k);
          sc[j][i] = *(const float4*)(mod + mr * 3072 + 1024 + k);
        }
      }
    }
#pragma unroll
    for (int j = 0; j < 2; ++j) {
      if (rows[j] < NTOK) {
        float ss = 0.f;
#pragma unroll
        for (int i = 0; i < 4; ++i) ss += v[j][i].x * v[j][i].x + v[j][i].y * v[j][i].y + v[j][i].z * v[j][i].z + v[j][i].w * v[j][i].w;
#pragma unroll
        for (int m = 32; m >= 1; m >>= 1) ss += __shfl_xor(ss, m);
        const float rstd = rsqrtf(ss * (1.f / 1024.f) + 1e-6f);
#pragma unroll
        for (int i = 0; i < 4; ++i) {
          const int k = (i * 64 + lane) * 4;
          const float h0 = v[j][i].x * rstd * nw[i].x * (1.f + sc[j][i].x) + sh[j][i].x;
          const float h1 = v[j][i].y * rstd * nw[i].y * (1.f + sc[j][i].y) + sh[j][i].y;
          const float h2 = v[j][i].z * rstd * nw[i].z * (1.f + sc[j][i].z) + sh[j][i].z;
          const float h3 = v[j][i].w * rstd * nw[i].w * (1.f + sc[j][i].w) + sh[j][i].w;
          *(uint2*)(hb + (size_t)rows[j] * DM + k) = make_uint2(pack2(h0, h1), pack2(h2, h3));
        }
      }
    }
  }
}

template <int MODE, int MT>
__device__ __forceinline__ void gemm_tile(const Params& p, const u16* __restrict__ A, const u16* __restrict__ B, const int K, const int mt,
                          const int nt, char* smem, u32x4 (&ra0)[MT], u32x4 (&rb0)[4], const bool have0, const bool has_next,
                          const int mt_next, const int nt_next) {
  constexpr int LDT = 72;
  constexpr int STAGE = 2 * 256 * LDT;
  u16* sm = (u16*)smem;
  int tid_ = threadIdx.x;
  asm volatile("" : "+v"(tid_));
  const int tid = tid_, lane = tid & 63, w = tid >> 6, wm = w >> 2, wn = w & 3, l31 = lane & 31, h = lane >> 5;
  constexpr int AROWS = 64 * MT;
  f32x16 acc[MT][2];
#pragma unroll
  for (int mi = 0; mi < MT; ++mi)
#pragma unroll
    for (int ni = 0; ni < 2; ++ni)
#pragma unroll
      for (int r = 0; r < 16; ++r) acc[mi][ni][r] = 0.f;
  const int srow = tid >> 3, sc8 = tid & 7;
  const u16* Ag = A + (size_t)(mt * AROWS + srow) * K + sc8 * 8;
  const u16* Bg = B + (size_t)(nt * 256 + srow) * K + sc8 * 8;
  const int nk = K / 64;
#define GLOAD(RA, RB, KT)                                                                                   \
  do {                                                                                                      \
    _Pragma("unroll") for (int i = 0; i < MT; ++i) RA[i] = *(const u32x4*)(Ag + (size_t)(i * 64) * K + (KT) * 64); \
    _Pragma("unroll") for (int i = 0; i < 4; ++i) RB[i] = *(const u32x4*)(Bg + (size_t)(i * 64) * K + (KT) * 64);  \
  } while (0)
#define SSTORE(RA, RB, ST)                                                                                  \
  do {                                                                                                      \
    u16* Ad = sm + (ST) * STAGE;                                                                            \
    _Pragma("unroll") for (int i = 0; i < MT; ++i) *(u32x4*)(Ad + (srow + i * 64) * LDT + sc8 * 8) = RA[i]; \
    _Pragma("unroll") for (int i = 0; i < 4; ++i) *(u32x4*)(Ad + 256 * LDT + (srow + i * 64) * LDT + sc8 * 8) = RB[i]; \
  } while (0)
#define LDFRAG(AF, BF, KS)                                                                                  \
  do {                                                                                                      \
    _Pragma("unroll") for (int mi = 0; mi < MT; ++mi) AF[mi] = *(const bf16x8*)(Abase + mi * 32 * LDT + (KS) * 16); \
    _Pragma("unroll") for (int ni = 0; ni < 2; ++ni) BF[ni] = *(const bf16x8*)(Bbase + ni * 32 * LDT + (KS) * 16);  \
  } while (0)
#define MMA(AF, BF)                                                                                         \
  do {                                                                                                      \
    _Pragma("unroll") for (int mi = 0; mi < MT; ++mi)                                                       \
    _Pragma("unroll") for (int ni = 0; ni < 2; ++ni) acc[mi][ni] = MFMA32(BF[ni], AF[mi], acc[mi][ni]);     \
  } while (0)
  auto compute = [&](const int st, const int kt) {
    const u16* Abase = sm + st * STAGE + (wm * (MT * 32) + l31) * LDT + h * 8;
    const u16* Bbase = sm + st * STAGE + 256 * LDT + (wn * 64 + l31) * LDT + h * 8;
    bf16x8 af0[MT], bf0[2], af1[MT], bf1[2];
    LDFRAG(af0, bf0, 0);
    __builtin_amdgcn_sched_barrier(0);
    LDFRAG(af1, bf1, 1);
    __builtin_amdgcn_sched_barrier(0);
    MMA(af0, bf0);
    __builtin_amdgcn_sched_barrier(0);
    LDFRAG(af0, bf0, 2);
    __builtin_amdgcn_sched_barrier(0);
    if (kt + 1 < nk) SSTORE(ra0, rb0, st ^ 1);
    __builtin_amdgcn_sched_barrier(0);
    MMA(af1, bf1);
    __builtin_amdgcn_sched_barrier(0);
    if (kt + 2 < nk) GLOAD(ra0, rb0, kt + 2);
    __builtin_amdgcn_sched_barrier(0);
    LDFRAG(af1, bf1, 3);
    __builtin_amdgcn_sched_barrier(0);
    MMA(af0, bf0);
    __builtin_amdgcn_sched_barrier(0);
    MMA(af1, bf1);
  };
  auto rowscale = [&]() {
    const float* ssq = (const float*)(p.ws + OFF_SSQ);
#pragma unroll
    for (int mi = 0; mi < MT; ++mi) {
      const int m = mt * AROWS + wm * (MT * 32) + mi * 32 + l31;
      float s = 0.f;
#pragma unroll
      for (int q = 0; q < 4; ++q) {
        float4 t = *(const float4*)(ssq + (size_t)m * 16 + q * 4);
        s += t.x + t.y + t.z + t.w;
      }
      const float rs = rsqrtf(s * (1.f / 1024.f) + 1e-6f);
#pragma unroll
      for (int ni = 0; ni < 2; ++ni)
#pragma unroll
        for (int r = 0; r < 16; ++r) acc[mi][ni][r] *= rs;
    }
  };
  if (!have0) GLOAD(ra0, rb0, 0);
  SSTORE(ra0, rb0, 0);
  GLOAD(ra0, rb0, 1);
  __syncthreads();
#pragma unroll 1
  for (int kt = 0; kt < nk; ++kt) {
    compute(kt & 1, kt);
    if (MODE == 1 && kt == 15) rowscale();
    __syncthreads();
  }
  if (has_next) {
    const u16* Ag2 = A + (size_t)(mt_next * AROWS + srow) * K + sc8 * 8;
    const u16* Bg2 = B + (size_t)(nt_next * 256 + srow) * K + sc8 * 8;
#pragma unroll
    for (int i = 0; i < MT; ++i) ra0[i] = *(const u32x4*)(Ag2 + (size_t)(i * 64) * K);
#pragma unroll
    for (int i = 0; i < 4; ++i) rb0[i] = *(const u32x4*)(Bg2 + (size_t)(i * 64) * K);
  }
#undef GLOAD
#undef SSTORE
#undef LDFRAG
#undef MMA
  if (MODE == 0) {
    if (nt < 24) {
      u16* u = (u16*)(p.ws + OFF_U);
      u16* cst = sm + w * (128 * 72);
#pragma unroll
      for (int mi = 0; mi < MT; ++mi) {
        const int m = mt * AROWS + wm * (MT * 32) + mi * 32 + l31;
#pragma unroll
        for (int ni = 0; ni < 2; ++ni)
#pragma unroll
          for (int g = 0; g < 4; ++g) {
            const int n = nt * 256 + wn * 64 + ni * 32 + 8 * g + 4 * h;
            const uint2 pk =
                make_uint2(pack2(acc[mi][ni][4 * g], acc[mi][ni][4 * g + 1]), pack2(acc[mi][ni][4 * g + 2], acc[mi][ni][4 * g + 3]));
            *(uint2*)(cst + (mi * 32 + l31) * 72 + ni * 32 + 8 * g + 4 * h) = pk;
            if (MT == 4 && nt >= 4 && nt < 12 && ((mi == 0 && l31 == 0) || (mi == 3 && l31 == 31)))
              *(uint2*)((u16*)(p.ws + OFF_HALO) + ((size_t)(m >> 7) * 2 + (mi == 3 ? 1 : 0)) * 2048 + (n - 1024)) = pk;
          }
      }
      {
        const int rr = lane >> 3, c8 = lane & 7;
        u16* ug = u + (size_t)(mt * AROWS + wm * (MT * 32) + rr) * UC + nt * 256 + wn * 64 + c8 * 8;
#pragma unroll
        for (int i = 0; i < MT * 4; ++i) {
          const u32x4 v = *(const u32x4*)(cst + (i * 8 + rr) * 72 + c8 * 8);
          *(u32x4*)(ug + (size_t)(i * 8) * UC) = v;
        }
      }
      __syncthreads();
    } else if (wn == 0) {
      float* dt = (float*)(p.ws + OFF_DT);
#pragma unroll
      for (int mi = 0; mi < MT; ++mi) {
        const int m = mt * AROWS + wm * (MT * 32) + mi * 32 + l31;
#pragma unroll
        for (int g = 0; g < 4; ++g)
          *(float4*)(dt + (size_t)m * 32 + 8 * g + 4 * h) =
              make_float4(acc[mi][0][4 * g], acc[mi][0][4 * g + 1], acc[mi][0][4 * g + 2], acc[mi][0][4 * g + 3]);
      }
    }
  } else {
    float* ob = (float*)(p.ws + OFF_OUTB);
    float* ssq2 = (float*)(p.ws + OFF_SSQ2);
    float* cst = (float*)smem + w * (MT * 32 * 36);
    float ssum[MT];
#pragma unroll
    for (int mi = 0; mi < MT; ++mi) ssum[mi] = 0.f;
#pragma unroll
    for (int ni = 0; ni < 2; ++ni) {
#pragma unroll
      for (int mi = 0; mi < MT; ++mi)
#pragma unroll
        for (int g = 0; g < 4; ++g) {
          const float4 v = make_float4(acc[mi][ni][4 * g], acc[mi][ni][4 * g + 1], acc[mi][ni][4 * g + 2], acc[mi][ni][4 * g + 3]);
          ssum[mi] += v.x * v.x + v.y * v.y + v.z * v.z + v.w * v.w;
          *(float4*)(cst + (mi * 32 + l31) * 36 + 8 * g + 4 * h) = v;
        }
      const int rr = lane >> 3, c4 = lane & 7;
      float* og = ob + (size_t)(mt * AROWS + wm * (MT * 32) + rr) * DM + nt * 256 + wn * 64 + ni * 32 + c4 * 4;
#pragma unroll
      for (int i = 0; i < MT * 4; ++i) {
        const float4 v = *(const float4*)(cst + (i * 8 + rr) * 36 + c4 * 4);
        *(float4*)(og + (size_t)(i * 8) * DM) = v;
      }
    }
#pragma unroll
    for (int mi = 0; mi < MT; ++mi) {
      const int m = mt * AROWS + wm * (MT * 32) + mi * 32 + l31;
      float s = ssum[mi];
      s += __shfl_xor(s, 32);
      if (h == 0) ssq2[(size_t)m * 16 + nt * 4 + wn] = s;
    }
    __syncthreads();
  }
}

__device__ __forceinline__ void phase_conv(const Params& p) {
  const int tid = otid();
  const int c8 = tid & 15, rg = tid >> 4;
  u16* u = (u16*)(p.ws + OFF_U);
  const u16* halo = (const u16*)(p.ws + OFF_HALO);
#pragma unroll 1
  for (int id = blockIdx.x; id < 96 * 16; id += gridDim.x) {
    const int c = id >> 4, strip = id & 15;
    const bool first = (c < 32) ? ((c & 1) == 0) : (((c - 32) & 7) == 0);
    const bool last = (c < 32) ? ((c & 1) == 1) : (((c - 32) & 7) == 7);
    const int ch = strip * 128 + c8 * 8;
    u16* up = u + (size_t)(c * 128 + rg * 4) * UC + 1024 + ch;
    u32x4 r[6];
    const u32x4 z4 = {0u, 0u, 0u, 0u};
#pragma unroll
    for (int i = 1; i < 5; ++i) r[i] = *(const u32x4*)(up + (ptrdiff_t)(i - 1) * UC);
    if (rg > 0) r[0] = *(const u32x4*)(up - UC);
    else r[0] = first ? z4 : *(const u32x4*)(halo + ((size_t)(c - 1) * 2 + 1) * 2048 + ch);
    if (rg < 31) r[5] = *(const u32x4*)(up + 4 * UC);
    else r[5] = last ? z4 : *(const u32x4*)(halo + ((size_t)(c + 1) * 2) * 2048 + ch);
    float w0[8], w1[8], w2[8], bs[8];
#pragma unroll
    for (int e = 0; e < 8; e += 4) {
      const float4 a = *(const float4*)(p.conv_w + ch + e), b = *(const float4*)(p.conv_w + 2048 + ch + e),
                   cc = *(const float4*)(p.conv_w + 4096 + ch + e), d = *(const float4*)(p.conv_b + ch + e);
      w0[e] = a.x; w0[e + 1] = a.y; w0[e + 2] = a.z; w0[e + 3] = a.w;
      w1[e] = b.x; w1[e + 1] = b.y; w1[e + 2] = b.z; w1[e + 3] = b.w;
      w2[e] = cc.x; w2[e + 1] = cc.y; w2[e + 2] = cc.z; w2[e + 3] = cc.w;
      bs[e] = d.x; bs[e + 1] = d.y; bs[e + 2] = d.z; bs[e + 3] = d.w;
    }
    u32x4 o[4];
#pragma unroll
    for (int i = 0; i < 4; ++i) {
      const unsigned pu[4] = {r[i][0], r[i][1], r[i][2], r[i][3]}, cu[4] = {r[i + 1][0], r[i + 1][1], r[i + 1][2], r[i + 1][3]},
                     nu[4] = {r[i + 2][0], r[i + 2][1], r[i + 2][2], r[i + 2][3]};
      unsigned ov[4];
#pragma unroll
      for (int e2 = 0; e2 < 4; ++e2) {
        const float v0 = w0[2 * e2] * lo_bf(pu[e2]) + w1[2 * e2] * lo_bf(cu[e2]) + w2[2 * e2] * lo_bf(nu[e2]) + bs[2 * e2];
        const float v1 = w0[2 * e2 + 1] * hi_bf(pu[e2]) + w1[2 * e2 + 1] * hi_bf(cu[e2]) + w2[2 * e2 + 1] * hi_bf(nu[e2]) + bs[2 * e2 + 1];
        ov[e2] = pack2(silu_f(v0), silu_f(v1));
      }
      o[i] = u32x4{ov[0], ov[1], ov[2], ov[3]};
    }
    __syncthreads();
#pragma unroll
    for (int i = 0; i < 4; ++i) *(u32x4*)(up + (ptrdiff_t)i * UC) = o[i];
  }
}

constexpr int SC_ARR = 143360;
constexpr int SC_ITEM = SC_ARR + 5632;
constexpr int SC_CW = SC_ARR + 6144;

template <int W>
DI void issue_rows(const u16* __restrict__ u, u32x4* r, const int ucol, const int tok0) {
  constexpr int PC = W / 8, RS = THREADS / PC, NI = 128 / RS;
  const int tid = otid();
  const int c8 = tid % PC, r0 = tid / PC;
  const u16* base = u + (size_t)(tok0 + r0) * UC + ucol + c8 * 8;
#pragma unroll
  for (int i = 0; i < NI; ++i) r[i] = *(const u32x4*)(base + (size_t)i * (RS * UC));
}
template <int W, bool WITHV, bool WITHW>
DI void finish_rows(const u32x4* r, u16* dst, u16* dstw, const int ld, const float* wgt) {
  constexpr int PC = W / 8, RS = THREADS / PC, NI = 128 / RS;
  const int tid = otid();
  const int c8 = tid % PC, r0 = tid / PC;
#pragma unroll
  for (int i = 0; i < NI; ++i) {
    const int row = r0 + RS * i;
    if (WITHV) *(u32x4*)(dst + row * ld + c8 * 8) = r[i];
    if (WITHW) {
      const float wg = wgt[row];
      const unsigned xu[4] = {r[i][0], r[i][1], r[i][2], r[i][3]};
      unsigned o[4];
#pragma unroll
      for (int e = 0; e < 4; ++e) o[e] = pack2(lo_bf(xu[e]) * wg, hi_bf(xu[e]) * wg);
      *(uint4*)(dstw + row * ld + c8 * 8) = make_uint4(o[0], o[1], o[2], o[3]);
    }
  }
}
DI void issue_qk(const u16* __restrict__ u, u32x4* r, const int ucol, const int tok0) {
  const int tid = otid();
  const int row = tid >> 2, pp = tid & 3;
  const int pa = (pp & 1) + (pp >> 1) * 4;
  const u16* up = u + (size_t)(tok0 + row) * UC + ucol;
  r[0] = *(const u32x4*)(up + pa * 8);
  r[1] = *(const u32x4*)(up + pa * 8 + 16);
}
DI void finish_qk(const u32x4* r, const float4* tb, u16* dst, const int ld, const bool rope, const float scale) {
  const int tid = otid();
  const int row = tid >> 2, pp = tid & 3;
  const int pa = (pp & 1) + (pp >> 1) * 4, pb = pa + 2;
  const unsigned au[4] = {r[0][0], r[0][1], r[0][2], r[0][3]}, bu[4] = {r[1][0], r[1][1], r[1][2], r[1][3]};
  const float tf[16] = {tb[0].x, tb[0].y, tb[0].z, tb[0].w, tb[1].x, tb[1].y, tb[1].z, tb[1].w,
                        tb[2].x, tb[2].y, tb[2].z, tb[2].w, tb[3].x, tb[3].y, tb[3].z, tb[3].w};
  float o1[8], o2[8];
#pragma unroll
  for (int e = 0; e < 8; ++e) {
    const float x1 = (e & 1) ? hi_bf(au[e >> 1]) : lo_bf(au[e >> 1]);
    const float x2 = (e & 1) ? hi_bf(bu[e >> 1]) : lo_bf(bu[e >> 1]);
    const float cs = rope ? tf[2 * e] : 1.f, sn = rope ? tf[2 * e + 1] : 0.f;
    o1[e] = (x1 * cs - x2 * sn) * scale;
    o2[e] = (x2 * cs + x1 * sn) * scale;
  }
  *(uint4*)(dst + row * ld + pa * 8) = make_uint4(pack2(o1[0], o1[1]), pack2(o1[2], o1[3]), pack2(o1[4], o1[5]), pack2(o1[6], o1[7]));
  *(uint4*)(dst + row * ld + pb * 8) = make_uint4(pack2(o2[0], o2[1]), pack2(o2[2], o2[3]), pack2(o2[4], o2[5]), pack2(o2[6], o2[7]));
}
template <int N, int P, bool SSD>
__device__ __forceinline__ void scan_item(const Params& p, char* smem, const int stream, const int b, const int hd, const int unit0, int* qctr, int* s_item) {
  constexpr int LQ = N + 8, LV = P + 8;
  constexpr int PT = P / 64, NKS = N / 16, NT = N / 32;
  constexpr int NQ = SSD ? 4 : 2;
  u16* Qs = (u16*)smem;
  u16* Ks = Qs + 128 * LQ;
  u16* Vs = Ks + 128 * LQ;
  u16* Vw = Vs + 128 * LV;
  u16* SfT = Vw + 128 * LV;
  u16* SbT = SfT + P * LQ;
  float* dtf = (float*)(smem + SC_ARR);
  float* dtb = dtf + 128;
  float* cumf = dtb + 128;
  float* cumb = cumf + 128;
  float* ecf = cumb + 128;
  float* ecb = ecf + 128;
  float* wgt = ecb + 128;
  float* fct = (float*)(smem + SC_CW);

  int tid_ = threadIdx.x;
  asm volatile("" : "+v"(tid_));
  const int tid = tid_, lane = tid & 63, w = __builtin_amdgcn_readfirstlane(tid >> 6), l31 = lane & 31, h = lane >> 5;
  const int strip = w & 3, half = w >> 2;
  const int ntile = w % NT, ptile = w / NT;
  const int q4 = (lane & 15) >> 2, p4 = lane & 3, blk = (lane >> 4) & 1;
  const int L = stream ? 1024 : 256, nc = L / 128;
  const int seqbase = stream ? NPR + b * 1024 : b * 256;
  char* wsb = p.ws;
  asm volatile("" : "+s"(wsb));
  const u16* u = (const u16*)(wsb + OFF_U);
  const float* dtraw = (const float*)(wsb + OFF_DT);
  u16* mix = (u16*)(wsb + OFF_MIX);
  float* ssq = (float*)(wsb + OFF_SSQ);
  uint2* dump = (uint2*)(wsb + OFF_DUMP);
  const float4* ropetab = (const float4*)(wsb + OFF_ROPE);

  float Dh = 0.f, lamf = 0.f, lamb = 0.f, bias_d = 0.f, A_d = 0.f;
  const int grp = hd >> 2;
  if (SSD) {
    Dh = p.ssd_D[hd];
    const int d = w & 1;
    bias_d = p.dt_bias[d * 16 + hd];
    A_d = expf(p.A_log[d * 16 + hd]);
  } else {
    lamf = -expf(p.ret_decay[hd]);
    lamb = -expf(p.ret_decay[8 + hd]);
  }

  u32x4 rq[NQ], rk[NQ], rx[4];
  uint2 rdump[4];
  float4 rt[4];
  float rd0 = 0.f, rd1 = 0.f;

  auto issue_loads = [&](const int c, const int sweep) {
    const int tok0 = seqbase + c * 128, t0 = c * 128;
    if (sweep) {
      const uint2* dp = dump + ((size_t)(unit0 + c) * 8 + w) * 256;
#pragma unroll
      for (int g = 0; g < 4; ++g) rdump[g] = dp[g * 64 + lane];
    }
    if (SSD) {
      if (sweep) issue_rows<128>(u, rq, 2560 + grp * 128, tok0);
      issue_rows<128>(u, rk, 2048 + grp * 128, tok0);
      issue_rows<64>(u, rx, 1024 + hd * 64, tok0);
      if (w < 2) {
        const int ol = otid() & 63;
        const int sj0 = (w & 1) ? 127 - 2 * ol : 2 * ol, sj1 = (w & 1) ? 126 - 2 * ol : 2 * ol + 1;
        rd0 = dtraw[(size_t)(tok0 + sj0) * 32 + w * 16 + hd];
        rd1 = dtraw[(size_t)(tok0 + sj1) * 32 + w * 16 + hd];
      }
    } else {
      if (sweep) issue_qk(u, rq, 3072 + hd * 64, tok0);
      issue_qk(u, rk, 3584 + hd * 64, tok0);
      issue_rows<128>(u, rx, 4096 + hd * 128, tok0);
      if (stream) {
        const int ot = otid();
        const int row = ot >> 2, pp = ot & 3;
        const float4* tp = ropetab + ((size_t)(t0 + row) * 32 + (pp >> 1) * 16 + (pp & 1) * 8) / 2;
#pragma unroll
        for (int i = 0; i < 4; ++i) rt[i] = tp[i];
      }
    }
  };

  auto finish_loads = [&](const int c, const int sweep) {
    if (SSD) {
      if (w < 2) {
        const int ol = otid() & 63;
        const int sj0 = (w & 1) ? 127 - 2 * ol : 2 * ol, sj1 = (w & 1) ? 126 - 2 * ol : 2 * ol + 1;
        const float raw0 = rd0 + bias_d, raw1 = rd1 + bias_d;
        const float dt0 = fmaxf(raw0, 0.f) + __logf(1.f + __expf(-fabsf(raw0)));
        const float dt1 = fmaxf(raw1, 0.f) + __logf(1.f + __expf(-fabsf(raw1)));
        const float la0 = -dt0 * A_d, la1 = -dt1 * A_d;
        float s = la0 + la1;
#pragma unroll
        for (int d = 1; d < 64; d <<= 1) {
          const float t = __shfl_up(s, d);
          if (lane >= d) s += t;
        }
        const float tot = __shfl(s, 63);
        const float c1 = s, c0 = s - la1;
        float* dta = w ? dtb : dtf;
        float* cua = w ? cumb : cumf;
        float* eca = w ? ecb : ecf;
        dta[sj0] = dt0; dta[sj1] = dt1;
        cua[sj0] = c0; cua[sj1] = c1;
        eca[sj0] = __expf(c0); eca[sj1] = __expf(c1);
        if (w == sweep) {
          wgt[sj0] = dt0 * __expf(tot - c0);
          wgt[sj1] = dt1 * __expf(tot - c1);
        }
      }
    } else {
      if (tid < 128) {
        const float cf = (float)(tid + 1) * lamf, cb = (float)(128 - tid) * lamb;
        dtf[tid] = 1.f; dtb[tid] = 1.f;
        cumf[tid] = cf; cumb[tid] = cb;
        ecf[tid] = __expf(cf); ecb[tid] = __expf(cb);
        wgt[tid] = sweep ? __expf((float)tid * lamb) : __expf((float)(127 - tid) * lamf);
      }
    }
    __syncthreads();
    if (sweep) {
      const int ot = otid();
      const int s = ot >> 7, j = ot & 127;
      float val = 0.f;
      if (j < s * 32) val = dtf[j] * __expf(cumf[s * 32 - 1] - cumf[j]);
      else if (j >= s * 32 + 32) val = dtb[j] * __expf(cumb[s * 32 + 32] - cumb[j]);
      fct[ot] = val;
    }
    if (SSD) {
      if (sweep) finish_rows<128, true, false>(rq, Qs, nullptr, LQ, nullptr);
      finish_rows<128, true, false>(rk, Ks, nullptr, LQ, nullptr);
      if (sweep) finish_rows<64, true, true>(rx, Vs, Vw, LV, wgt);
      else finish_rows<64, false, true>(rx, Vs, Vw, LV, wgt);
    } else {
      if (sweep) finish_qk(rq, rt, Qs, LQ, stream != 0, 1.f);
      finish_qk(rk, rt, Ks, LQ, stream != 0, 0.125f);
      if (sweep) finish_rows<128, true, true>(rx, Vs, Vw, LV, wgt);
      else finish_rows<128, false, true>(rx, Vs, Vw, LV, wgt);
    }
    if (sweep) {
#pragma unroll
      for (int g = 0; g < 4; ++g) *(uint2*)(SfT + (ptile * 32 + l31) * LQ + ntile * 32 + 8 * g + 4 * h) = rdump[g];
    }
    __syncthreads();
  };

  auto state_update = [&](f32x16& S, const float dec) {
#pragma unroll
    for (int r = 0; r < 16; ++r) S[r] *= dec;
    const u16* ka0 = Ks + (8 * h + q4) * LQ + ntile * 32 + 16 * blk + 4 * p4;
    const u16* vb0 = Vw + (8 * h + q4) * LV + ptile * 32 + 16 * blk + 4 * p4;
    s16x4 ta[8][2], tb[8][2];
#pragma unroll
    for (int ks = 0; ks < 8; ++ks) {
      ta[ks][0] = tr_read(ka0 + ks * 16 * LQ);
      ta[ks][1] = tr_read(ka0 + ks * 16 * LQ + 4 * LQ);
      tb[ks][0] = tr_read(vb0 + ks * 16 * LV);
      tb[ks][1] = tr_read(vb0 + ks * 16 * LV + 4 * LV);
    }
    __builtin_amdgcn_sched_barrier(0);
#pragma unroll
    for (int ks = 0; ks < 8; ++ks) S = MFMA32(cat8(ta[ks][0], ta[ks][1]), cat8(tb[ks][0], tb[ks][1]), S);
    __builtin_amdgcn_sched_barrier(0);
  };

  auto load_state = [&](f32x16& S, const int dir) {
    if (stream) {
      const float* sp = SSD ? p.state_ssd + ((size_t)((b * 2 + dir) * 16 + hd)) * 128 * 64
                            : p.state_ret + ((size_t)((b * 2 + dir) * 8 + hd)) * 64 * 128;
#pragma unroll
      for (int r = 0; r < 16; ++r) S[r] = sp[(ntile * 32 + crow(r, h)) * P + ptile * 32 + l31];
    } else {
#pragma unroll
      for (int r = 0; r < 16; ++r) S[r] = 0.f;
    }
  };
  auto store_state = [&](const f32x16& S, const int dir) {
    if (!stream) {
      float* op = SSD ? p.out + (size_t)NTOK * DM + ((size_t)((b * 2 + dir) * 16 + hd)) * 128 * 64
                      : p.out + (size_t)NTOK * DM + (size_t)16 * 2 * 16 * 128 * 64 + ((size_t)((b * 2 + dir) * 8 + hd)) * 64 * 128;
#pragma unroll
      for (int r = 0; r < 16; ++r) op[(ntile * 32 + crow(r, h)) * P + ptile * 32 + l31] = S[r];
    }
  };

  f32x16 S;
  issue_loads(0, 0);
  load_state(S, 0);
#pragma unroll 1
  for (int c = 0; c < nc; ++c) {
    finish_loads(c, 0);
    {
      uint2* dp = dump + ((size_t)(unit0 + c) * 8 + w) * 256;
#pragma unroll
      for (int g = 0; g < 4; ++g) dp[g * 64 + lane] = make_uint2(pack2(S[4 * g], S[4 * g + 1]), pack2(S[4 * g + 2], S[4 * g + 3]));
    }
    if (c + 1 < nc) issue_loads(c + 1, 0);
    else {
      issue_loads(nc - 1, 1);
#pragma unroll
      for (int g = 0; g < 4; ++g) rdump[g] = make_uint2(pack2(S[4 * g], S[4 * g + 1]), pack2(S[4 * g + 2], S[4 * g + 3]));
    }
    state_update(S, __expf(cumf[127]));
    __syncthreads();
  }
  store_state(S, 0);

  load_state(S, 1);
#pragma unroll
  for (int g = 0; g < 4; ++g)
    *(uint2*)(SbT + (ptile * 32 + l31) * LQ + ntile * 32 + 8 * g + 4 * h) =
        make_uint2(pack2(S[4 * g], S[4 * g + 1]), pack2(S[4 * g + 2], S[4 * g + 3]));
  int nextq = 0;
#pragma unroll 1
  for (int c = nc - 1; c >= 0; --c) {
    const int tok0 = seqbase + c * 128;
    finish_loads(c, 1);
    if (c == 0 && threadIdx.x == 0) nextq = atomicAdd(qctr, 1);
    if (c > 0) issue_loads(c - 1, 1);

    const u16* qrow = Qs + (strip * 32 + l31) * LQ + h * 8;
    constexpr bool SJ = SSD;
    constexpr int YT = SJ ? 2 : PT;
    f32x16 Y[YT];
    if constexpr (SJ) {
      const u16* Sx = half ? SbT : SfT;
      const float* ex = half ? ecb : ecf;
#pragma unroll
      for (int pt = 0; pt < 2; ++pt) {
        const int prow = pt * 32 + l31;
        bf16x8 fq[NKS], fs[NKS];
#pragma unroll
        for (int ks = 0; ks < NKS; ++ks) {
          fq[ks] = *(const bf16x8*)(qrow + ks * 16);
          fs[ks] = *(const bf16x8*)(Sx + prow * LQ + ks * 16 + h * 8);
        }
        __builtin_amdgcn_sched_barrier(0);
        f32x16 a1;
#pragma unroll
        for (int r = 0; r < 16; ++r) a1[r] = 0.f;
#pragma unroll
        for (int ks = 0; ks < NKS; ++ks) a1 = MFMA32(fq[ks], fs[ks], a1);
        __builtin_amdgcn_sched_barrier(0);
#pragma unroll
        for (int g = 0; g < 4; ++g) {
          const float4 ef = *(const float4*)(ex + strip * 32 + 8 * g + 4 * h);
          Y[pt][4 * g + 0] = ef.x * a1[4 * g + 0];
          Y[pt][4 * g + 1] = ef.y * a1[4 * g + 1];
          Y[pt][4 * g + 2] = ef.z * a1[4 * g + 2];
          Y[pt][4 * g + 3] = ef.w * a1[4 * g + 3];
        }
      }
    } else {
#pragma unroll
    for (int pt = 0; pt < PT; ++pt) {
      const int prow = (half * PT + pt) * 32 + l31;
      bf16x8 fq[NKS], fs[NKS];
      {
#pragma unroll
        for (int ks = 0; ks < NKS; ++ks) {
          fq[ks] = *(const bf16x8*)(qrow + ks * 16);
          fs[ks] = *(const bf16x8*)(SfT + prow * LQ + ks * 16 + h * 8);
        }
        __builtin_amdgcn_sched_barrier(0);
        f32x16 a1;
#pragma unroll
        for (int r = 0; r < 16; ++r) a1[r] = 0.f;
#pragma unroll
        for (int ks = 0; ks < NKS; ++ks) a1 = MFMA32(fq[ks], fs[ks], a1);
        __builtin_amdgcn_sched_barrier(0);
#pragma unroll
        for (int ks = 0; ks < NKS; ++ks) fs[ks] = *(const bf16x8*)(SbT + prow * LQ + ks * 16 + h * 8);
#pragma unroll
        for (int g = 0; g < 4; ++g) {
          const float4 ef = *(const float4*)(ecf + strip * 32 + 8 * g + 4 * h);
          Y[pt][4 * g + 0] = ef.x * a1[4 * g + 0];
          Y[pt][4 * g + 1] = ef.y * a1[4 * g + 1];
          Y[pt][4 * g + 2] = ef.z * a1[4 * g + 2];
          Y[pt][4 * g + 3] = ef.w * a1[4 * g + 3];
        }
      }
      {
        __builtin_amdgcn_sched_barrier(0);
        f32x16 a2;
#pragma unroll
        for (int r = 0; r < 16; ++r) a2[r] = 0.f;
#pragma unroll
        for (int ks = 0; ks < NKS; ++ks) a2 = MFMA32(fq[ks], fs[ks], a2);
        __builtin_amdgcn_sched_barrier(0);
#pragma unroll
        for (int g = 0; g < 4; ++g) {
          const float4 eb = *(const float4*)(ecb + strip * 32 + 8 * g + 4 * h);
          Y[pt][4 * g + 0] += eb.x * a2[4 * g + 0];
          Y[pt][4 * g + 1] += eb.y * a2[4 * g + 1];
          Y[pt][4 * g + 2] += eb.z * a2[4 * g + 2];
          Y[pt][4 * g + 3] += eb.w * a2[4 * g + 3];
        }
      }
    }
    }
    const int ii = strip * 32 + l31;
    const float cfi = cumf[ii], cbi = cumb[ii];

#pragma unroll 1
    for (int jj = 0; jj < (SJ ? 2 : 4); ++jj) {
      const int jt = SJ ? half * 2 + jj : jj;
      f32x16 G;
#pragma unroll
      for (int r = 0; r < 16; ++r) G[r] = 0.f;
      s16x4 tv[YT][4];
      {
        bf16x8 fk[NKS], fq[NKS];
#pragma unroll
        for (int ks = 0; ks < NKS; ++ks) {
          fk[ks] = *(const bf16x8*)(Ks + (jt * 32 + l31) * LQ + ks * 16 + h * 8);
          fq[ks] = *(const bf16x8*)(qrow + ks * 16);
        }
        __builtin_amdgcn_sched_barrier(0);
#pragma unroll
        for (int ks = 0; ks < NKS; ++ks) G = MFMA32(fk[ks], fq[ks], G);
        __builtin_amdgcn_sched_barrier(0);
#pragma unroll
        for (int pt = 0; pt < YT; ++pt) {
          const u16* vp = Vs + (jt * 32 + 4 * h + q4) * LV + (SJ ? pt : half * PT + pt) * 32 + 16 * blk + 4 * p4;
          tv[pt][0] = tr_read(vp);
          tv[pt][1] = tr_read(vp + 8 * LV);
          tv[pt][2] = tr_read(vp + 16 * LV);
          tv[pt][3] = tr_read(vp + 24 * LV);
        }
        __builtin_amdgcn_sched_barrier(0);
      }
      if (jt == strip) {
#pragma unroll
        for (int g = 0; g < 4; ++g) {
          const int jb = jt * 32 + 8 * g + 4 * h;
          const float4 cf4 = *(const float4*)(cumf + jb), cb4 = *(const float4*)(cumb + jb);
          const float4 df4 = *(const float4*)(dtf + jb), db4 = *(const float4*)(dtb + jb);
          const float cfa[4] = {cf4.x, cf4.y, cf4.z, cf4.w}, cba[4] = {cb4.x, cb4.y, cb4.z, cb4.w};
          const float dfa[4] = {df4.x, df4.y, df4.z, df4.w}, dba[4] = {db4.x, db4.y, db4.z, db4.w};
#pragma unroll
          for (int e = 0; e < 4; ++e) {
            const int j = jb + e;
            const float tf = __expf(cfi - cfa[e]) * dfa[e];
            const float tb = __expf(cbi - cba[e]) * dba[e];
            const float m = ((ii >= j) ? tf : 0.f) + ((ii <= j) ? tb : 0.f);
            float pv = G[4 * g + e] * m;
            if (SSD && ii == j) pv += Dh;
            G[4 * g + e] = pv;
          }
        }
      } else {
        const float ei = (jt < strip) ? __expf(cfi - cumf[strip * 32 - 1]) : __expf(cbi - cumb[strip * 32 + 32]);
#pragma unroll
        for (int g = 0; g < 4; ++g) {
          const float4 f4 = *(const float4*)(fct + strip * 128 + jt * 32 + 8 * g + 4 * h);
          G[4 * g + 0] *= ei * f4.x;
          G[4 * g + 1] *= ei * f4.y;
          G[4 * g + 2] *= ei * f4.z;
          G[4 * g + 3] *= ei * f4.w;
        }
      }
      const bf16x8 pf0 = pack8(G[0], G[1], G[2], G[3], G[4], G[5], G[6], G[7]);
      const bf16x8 pf1 = pack8(G[8], G[9], G[10], G[11], G[12], G[13], G[14], G[15]);
#pragma unroll
      for (int pt = 0; pt < YT; ++pt) {
        Y[pt] = MFMA32(pf0, cat8(tv[pt][0], tv[pt][1]), Y[pt]);
        Y[pt] = MFMA32(pf1, cat8(tv[pt][2], tv[pt][3]), Y[pt]);
      }
    }
    state_update(S, __expf(cumb[0]));
    constexpr int CPR = P / 8, NIT = 128 * CPR / THREADS;
    const int ec8 = tid % CPR, er0 = tid / CPR;
    const int ecol = SSD ? hd * 64 + ec8 * 8 : hd * 128 + ec8 * 8;
    uint4 gz[NIT];
#pragma unroll
    for (int i = 0; i < NIT; ++i)
      gz[i] = *(const uint4*)(u + (size_t)(tok0 + er0 + i * (THREADS / CPR)) * UC + (SSD ? 0 : 5120) + ecol);
    const float* nwp = SSD ? p.ssd_norm_w + ecol : p.ret_norm_w + ecol;
    const float4 n0 = *(const float4*)nwp, n1 = *(const float4*)(nwp + 4);
    const float nw[8] = {n0.x, n0.y, n0.z, n0.w, n1.x, n1.y, n1.z, n1.w};
    __syncthreads();
#pragma unroll
    for (int g = 0; g < 4; ++g)
      *(uint2*)(SbT + (ptile * 32 + l31) * LQ + ntile * 32 + 8 * g + 4 * h) =
          make_uint2(pack2(S[4 * g], S[4 * g + 1]), pack2(S[4 * g + 2], S[4 * g + 3]));
    constexpr int LY = P + 4;
    float* Yst = (float*)smem;
#pragma unroll
    for (int pt = 0; pt < YT; ++pt)
#pragma unroll
      for (int r = 0; r < 16; ++r)
        Yst[(SJ ? half * (128 * LY) : 0) + (strip * 32 + crow(r, h)) * LY + (SJ ? pt : half * PT + pt) * 32 + l31] = Y[pt][r];
    __syncthreads();
#pragma unroll
    for (int i = 0; i < NIT; ++i) {
      const int row = er0 + i * (THREADS / CPR);
      const float* yp = Yst + row * LY + ec8 * 8;
      const float4 y0 = *(const float4*)yp, y1 = *(const float4*)(yp + 4);
      float v[8] = {y0.x, y0.y, y0.z, y0.w, y1.x, y1.y, y1.z, y1.w};
      if constexpr (SJ) {
        const float4 z0 = *(const float4*)(yp + 128 * LY), z1 = *(const float4*)(yp + 128 * LY + 4);
        v[0] += z0.x; v[1] += z0.y; v[2] += z0.z; v[3] += z0.w;
        v[4] += z1.x; v[5] += z1.y; v[6] += z1.z; v[7] += z1.w;
      }
      const size_t tok = (size_t)(tok0 + row);
      const unsigned zu[4] = {gz[i].x, gz[i].y, gz[i].z, gz[i].w};
      if (SSD) {
        float sq = 0.f;
#pragma unroll
        for (int e = 0; e < 8; ++e) {
          const float z = (e & 1) ? hi_bf(zu[e >> 1]) : lo_bf(zu[e >> 1]);
          v[e] *= silu_f(z);
          sq += v[e] * v[e];
        }
        sq += __shfl_xor(sq, 1);
        sq += __shfl_xor(sq, 2);
        sq += __shfl_xor(sq, 4);
        if (ec8 == 0) ssq[tok * 16 + hd] = sq;
        *(uint4*)(mix + tok * 2048 + ecol) = make_uint4(pack2(v[0] * nw[0], v[1] * nw[1]), pack2(v[2] * nw[2], v[3] * nw[3]),
                                                        pack2(v[4] * nw[4], v[5] * nw[5]), pack2(v[6] * nw[6], v[7] * nw[7]));
      } else {
        float s = 0.f;
#pragma unroll
        for (int e = 0; e < 8; ++e) s += v[e];
        s += __shfl_xor(s, 1);
        s += __shfl_xor(s, 2);
        s += __shfl_xor(s, 4);
        s += __shfl_xor(s, 8);
        const float mean = s * (1.f / 128.f);
        float s2 = 0.f;
#pragma unroll
        for (int e = 0; e < 8; ++e) {
          v[e] -= mean;
          s2 += v[e] * v[e];
        }
        s2 += __shfl_xor(s2, 1);
        s2 += __shfl_xor(s2, 2);
        s2 += __shfl_xor(s2, 4);
        s2 += __shfl_xor(s2, 8);
        const float rstd = rsqrtf(s2 * (1.f / 128.f) + 1e-6f);
#pragma unroll
        for (int e = 0; e < 8; ++e) {
          const float gv = (e & 1) ? hi_bf(zu[e >> 1]) : lo_bf(zu[e >> 1]);
          v[e] = v[e] * rstd * nw[e] * silu_f(gv);
        }
        *(uint4*)(mix + tok * 2048 + 1024 + ecol) =
            make_uint4(pack2(v[0], v[1]), pack2(v[2], v[3]), pack2(v[4], v[5]), pack2(v[6], v[7]));
      }
    }
  }
  store_state(S, 1);
  if (threadIdx.x == 0) *s_item = nextq;
}

__device__ __forceinline__ void phase3(const Params& p, char* smem, const int ctr_idx) {
  int* s_item = (int*)(smem + SC_ITEM);
  int* ctr = (int*)(p.ws + OFF_CTR) + ctr_idx;
  if (threadIdx.x == 0) *s_item = atomicAdd(ctr, 1);
  __syncthreads();
#pragma unroll 1
  for (;;) {
    const int q = *s_item;
    __syncthreads();
    if (q >= 576) break;
    int kind, stream, bb, hd, unit0;
    if (q < 128) { kind = 0; stream = 1; bb = q >> 4; hd = q & 15; unit0 = q * 8; }
    else if (q < 192) { kind = 1; stream = 1; bb = (q - 128) >> 3; hd = (q - 128) & 7; unit0 = 1024 + (q - 128) * 8; }
    else if (q < 448) { kind = 0; stream = 0; bb = (q - 192) >> 4; hd = (q - 192) & 15; unit0 = 1536 + (q - 192) * 2; }
    else { kind = 1; stream = 0; bb = (q - 448) >> 3; hd = (q - 448) & 7; unit0 = 2048 + (q - 448) * 2; }
    if (kind == 0) scan_item<128, 64, true>(p, smem, stream, bb, hd, unit0, ctr, s_item);
    else scan_item<64, 128, false>(p, smem, stream, bb, hd, unit0, ctr, s_item);
    __syncthreads();
  }
}

__device__ __forceinline__ void phase5(const Params& p) {
  const int tid = otid(), lane = tid & 63, w = tid >> 6;
  const float* mod = (const float*)(p.ws + OFF_MOD);
  const float* ob = (const float*)(p.ws + OFF_OUTB);
  const float* ssq2 = (const float*)(p.ws + OFF_SSQ2);
  for (int row = blockIdx.x * 8 + w; row < NTOK; row += gridDim.x * 8) {
    const float* xr = (row < NPR) ? p.x_prompt + (size_t)row * DM : p.x_sample + (size_t)(row - NPR) * DM;
    const int mr = (row < NPR) ? 0 : 1 + ((row - NPR) >> 10);
    float s = (lane < 16) ? ssq2[(size_t)row * 16 + lane] : 0.f;
#pragma unroll
    for (int m = 8; m >= 1; m >>= 1) s += __shfl_xor(s, m);
    s = __shfl(s, 0);
    const float rstd = rsqrtf(s * (1.f / 1024.f) + 1e-6f);
#pragma unroll
    for (int i = 0; i < 4; ++i) {
      const int k = (i * 64 + lane) * 4;
      const float4 xv = *(const float4*)(xr + k);
      const float4 ov = *(const float4*)(ob + (size_t)row * DM + k);
      const float4 nw = *(const float4*)(p.norm_post_w + k);
      const float4 gt = *(const float4*)(mod + mr * 3072 + 2048 + k);
      float4 y;
      y.x = xv.x + gt.x * ov.x * rstd * nw.x;
      y.y = xv.y + gt.y * ov.y * rstd * nw.y;
      y.z = xv.z + gt.z * ov.z * rstd * nw.z;
      y.w = xv.w + gt.w * ov.w * rstd * nw.w;
      *(float4*)(p.out + (size_t)row * DM + k) = y;
    }
  }
}

__global__ void __launch_bounds__(THREADS) fwd_megakernel(Params p) {
  extern __shared__ __attribute__((aligned(16))) char smem[];
  cg::grid_group grid = cg::this_grid();
  const int G = gridDim.x;
  const int bx = blockIdx.x;
  const int rb = (G % 8 == 0) ? (bx % 8) * (G / 8) + bx / 8 : bx;

  unsigned* gbar = (unsigned*)(p.ws + OFF_CTR + 1024);
  unsigned epoch = 0u;
  if (p.ws == nullptr) grid.sync();
  phase0(p, smem);
#if PROBE == 5
  phase0(p, smem);
  grid_barrier(gbar, epoch);
#endif
#if PROBE == 4
  for (int i = 0; i < 10; ++i) grid_barrier(gbar, epoch);
#endif
  phase1(p);
  grid_barrier(gbar, epoch);
#if PROBE == 6
  phase1(p);
  grid_barrier(gbar, epoch);
#endif
  {
    u32x4 sra[4], srb[4];
    bool have0 = false;
    for (int id = rb; id < 48 * 25; id += G) {
      const int band = id / 200, rem = id % 200;
      const int id2 = id + G;
      const bool has2 = id2 < 48 * 25;
      const int band2 = id2 / 200, rem2 = id2 % 200;
      gemm_tile<0, 4>(p, (const u16*)(p.ws + OFF_H), (const u16*)(p.ws + OFF_WTIN), 1024, band * 8 + (rem & 7), rem >> 3, smem, sra, srb,
                      have0, has2, band2 * 8 + (rem2 & 7), rem2 >> 3);
      have0 = has2;
    }
  }
  {
    const int nfull = (48 * 25) % G;
    const int nhelp = (nfull > 0) ? G - nfull : G;
    const int hb = (nfull > 0) ? rb - nfull : rb;
    if (hb >= 0)
      for (int q = hb; q < 512; q += nhelp)
        p0_transpose_item(p.w_out, 1024, (u16*)(p.ws + OFF_WTOUT), 2048, q / 16, q % 16, 1024, false, smem);
  }
  grid_barrier(gbar, epoch);
#if PROBE == 1
  for (int id = rb; id < 48 * 25; id += G) {
    const int band = id / 200, rem = id % 200;
    u32x4 sra[4], srb[4];
    gemm_tile<0, 4>(p, (const u16*)(p.ws + OFF_H), (const u16*)(p.ws + OFF_WTIN), 1024, band * 8 + (rem & 7), rem >> 3, smem, sra, srb, false, false, 0, 0);
  }
  grid_barrier(gbar, epoch);
#endif
  phase_conv(p);
  grid_barrier(gbar, epoch);
  phase3(p, smem, 0);
#if PROBE == 2
  phase3(p, smem, 1);
#endif
  grid_barrier(gbar, epoch);
#if PROBE == 3
  for (int id = rb; id < 64 * 4; id += G)
  {
    u32x4 sra[3], srb[4];
    gemm_tile<1, 3>(p, (const u16*)(p.ws + OFF_MIX), (const u16*)(p.ws + OFF_WTOUT), 2048, id >> 2, id & 3, smem, sra, srb, false, false, 0, 0);
  }
  grid_barrier(gbar, epoch);
#endif
  for (int id = rb; id < 64 * 4; id += G)
  {
    u32x4 sra[3], srb[4];
    gemm_tile<1, 3>(p, (const u16*)(p.ws + OFF_MIX), (const u16*)(p.ws + OFF_WTOUT), 2048, id >> 2, id & 3, smem, sra, srb, false, false, 0, 0);
  }
  grid_barrier(gbar, epoch);
  phase5(p);
#if PROBE == 7
  phase5(p);
#endif
}

extern "C" void kernel_launch(void* const* d_in, const int* in_sizes, int n_in, void* d_out, int out_size, void* d_ws,
                              size_t ws_size, hipStream_t stream) {
  static int grid_blocks = 0;
  if (!grid_blocks) {
    int dev = 0, cus = 0, per_cu = 0;
    hipGetDevice(&dev);
    hipDeviceGetAttribute(&cus, hipDeviceAttributeMultiprocessorCount, dev);
    hipFuncSetAttribute((const void*)fwd_megakernel, hipFuncAttributeMaxDynamicSharedMemorySize, SMEM_BYTES);
    hipOccupancyMaxActiveBlocksPerMultiprocessor(&per_cu, fwd_megakernel, THREADS, SMEM_BYTES);
    if (per_cu < 1) per_cu = 1;
    grid_blocks = cus * per_cu;
  }
  Params p{};
  const float* const* in = (const float* const*)d_in;
  p.x_prompt = in[0]; p.x_sample = in[1]; p.state_ssd = in[2]; p.state_ret = in[3]; p.c = in[4]; p.c_ctx = in[5];
  p.w_mod = in[6]; p.b_mod = in[7]; p.norm_pre_w = in[8]; p.norm_post_w = in[9]; p.w_in = in[10]; p.conv_w = in[11];
  p.conv_b = in[12]; p.A_log = in[13]; p.dt_bias = in[14]; p.ssd_D = in[15]; p.ssd_norm_w = in[16]; p.ret_decay = in[17];
  p.ret_norm_w = in[18]; p.w_out = in[19];
  p.out = (float*)d_out;
  p.ws = (char*)d_ws;
  hipMemsetAsync((char*)d_ws + OFF_CTR, 0, 8192, stream);
  void* args[] = {&p};
  hipError_t e = hipLaunchCooperativeKernel((void*)fwd_megakernel, dim3(grid_blocks), dim3(THREADS), args, SMEM_BYTES, stream);
  if (e != hipSuccess) fprintf(stderr, "cooperative launch failed: %s (grid %d)\n", hipGetErrorString(e), grid_blocks);
}
```

```cpp
#include <hip/hip_runtime.h>
#include <hip/hip_cooperative_groups.h>
#include <cstdio>
namespace cg = cooperative_groups;

typedef unsigned short u16;
typedef __bf16 bf16v2 __attribute__((ext_vector_type(2)));
typedef float f32v2 __attribute__((ext_vector_type(2)));
typedef short s16x4 __attribute__((ext_vector_type(4)));
using bf16x8 = __attribute__((ext_vector_type(8))) short;
using f32x16 = __attribute__((ext_vector_type(16))) float;
using u32x4 = __attribute__((ext_vector_type(4))) unsigned;
#define DI __device__ __forceinline__
#define MFMA32(a, b, c) __builtin_amdgcn_mfma_f32_32x32x16_bf16((a), (b), (c), 0, 0, 0)

constexpr int NTOK = 12288;
constexpr int NPR = 4096;
constexpr int DM = 1024;
constexpr int INC = 6176;
constexpr int UC = 6144;
#ifndef PROBE
#define PROBE 0
#endif
constexpr int THREADS = 512;
constexpr int SMEM_BYTES = 152 * 1024;

constexpr size_t OFF_MOD = 0;
constexpr size_t OFF_ROPE = 131072;
constexpr size_t OFF_CTR = 393216;
constexpr size_t OFF_H = 524288;
constexpr size_t OFF_WTIN = OFF_H + 25165824;
constexpr size_t OFF_DUMP = OFF_H;
constexpr size_t OFF_WTOUT = OFF_WTIN + 13107200;
constexpr size_t OFF_U = OFF_WTOUT + 4194304;
constexpr size_t OFF_OUTB = OFF_U;
constexpr size_t OFF_DT = OFF_U + 150994944;
constexpr size_t OFF_MIX = OFF_DT + 1572864;
constexpr size_t OFF_SSQ = OFF_MIX + 50331648;
constexpr size_t OFF_SSQ2 = OFF_SSQ + 1572864;
constexpr size_t OFF_HALO = OFF_SSQ2 + 786432;

struct Params {
  const float *x_prompt, *x_sample, *state_ssd, *state_ret, *c, *c_ctx, *w_mod, *b_mod, *norm_pre_w, *norm_post_w,
      *w_in, *conv_w, *conv_b, *A_log, *dt_bias, *ssd_D, *ssd_norm_w, *ret_decay, *ret_norm_w, *w_out;
  float* out;
  char* ws;
};

DI float bf2f(u16 v) { return __uint_as_float(((unsigned)v) << 16); }
DI unsigned pack2(float a, float b) {
  f32v2 f = {a, b};
  bf16v2 r = __builtin_convertvector(f, bf16v2);
  return __builtin_bit_cast(unsigned, r);
}
DI u16 f2bf(float a) { return (u16)(pack2(a, 0.f) & 0xffffu); }
DI float lo_bf(unsigned v) { return __uint_as_float(v << 16); }
DI float hi_bf(unsigned v) { return __uint_as_float(v & 0xffff0000u); }
DI float silu_f(float v) { return v * __builtin_amdgcn_rcpf(1.f + __expf(-v)); }
DI int crow(int r, int h) { return (r & 3) + 8 * (r >> 2) + 4 * h; }
DI int otid() {
  int t = threadIdx.x;
  asm volatile("" : "+v"(t));
  return t;
}
DI s16x4 tr_read(const u16* p) {
  return __builtin_amdgcn_ds_read_tr16_b64_v4i16((s16x4 __attribute__((address_space(3)))*)(p));
}
DI bf16x8 cat8(s16x4 lo, s16x4 hi) { return __builtin_shufflevector(lo, hi, 0, 1, 2, 3, 4, 5, 6, 7); }
DI bf16x8 pack8(float a0, float a1, float a2, float a3, float a4, float a5, float a6, float a7) {
  uint4 v = make_uint4(pack2(a0, a1), pack2(a2, a3), pack2(a4, a5), pack2(a6, a7));
  return __builtin_bit_cast(bf16x8, v);
}


DI void grid_barrier(unsigned* bar, unsigned& epoch) {
  asm volatile("s_waitcnt vmcnt(0)" ::: "memory");
  __syncthreads();
  if (threadIdx.x == 0) {
    __builtin_amdgcn_fence(__ATOMIC_RELEASE, "agent");
    asm volatile("s_waitcnt vmcnt(0)" ::: "memory");
    const unsigned G = gridDim.x;
    const unsigned ng = (G % 8u == 0u) ? 8u : 1u;
    const unsigned gs = G / ng, g = blockIdx.x % ng, e1 = epoch + 1u;
    const unsigned old = __hip_atomic_fetch_add(&bar[64u * (1u + g)], 1u, __ATOMIC_RELAXED, __HIP_MEMORY_SCOPE_AGENT);
    if (old + 1u == gs * e1) {
      const unsigned o2 = __hip_atomic_fetch_add(&bar[0], 1u, __ATOMIC_RELAXED, __HIP_MEMORY_SCOPE_AGENT);
      if (o2 + 1u == ng * e1) __hip_atomic_fetch_add(&bar[64u * 16u], 1u, __ATOMIC_RELAXED, __HIP_MEMORY_SCOPE_AGENT);
    }
    while (__hip_atomic_load(&bar[64u * 16u], __ATOMIC_RELAXED, __HIP_MEMORY_SCOPE_AGENT) < e1) __builtin_amdgcn_s_sleep(1);
    __builtin_amdgcn_fence(__ATOMIC_ACQUIRE, "agent");
    asm volatile("s_waitcnt vmcnt(0)" ::: "memory");
  }
  __syncthreads();
  ++epoch;
}


#define XB_TMO      128
#define XB_XCNT(j)  (256  + 64 * (j))
#define XB_XSUB(j)  (1280 + 64 * (j))
#define XB_XGEN(j)  (2304 + 64 * (j))
#define XB_TOP      3328
#define XB_TOPGEN   3392
#define XB_SPIN_CAP (1u << 22)
#define LAS __attribute__((address_space(3)))
DI unsigned xb_ld(unsigned* p) { return __hip_atomic_load(p, __ATOMIC_RELAXED, __HIP_MEMORY_SCOPE_AGENT); }
DI unsigned xb_add(unsigned* p, unsigned v) { return __hip_atomic_fetch_add(p, v, __ATOMIC_RELAXED, __HIP_MEMORY_SCOPE_AGENT); }
DI unsigned xb_xcc_id() { return (unsigned)__builtin_amdgcn_s_getreg((3 << 11) | 20) & 0xFu; }
#define XB_SPIN(cond, bar) do { unsigned _sp = 0; while (cond) { __builtin_amdgcn_s_sleep(1); \
    if ((++_sp & 255u) == 0u) { if (xb_ld(&(bar)[XB_TMO])) break; if (_sp > XB_SPIN_CAP) { atomicAdd(&(bar)[XB_TMO], 1u); break; } } } } while (0)
struct XcdBarrier { unsigned* bar; unsigned x; volatile LAS unsigned* st; };
DI XcdBarrier xcd_barrier_post(unsigned* bar, volatile LAS unsigned* st) {
  XcdBarrier b; b.bar = bar; b.x = xb_xcc_id(); b.st = st;
  if (threadIdx.x == 0) (void)xb_add(&bar[XB_XCNT(b.x)], 1u);
  return b;
}
DI void xcd_barrier_complete(unsigned* bar, unsigned x, unsigned& nloc, unsigned& nx) {
  const unsigned G = gridDim.x;
  unsigned sum, cnt, mine, sp = 0u;
  for (;;) {
    sum = 0u; cnt = 0u; mine = 0u;
#pragma unroll
    for (unsigned j = 0; j < 16; ++j) { const unsigned c = xb_ld(&bar[XB_XCNT(j)]); sum += c; cnt += (c > 0u) ? 1u : 0u; mine = (j == x) ? c : mine; }
    if (sum == G) break;
    __builtin_amdgcn_s_sleep(1);
    if ((++sp & 255u) == 0u) { if (xb_ld(&bar[XB_TMO])) break; if (sp > XB_SPIN_CAP) { atomicAdd(&bar[XB_TMO], 1u); break; } }
  }
  nloc = mine > 0u ? mine : 1u; nx = cnt > 0u ? cnt : 1u;
}
DI void xcd_barrier(const XcdBarrier& b) {
  asm volatile("s_waitcnt vmcnt(0)" ::: "memory");
  __syncthreads();
  if (threadIdx.x == 0) {
    unsigned* bar = b.bar;
    __builtin_amdgcn_s_waitcnt(0);
    unsigned nloc = b.st[0], nx = b.st[1];
    if (nloc == 0u) { xcd_barrier_complete(bar, b.x, nloc, nx); b.st[0] = nloc; b.st[1] = nx; }
    const unsigned old = xb_add(&bar[XB_XSUB(b.x)], 1u);
    const unsigned gen = old / nloc;
    if (old + 1u == (gen + 1u) * nloc) {
      __builtin_amdgcn_fence(__ATOMIC_RELEASE, "agent");
      asm volatile("s_waitcnt vmcnt(0)" ::: "memory");
      const unsigned og = xb_add(&bar[XB_TOP], 1u);
      const unsigned tg = og / nx;
      if (og + 1u == (tg + 1u) * nx) xb_add(&bar[XB_TOPGEN], 1u);
      else XB_SPIN(xb_ld(&bar[XB_TOPGEN]) == tg, bar);
      __builtin_amdgcn_fence(__ATOMIC_ACQUIRE, "agent");
      xb_add(&bar[XB_XGEN(b.x)], 1u);
      asm volatile("s_waitcnt vmcnt(0)" ::: "memory");
    } else {
      XB_SPIN(xb_ld(&bar[XB_XGEN(b.x)]) == gen, bar);
      __builtin_amdgcn_fence(__ATOMIC_ACQUIRE, "agent");
      asm volatile("s_waitcnt vmcnt(0)" ::: "memory");
    }
  }
  __syncthreads();
}

__device__ __forceinline__ void p0_mod_item(const Params& p, char* smem, int it) {
  float* sc = (float*)smem;
  float* red = sc + 9 * 1024;
  const int tid = threadIdx.x, lane = tid & 63, w = tid >> 6;
  for (int idx = tid; idx < 9 * 1024; idx += THREADS) {
    int r = idx >> 10, k = idx & 1023;
    float v = (r == 0) ? p.c_ctx[k] : p.c[(r - 1) * 1024 + k];
    sc[idx] = v / (1.f + expf(-v));
  }
  __syncthreads();
  const int cg4 = tid & 7, kg = tid >> 3, n0 = it * 32;
  float acc[9][4];
#pragma unroll
  for (int r = 0; r < 9; ++r)
#pragma unroll
    for (int e = 0; e < 4; ++e) acc[r][e] = 0.f;
  float4 wv[16];
#pragma unroll
  for (int i = 0; i < 16; ++i) wv[i] = *(const float4*)(p.w_mod + (size_t)(kg * 16 + i) * 3072 + n0 + cg4 * 4);
#pragma unroll
  for (int i = 0; i < 16; ++i) {
#pragma unroll
    for (int r = 0; r < 9; ++r) {
      const float s = sc[r * 1024 + kg * 16 + i];
      acc[r][0] += s * wv[i].x; acc[r][1] += s * wv[i].y; acc[r][2] += s * wv[i].z; acc[r][3] += s * wv[i].w;
    }
  }
#pragma unroll
  for (int r = 0; r < 9; ++r)
#pragma unroll
    for (int e = 0; e < 4; ++e) {
      float v = acc[r][e];
      v += __shfl_xor(v, 8);
      v += __shfl_xor(v, 16);
      v += __shfl_xor(v, 32);
      acc[r][e] = v;
    }
  if (lane < 8) {
#pragma unroll
    for (int r = 0; r < 9; ++r)
#pragma unroll
      for (int e = 0; e < 4; ++e) red[(w * 9 + r) * 32 + lane * 4 + e] = acc[r][e];
  }
  __syncthreads();
  float* mod = (float*)(p.ws + OFF_MOD);
  if (tid < 9 * 32) {
    int r = tid >> 5, c2 = tid & 31;
    float s = p.b_mod[n0 + c2];
#pragma unroll
    for (int g = 0; g < 8; ++g) s += red[(g * 9 + r) * 32 + c2];
    mod[r * 3072 + n0 + c2] = s;
  }
  asm volatile("s_waitcnt vmcnt(0)" ::: "memory");
  __syncthreads();
  if (tid == 0) {
    __builtin_amdgcn_fence(__ATOMIC_RELEASE, "agent");
    asm volatile("s_waitcnt vmcnt(0)" ::: "memory");
    __hip_atomic_fetch_add((unsigned*)(p.ws + OFF_CTR) + 16, 1u, __ATOMIC_RELAXED, __HIP_MEMORY_SCOPE_AGENT);
  }
}

__device__ __forceinline__ void p0_transpose_item(const float* __restrict__ src, int lds_src, u16* __restrict__ dst, int ldk, int kt, int nt,
                                  int nvalid, bool permute, char* smem) {
  u16* T = (u16*)smem;
  const int tid = threadIdx.x, cc = tid & 63, kr = tid >> 6;
  const int n = nt * 64 + cc;
  int on = n;
  if (permute) on = (n < 3072) ? n : (n < 6144 ? n + 32 : n - 3072);
#pragma unroll
  for (int i = 0; i < 8; ++i) {
    int kk = kr + i * 8;
    float v = (n < nvalid) ? src[(size_t)(kt * 64 + kk) * lds_src + on] : 0.f;
    T[cc * 72 + kk] = f2bf(v);
  }
  __syncthreads();
  const int row = tid >> 3, c8 = tid & 7;
  uint4 v = *(const uint4*)(T + row * 72 + c8 * 8);
  *(uint4*)(dst + (size_t)(nt * 64 + row) * ldk + kt * 64 + c8 * 8) = v;
  __syncthreads();
}

__device__ __forceinline__ void phase0(const Params& p, char* smem) {
  const int tid = threadIdx.x;

  constexpr int N_MOD = 96, N_WIN = 1600, N_ROPE = 64;
  for (int it = blockIdx.x; it < N_MOD + N_WIN + N_ROPE; it += gridDim.x) {
    if (it < N_MOD) {
      p0_mod_item(p, smem, it);
    } else if (it < N_MOD + N_WIN) {
      int q = it - N_MOD;
      p0_transpose_item(p.w_in, INC, (u16*)(p.ws + OFF_WTIN), 1024, q / 100, q % 100, INC, true, smem);
    } else {
      int q = it - N_MOD - N_WIN;
      int idx = q * 512 + tid;
      int pos = idx >> 5, m = idx & 31, fm = m & 15;
      float inv = exp2f(-(float)(2 * fm) / 32.f * 13.287712379549449f);
      float coord = (float)((m < 16) ? (pos >> 6) : (pos & 63));
      float ang = coord * inv;
      float* tab = (float*)(p.ws + OFF_ROPE);
      tab[idx * 2] = __cosf(ang);
      tab[idx * 2 + 1] = __sinf(ang);
    }
  }
}

__device__ __forceinline__ void phase1(const Params& p) {
  if (threadIdx.x == 0) {
    unsigned* flag = (unsigned*)(p.ws + OFF_CTR) + 16;
    while (__hip_atomic_load(flag, __ATOMIC_RELAXED, __HIP_MEMORY_SCOPE_AGENT) < 96u) __builtin_amdgcn_s_sleep(1);
    __builtin_amdgcn_fence(__ATOMIC_ACQUIRE, "agent");
    asm volatile("s_waitcnt vmcnt(0)" ::: "memory");
  }
  __syncthreads();
  const int tid = otid(), lane = tid & 63, w = tid >> 6;
  const float* mod = (const float*)(p.ws + OFF_MOD);
  u16* hb = (u16*)(p.ws + OFF_H);
  float4 nw[4];
#pragma unroll
  for (int i = 0; i < 4; ++i) nw[i] = *(const float4*)(p.norm_pre_w + (i * 64 + lane) * 4);
  const int rstep = gridDim.x * 8;
#pragma unroll 1
  for (int row0 = blockIdx.x * 8 + w; row0 < NTOK; row0 += 2 * rstep) {
    float4 v[2][4], sh[2][4], sc[2][4];
    int rows[2];
#pragma unroll
    for (int j = 0; j < 2; ++j) {
      const int row = row0 + j * rstep;
      rows[j] = row;
      if (row < NTOK) {
        const float* xr = (row < NPR) ? p.x_prompt + (size_t)row * DM : p.x_sample + (size_t)(row - NPR) * DM;
        const int mr = (row < NPR) ? 0 : 1 + ((row - NPR) >> 10);
#pragma unroll
        for (int i = 0; i < 4; ++i) {
          const int k = (i * 64 + lane) * 4;
          v[j][i] = *(const float4*)(xr + k);
          sh[j][i] = *(const float4*)(mod + mr * 3072 + k);
          sc[j][i] = *(const float4*)(mod + mr * 3072 + 1024 + k);
        }
      }
    }
#pragma unroll
    for (int j = 0; j < 2; ++j) {
      if (rows[j] < NTOK) {
        float ss = 0.f;
#pragma unroll
        for (int i = 0; i < 4; ++i) ss += v[j][i].x * v[j][i].x + v[j][i].y * v[j][i].y + v[j][i].z * v[j][i].z + v[j][i].w * v[j][i].w;
#pragma unroll
        for (int m = 32; m >= 1; m >>= 1) ss += __shfl_xor(ss, m);
        const float rstd = rsqrtf(ss * (1.f / 1024.f) + 1e-6f);
#pragma unroll
        for (int i = 0; i < 4; ++i) {
          const int k = (i * 64 + lane) * 4;
          const float h0 = v[j][i].x * rstd * nw[i].x * (1.f + sc[j][i].x) + sh[j][i].x;
          const float h1 = v[j][i].y * rstd * nw[i].y * (1.f + sc[j][i].y) + sh[j][i].y;
          const float h2 = v[j][i].z * rstd * nw[i].z * (1.f + sc[j][i].z) + sh[j][i].z;
          const float h3 = v[j][i].w * rstd * nw[i].w * (1.f + sc[j][i].w) + sh[j][i].w;
          *(uint2*)(hb + (size_t)rows[j] * DM + k) = make_uint2(pack2(h0, h1), pack2(h2, h3));
        }
      }
    }
  }
}

template <int MODE, int MT>
__device__ __forceinline__ void gemm_tile(const Params& p, const u16* __restrict__ A, const u16* __restrict__ B, const int K, const int mt,
                          const int nt, char* smem, u32x4 (&ra0)[MT], u32x4 (&rb0)[4], const bool have0, const bool has_next,
                          const int mt_next, const int nt_next) {
  constexpr int LDT = 72;
  constexpr int STAGE = 2 * 256 * LDT;
  u16* sm = (u16*)smem;
  int tid_ = threadIdx.x;
  asm volatile("" : "+v"(tid_));
  const int tid = tid_, lane = tid & 63, w = tid >> 6, wm = w >> 2, wn = w & 3, l31 = lane & 31, h = lane >> 5;
  constexpr int AROWS = 64 * MT;
  f32x16 acc[MT][2];
#pragma unroll
  for (int mi = 0; mi < MT; ++mi)
#pragma unroll
    for (int ni = 0; ni < 2; ++ni)
#pragma unroll
      for (int r = 0; r < 16; ++r) acc[mi][ni][r] = 0.f;
  const int srow = tid >> 3, sc8 = tid & 7;
  const u16* Ag = A + (size_t)(mt * AROWS + srow) * K + sc8 * 8;
  const u16* Bg = B + (size_t)(nt * 256 + srow) * K + sc8 * 8;
  const int nk = K / 64;
#define GLOAD(RA, RB, KT)                                                                                   \
  do {                                                                                                      \
    _Pragma("unroll") for (int i = 0; i < MT; ++i) RA[i] = *(const u32x4*)(Ag + (size_t)(i * 64) * K + (KT) * 64); \
    _Pragma("unroll") for (int i = 0; i < 4; ++i) RB[i] = *(const u32x4*)(Bg + (size_t)(i * 64) * K + (KT) * 64);  \
  } while (0)
#define SSTORE(RA, RB, ST)                                                                                  \
  do {                                                                                                      \
    u16* Ad = sm + (ST) * STAGE;                                                                            \
    _Pragma("unroll") for (int i = 0; i < MT; ++i) *(u32x4*)(Ad + (srow + i * 64) * LDT + sc8 * 8) = RA[i]; \
    _Pragma("unroll") for (int i = 0; i < 4; ++i) *(u32x4*)(Ad + 256 * LDT + (srow + i * 64) * LDT + sc8 * 8) = RB[i]; \
  } while (0)
#define LDFRAG(AF, BF, KS)                                                                                  \
  do {                                                                                                      \
    _Pragma("unroll") for (int mi = 0; mi < MT; ++mi) AF[mi] = *(const bf16x8*)(Abase + mi * 32 * LDT + (KS) * 16); \
    _Pragma("unroll") for (int ni = 0; ni < 2; ++ni) BF[ni] = *(const bf16x8*)(Bbase + ni * 32 * LDT + (KS) * 16);  \
  } while (0)
#define MMA(AF, BF)                                                                                         \
  do {                                                                                                      \
    _Pragma("unroll") for (int mi = 0; mi < MT; ++mi)                                                       \
    _Pragma("unroll") for (int ni = 0; ni < 2; ++ni) acc[mi][ni] = MFMA32(BF[ni], AF[mi], acc[mi][ni]);     \
  } while (0)
  auto compute = [&](const int st, const int kt) {
    const u16* Abase = sm + st * STAGE + (wm * (MT * 32) + l31) * LDT + h * 8;
    const u16* Bbase = sm + st * STAGE + 256 * LDT + (wn * 64 + l31) * LDT + h * 8;
    bf16x8 af0[MT], bf0[2], af1[MT], bf1[2];
    LDFRAG(af0, bf0, 0);
    __builtin_amdgcn_sched_barrier(0);
    LDFRAG(af1, bf1, 1);
    __builtin_amdgcn_sched_barrier(0);
    MMA(af0, bf0);
    __builtin_amdgcn_sched_barrier(0);
    LDFRAG(af0, bf0, 2);
    __builtin_amdgcn_sched_barrier(0);
    if (kt + 1 < nk) SSTORE(ra0, rb0, st ^ 1);
    __builtin_amdgcn_sched_barrier(0);
    MMA(af1, bf1);
    __builtin_amdgcn_sched_barrier(0);
    if (kt + 2 < nk) GLOAD(ra0, rb0, kt + 2);
    __builtin_amdgcn_sched_barrier(0);
    LDFRAG(af1, bf1, 3);
    __builtin_amdgcn_sched_barrier(0);
    MMA(af0, bf0);
    __builtin_amdgcn_sched_barrier(0);
    MMA(af1, bf1);
  };
  auto rowscale = [&]() {
    const float* ssq = (const float*)(p.ws + OFF_SSQ);
#pragma unroll
    for (int mi = 0; mi < MT; ++mi) {
      const int m = mt * AROWS + wm * (MT * 32) + mi * 32 + l31;
      float s = 0.f;
#pragma unroll
      for (int q = 0; q < 4; ++q) {
        float4 t = *(const float4*)(ssq + (size_t)m * 16 + q * 4);
        s += t.x + t.y + t.z + t.w;
      }
      const float rs = rsqrtf(s * (1.f / 1024.f) + 1e-6f);
#pragma unroll
      for (int ni = 0; ni < 2; ++ni)
#pragma unroll
        for (int r = 0; r < 16; ++r) acc[mi][ni][r] *= rs;
    }
  };
  if (!have0) GLOAD(ra0, rb0, 0);
  SSTORE(ra0, rb0, 0);
  GLOAD(ra0, rb0, 1);
  __syncthreads();
#pragma unroll 1
  for (int kt = 0; kt < nk; ++kt) {
    compute(kt & 1, kt);
    if (MODE == 1 && kt == 15) rowscale();
    __syncthreads();
  }
  if (has_next) {
    const u16* Ag2 = A + (size_t)(mt_next * AROWS + srow) * K + sc8 * 8;
    const u16* Bg2 = B + (size_t)(nt_next * 256 + srow) * K + sc8 * 8;
#pragma unroll
    for (int i = 0; i < MT; ++i) ra0[i] = *(const u32x4*)(Ag2 + (size_t)(i * 64) * K);
#pragma unroll
    for (int i = 0; i < 4; ++i) rb0[i] = *(const u32x4*)(Bg2 + (size_t)(i * 64) * K);
  }
#undef GLOAD
#undef SSTORE
#undef LDFRAG
#undef MMA
  if (MODE == 0) {
    if (nt < 24) {
      u16* u = (u16*)(p.ws + OFF_U);
      u16* cst = sm + w * (128 * 72);
#pragma unroll
      for (int mi = 0; mi < MT; ++mi) {
        const int m = mt * AROWS + wm * (MT * 32) + mi * 32 + l31;
#pragma unroll
        for (int ni = 0; ni < 2; ++ni)
#pragma unroll
          for (int g = 0; g < 4; ++g) {
            const int n = nt * 256 + wn * 64 + ni * 32 + 8 * g + 4 * h;
            const uint2 pk =
                make_uint2(pack2(acc[mi][ni][4 * g], acc[mi][ni][4 * g + 1]), pack2(acc[mi][ni][4 * g + 2], acc[mi][ni][4 * g + 3]));
            *(uint2*)(cst + (mi * 32 + l31) * 72 + ni * 32 + 8 * g + 4 * h) = pk;
            if (MT == 4 && nt >= 4 && nt < 12 && ((mi == 0 && l31 == 0) || (mi == 3 && l31 == 31)))
              *(uint2*)((u16*)(p.ws + OFF_HALO) + ((size_t)(m >> 7) * 2 + (mi == 3 ? 1 : 0)) * 2048 + (n - 1024)) = pk;
          }
      }
      {
        const int rr = lane >> 3, c8 = lane & 7;
        u16* ug = u + (size_t)(mt * AROWS + wm * (MT * 32) + rr) * UC + nt * 256 + wn * 64 + c8 * 8;
#pragma unroll
        for (int i = 0; i < MT * 4; ++i) {
          const u32x4 v = *(const u32x4*)(cst + (i * 8 + rr) * 72 + c8 * 8);
          *(u32x4*)(ug + (size_t)(i * 8) * UC) = v;
        }
      }
      __syncthreads();
    } else if (wn == 0) {
      float* dt = (float*)(p.ws + OFF_DT);
#pragma unroll
      for (int mi = 0; mi < MT; ++mi) {
        const int m = mt * AROWS + wm * (MT * 32) + mi * 32 + l31;
#pragma unroll
        for (int g = 0; g < 4; ++g)
          *(float4*)(dt + (size_t)m * 32 + 8 * g + 4 * h) =
              make_float4(acc[mi][0][4 * g], acc[mi][0][4 * g + 1], acc[mi][0][4 * g + 2], acc[mi][0][4 * g + 3]);
      }
    }
  } else {
    float* ob = (float*)(p.ws + OFF_OUTB);
    float* ssq2 = (float*)(p.ws + OFF_SSQ2);
    float* cst = (float*)smem + w * (MT * 32 * 36);
    float ssum[MT];
#pragma unroll
    for (int mi = 0; mi < MT; ++mi) ssum[mi] = 0.f;
#pragma unroll
    for (int ni = 0; ni < 2; ++ni) {
#pragma unroll
      for (int mi = 0; mi < MT; ++mi)
#pragma unroll
        for (int g = 0; g < 4; ++g) {
          const float4 v = make_float4(acc[mi][ni][4 * g], acc[mi][ni][4 * g + 1], acc[mi][ni][4 * g + 2], acc[mi][ni][4 * g + 3]);
          ssum[mi] += v.x * v.x + v.y * v.y + v.z * v.z + v.w * v.w;
          *(float4*)(cst + (mi * 32 + l31) * 36 + 8 * g + 4 * h) = v;
        }
      const int rr = lane >> 3, c4 = lane & 7;
      float* og = ob + (size_t)(mt * AROWS + wm * (MT * 32) + rr) * DM + nt * 256 + wn * 64 + ni * 32 + c4 * 4;
#pragma unroll
      for (int i = 0; i < MT * 4; ++i) {
        const float4 v = *(const float4*)(cst + (i * 8 + rr) * 36 + c4 * 4);
        *(float4*)(og + (size_t)(i * 8) * DM) = v;
      }
    }
#pragma unroll
    for (int mi = 0; mi < MT; ++mi) {
      const int m = mt * AROWS + wm * (MT * 32) + mi * 32 + l31;
      float s = ssum[mi];
      s += __shfl_xor(s, 32);
      if (h == 0) ssq2[(size_t)m * 16 + nt * 4 + wn] = s;
    }
    __syncthreads();
  }
}

__device__ __forceinline__ void phase_conv(const Params& p) {
  const int tid = otid();
  const int c8 = tid & 15, rg = tid >> 4;
  u16* u = (u16*)(p.ws + OFF_U);
  const u16* halo = (const u16*)(p.ws + OFF_HALO);
#pragma unroll 1
  for (int id = blockIdx.x; id < 96 * 16; id += gridDim.x) {
    const int c = id >> 4, strip = id & 15;
    const bool first = (c < 32) ? ((c & 1) == 0) : (((c - 32) & 7) == 0);
    const bool last = (c < 32) ? ((c & 1) == 1) : (((c - 32) & 7) == 7);
    const int ch = strip * 128 + c8 * 8;
    u16* up = u + (size_t)(c * 128 + rg * 4) * UC + 1024 + ch;
    u32x4 r[6];
    const u32x4 z4 = {0u, 0u, 0u, 0u};
#pragma unroll
    for (int i = 1; i < 5; ++i) r[i] = *(const u32x4*)(up + (ptrdiff_t)(i - 1) * UC);
    if (rg > 0) r[0] = *(const u32x4*)(up - UC);
    else r[0] = first ? z4 : *(const u32x4*)(halo + ((size_t)(c - 1) * 2 + 1) * 2048 + ch);
    if (rg < 31) r[5] = *(const u32x4*)(up + 4 * UC);
    else r[5] = last ? z4 : *(const u32x4*)(halo + ((size_t)(c + 1) * 2) * 2048 + ch);
    float w0[8], w1[8], w2[8], bs[8];
#pragma unroll
    for (int e = 0; e < 8; e += 4) {
      const float4 a = *(const float4*)(p.conv_w + ch + e), b = *(const float4*)(p.conv_w + 2048 + ch + e),
                   cc = *(const float4*)(p.conv_w + 4096 + ch + e), d = *(const float4*)(p.conv_b + ch + e);
      w0[e] = a.x; w0[e + 1] = a.y; w0[e + 2] = a.z; w0[e + 3] = a.w;
      w1[e] = b.x; w1[e + 1] = b.y; w1[e + 2] = b.z; w1[e + 3] = b.w;
      w2[e] = cc.x; w2[e + 1] = cc.y; w2[e + 2] = cc.z; w2[e + 3] = cc.w;
      bs[e] = d.x; bs[e + 1] = d.y; bs[e + 2] = d.z; bs[e + 3] = d.w;
    }
    u32x4 o[4];
#pragma unroll
    for (int i = 0; i < 4; ++i) {
      const unsigned pu[4] = {r[i][0], r[i][1], r[i][2], r[i][3]}, cu[4] = {r[i + 1][0], r[i + 1][1], r[i + 1][2], r[i + 1][3]},
                     nu[4] = {r[i + 2][0], r[i + 2][1], r[i + 2][2], r[i + 2][3]};
      unsigned ov[4];
#pragma unroll
      for (int e2 = 0; e2 < 4; ++e2) {
        const float v0 = w0[2 * e2] * lo_bf(pu[e2]) + w1[2 * e2] * lo_bf(cu[e2]) + w2[2 * e2] * lo_bf(nu[e2]) + bs[2 * e2];
        const float v1 = w0[2 * e2 + 1] * hi_bf(pu[e2]) + w1[2 * e2 + 1] * hi_bf(cu[e2]) + w2[2 * e2 + 1] * hi_bf(nu[e2]) + bs[2 * e2 + 1];
        ov[e2] = pack2(silu_f(v0), silu_f(v1));
      }
      o[i] = u32x4{ov[0], ov[1], ov[2], ov[3]};
    }
    __syncthreads();
#pragma unroll
    for (int i = 0; i < 4; ++i) *(u32x4*)(up + (ptrdiff_t)i * UC) = o[i];
  }
}

constexpr int SC_ARR = 143360;
constexpr int SC_ITEM = SC_ARR + 5632;
constexpr int SC_CW = SC_ARR + 6144;

template <int W>
DI void issue_rows(const u16* __restrict__ u, u32x4* r, const int ucol, const int tok0) {
  constexpr int PC = W / 8, RS = THREADS / PC, NI = 128 / RS;
  const int tid = otid();
  const int c8 = tid % PC, r0 = tid / PC;
  const u16* base = u + (size_t)(tok0 + r0) * UC + ucol + c8 * 8;
#pragma unroll
  for (int i = 0; i < NI; ++i) r[i] = *(const u32x4*)(base + (size_t)i * (RS * UC));
}
template <int W, bool WITHV, bool WITHW>
DI void finish_rows(const u32x4* r, u16* dst, u16* dstw, const int ld, const float* wgt) {
  constexpr int PC = W / 8, RS = THREADS / PC, NI = 128 / RS;
  const int tid = otid();
  const int c8 = tid % PC, r0 = tid / PC;
#pragma unroll
  for (int i = 0; i < NI; ++i) {
    const int row = r0 + RS * i;
    if (WITHV) *(u32x4*)(dst + row * ld + c8 * 8) = r[i];
    if (WITHW) {
      const float wg = wgt[row];
      const unsigned xu[4] = {r[i][0], r[i][1], r[i][2], r[i][3]};
      unsigned o[4];
#pragma unroll
      for (int e = 0; e < 4; ++e) o[e] = pack2(lo_bf(xu[e]) * wg, hi_bf(xu[e]) * wg);
      *(uint4*)(dstw + row * ld + c8 * 8) = make_uint4(o[0], o[1], o[2], o[3]);
    }
  }
}
DI void issue_qk(const u16* __restrict__ u, u32x4* r, const int ucol, const int tok0) {
  const int tid = otid();
  const int row = tid >> 2, pp = tid & 3;
  const int pa = (pp & 1) + (pp >> 1) * 4;
  const u16* up = u + (size_t)(tok0 + row) * UC + ucol;
  r[0] = *(const u32x4*)(up + pa * 8);
  r[1] = *(const u32x4*)(up + pa * 8 + 16);
}
DI void finish_qk(const u32x4* r, const float4* tb, u16* dst, const int ld, const bool rope, const float scale) {
  const int tid = otid();
  const int row = tid >> 2, pp = tid & 3;
  const int pa = (pp & 1) + (pp >> 1) * 4, pb = pa + 2;
  const unsigned au[4] = {r[0][0], r[0][1], r[0][2], r[0][3]}, bu[4] = {r[1][0], r[1][1], r[1][2], r[1][3]};
  const float tf[16] = {tb[0].x, tb[0].y, tb[0].z, tb[0].w, tb[1].x, tb[1].y, tb[1].z, tb[1].w,
                        tb[2].x, tb[2].y, tb[2].z, tb[2].w, tb[3].x, tb[3].y, tb[3].z, tb[3].w};
  float o1[8], o2[8];
#pragma unroll
  for (int e = 0; e < 8; ++e) {
    const float x1 = (e & 1) ? hi_bf(au[e >> 1]) : lo_bf(au[e >> 1]);
    const float x2 = (e & 1) ? hi_bf(bu[e >> 1]) : lo_bf(bu[e >> 1]);
    const float cs = rope ? tf[2 * e] : 1.f, sn = rope ? tf[2 * e + 1] : 0.f;
    o1[e] = (x1 * cs - x2 * sn) * scale;
    o2[e] = (x2 * cs + x1 * sn) * scale;
  }
  *(uint4*)(dst + row * ld + pa * 8) = make_uint4(pack2(o1[0], o1[1]), pack2(o1[2], o1[3]), pack2(o1[4], o1[5]), pack2(o1[6], o1[7]));
  *(uint4*)(dst + row * ld + pb * 8) = make_uint4(pack2(o2[0], o2[1]), pack2(o2[2], o2[3]), pack2(o2[4], o2[5]), pack2(o2[6], o2[7]));
}
template <int N, int P, bool SSD>
__device__ __forceinline__ void scan_item(const Params& p, char* smem, const int stream, const int b, const int hd, const int unit0, int* qctr, int* s_item) {
  constexpr int LQ = N + 8, LV = P + 8;
  constexpr int PT = P / 64, NKS = N / 16, NT = N / 32;
  constexpr int NQ = SSD ? 4 : 2;
  u16* Qs = (u16*)smem;
  u16* Ks = Qs + 128 * LQ;
  u16* Vs = Ks + 128 * LQ;
  u16* Vw = Vs + 128 * LV;
  u16* SfT = Vw + 128 * LV;
  u16* SbT = SfT + P * LQ;
  float* dtf = (float*)(smem + SC_ARR);
  float* dtb = dtf + 128;
  float* cumf = dtb + 128;
  float* cumb = cumf + 128;
  float* ecf = cumb + 128;
  float* ecb = ecf + 128;
  float* wgt = ecb + 128;
  float* fct = (float*)(smem + SC_CW);

  int tid_ = threadIdx.x;
  asm volatile("" : "+v"(tid_));
  const int tid = tid_, lane = tid & 63, w = __builtin_amdgcn_readfirstlane(tid >> 6), l31 = lane & 31, h = lane >> 5;
  const int strip = w & 3, half = w >> 2;
  const int ntile = w % NT, ptile = w / NT;
  const int q4 = (lane & 15) >> 2, p4 = lane & 3, blk = (lane >> 4) & 1;
  const int L = stream ? 1024 : 256, nc = L / 128;
  const int seqbase = stream ? NPR + b * 1024 : b * 256;
  char* wsb = p.ws;
  asm volatile("" : "+s"(wsb));
  const u16* u = (const u16*)(wsb + OFF_U);
  const float* dtraw = (const float*)(wsb + OFF_DT);
  u16* mix = (u16*)(wsb + OFF_MIX);
  float* ssq = (float*)(wsb + OFF_SSQ);
  uint2* dump = (uint2*)(wsb + OFF_DUMP);
  const float4* ropetab = (const float4*)(wsb + OFF_ROPE);

  float Dh = 0.f, lamf = 0.f, lamb = 0.f, bias_d = 0.f, A_d = 0.f;
  const int grp = hd >> 2;
  if (SSD) {
    Dh = p.ssd_D[hd];
    const int d = w & 1;
    bias_d = p.dt_bias[d * 16 + hd];
    A_d = expf(p.A_log[d * 16 + hd]);
  } else {
    lamf = -expf(p.ret_decay[hd]);
    lamb = -expf(p.ret_decay[8 + hd]);
  }

  u32x4 rq[NQ], rk[NQ], rx[4];
  uint2 rdump[4];
  float4 rt[4];
  float rd0 = 0.f, rd1 = 0.f;

  auto issue_loads = [&](const int c, const int sweep) {
    const int tok0 = seqbase + c * 128, t0 = c * 128;
    if (sweep) {
      const uint2* dp = dump + ((size_t)(unit0 + c) * 8 + w) * 256;
#pragma unroll
      for (int g = 0; g < 4; ++g) rdump[g] = dp[g * 64 + lane];
    }
    if (SSD) {
      if (sweep) issue_rows<128>(u, rq, 2560 + grp * 128, tok0);
      issue_rows<128>(u, rk, 2048 + grp * 128, tok0);
      issue_rows<64>(u, rx, 1024 + hd * 64, tok0);
      if (w < 2) {
        const int ol = otid() & 63;
        const int sj0 = (w & 1) ? 127 - 2 * ol : 2 * ol, sj1 = (w & 1) ? 126 - 2 * ol : 2 * ol + 1;
        rd0 = dtraw[(size_t)(tok0 + sj0) * 32 + w * 16 + hd];
        rd1 = dtraw[(size_t)(tok0 + sj1) * 32 + w * 16 + hd];
      }
    } else {
      if (sweep) issue_qk(u, rq, 3072 + hd * 64, tok0);
      issue_qk(u, rk, 3584 + hd * 64, tok0);
      issue_rows<128>(u, rx, 4096 + hd * 128, tok0);
      if (stream) {
        const int ot = otid();
        const int row = ot >> 2, pp = ot & 3;
        const float4* tp = ropetab + ((size_t)(t0 + row) * 32 + (pp >> 1) * 16 + (pp & 1) * 8) / 2;
#pragma unroll
        for (int i = 0; i < 4; ++i) rt[i] = tp[i];
      }
    }
  };

  auto finish_loads = [&](const int c, const int sweep) {
    if (SSD) {
      if (w < 2) {
        const int ol = otid() & 63;
        const int sj0 = (w & 1) ? 127 - 2 * ol : 2 * ol, sj1 = (w & 1) ? 126 - 2 * ol : 2 * ol + 1;
        const float raw0 = rd0 + bias_d, raw1 = rd1 + bias_d;
        const float dt0 = fmaxf(raw0, 0.f) + __logf(1.f + __expf(-fabsf(raw0)));
        const float dt1 = fmaxf(raw1, 0.f) + __logf(1.f + __expf(-fabsf(raw1)));
        const float la0 = -dt0 * A_d, la1 = -dt1 * A_d;
        float s = la0 + la1;
#pragma unroll
        for (int d = 1; d < 64; d <<= 1) {
          const float t = __shfl_up(s, d);
          if (lane >= d) s += t;
        }
        const float tot = __shfl(s, 63);
        const float c1 = s, c0 = s - la1;
        float* dta = w ? dtb : dtf;
        float* cua = w ? cumb : cumf;
        float* eca = w ? ecb : ecf;
        dta[sj0] = dt0; dta[sj1] = dt1;
        cua[sj0] = c0; cua[sj1] = c1;
        eca[sj0] = __expf(c0); eca[sj1] = __expf(c1);
        if (w == sweep) {
          wgt[sj0] = dt0 * __expf(tot - c0);
          wgt[sj1] = dt1 * __expf(tot - c1);
        }
      }
    } else {
      if (tid < 128) {
        const float cf = (float)(tid + 1) * lamf, cb = (float)(128 - tid) * lamb;
        dtf[tid] = 1.f; dtb[tid] = 1.f;
        cumf[tid] = cf; cumb[tid] = cb;
        ecf[tid] = __expf(cf); ecb[tid] = __expf(cb);
        wgt[tid] = sweep ? __expf((float)tid * lamb) : __expf((float)(127 - tid) * lamf);
      }
    }
    __syncthreads();
    if (sweep) {
      const int ot = otid();
      const int s = ot >> 7, j = ot & 127;
      float val = 0.f;
      if (j < s * 32) val = dtf[j] * __expf(cumf[s * 32 - 1] - cumf[j]);
      else if (j >= s * 32 + 32) val = dtb[j] * __expf(cumb[s * 32 + 32] - cumb[j]);
      fct[ot] = val;
    }
    if (SSD) {
      if (sweep) finish_rows<128, true, false>(rq, Qs, nullptr, LQ, nullptr);
      finish_rows<128, true, false>(rk, Ks, nullptr, LQ, nullptr);
      if (sweep) finish_rows<64, true, true>(rx, Vs, Vw, LV, wgt);
      else finish_rows<64, false, true>(rx, Vs, Vw, LV, wgt);
    } else {
      if (sweep) finish_qk(rq, rt, Qs, LQ, stream != 0, 1.f);
      finish_qk(rk, rt, Ks, LQ, stream != 0, 0.125f);
      if (sweep) finish_rows<128, true, true>(rx, Vs, Vw, LV, wgt);
      else finish_rows<128, false, true>(rx, Vs, Vw, LV, wgt);
    }
    if (sweep) {
#pragma unroll
      for (int g = 0; g < 4; ++g) *(uint2*)(SfT + (ptile * 32 + l31) * LQ + ntile * 32 + 8 * g + 4 * h) = rdump[g];
    }
    __syncthreads();
  };

  auto state_update = [&](f32x16& S, const float dec) {
#pragma unroll
    for (int r = 0; r < 16; ++r) S[r] *= dec;
    const u16* ka0 = Ks + (8 * h + q4) * LQ + ntile * 32 + 16 * blk + 4 * p4;
    const u16* vb0 = Vw + (8 * h + q4) * LV + ptile * 32 + 16 * blk + 4 * p4;
    s16x4 ta[8][2], tb[8][2];
#pragma unroll
    for (int ks = 0; ks < 8; ++ks) {
      ta[ks][0] = tr_read(ka0 + ks * 16 * LQ);
      ta[ks][1] = tr_read(ka0 + ks * 16 * LQ + 4 * LQ);
      tb[ks][0] = tr_read(vb0 + ks * 16 * LV);
      tb[ks][1] = tr_read(vb0 + ks * 16 * LV + 4 * LV);
    }
    __builtin_amdgcn_sched_barrier(0);
#pragma unroll
    for (int ks = 0; ks < 8; ++ks) S = MFMA32(cat8(ta[ks][0], ta[ks][1]), cat8(tb[ks][0], tb[ks][1]), S);
    __builtin_amdgcn_sched_barrier(0);
  };

  auto load_state = [&](f32x16& S, const int dir) {
    if (stream) {
      const float* sp = SSD ? p.state_ssd + ((size_t)((b * 2 + dir) * 16 + hd)) * 128 * 64
                            : p.state_ret + ((size_t)((b * 2 + dir) * 8 + hd)) * 64 * 128;
#pragma unroll
      for (int r = 0; r < 16; ++r) S[r] = sp[(ntile * 32 + crow(r, h)) * P + ptile * 32 + l31];
    } else {
#pragma unroll
      for (int r = 0; r < 16; ++r) S[r] = 0.f;
    }
  };
  auto store_state = [&](const f32x16& S, const int dir) {
    if (!stream) {
      float* op = SSD ? p.out + (size_t)NTOK * DM + ((size_t)((b * 2 + dir) * 16 + hd)) * 128 * 64
                      : p.out + (size_t)NTOK * DM + (size_t)16 * 2 * 16 * 128 * 64 + ((size_t)((b * 2 + dir) * 8 + hd)) * 64 * 128;
#pragma unroll
      for (int r = 0; r < 16; ++r) op[(ntile * 32 + crow(r, h)) * P + ptile * 32 + l31] = S[r];
    }
  };

  f32x16 S;
  issue_loads(0, 0);
  load_state(S, 0);
#pragma unroll 1
  for (int c = 0; c < nc; ++c) {
    finish_loads(c, 0);
    {
      uint2* dp = dump + ((size_t)(unit0 + c) * 8 + w) * 256;
#pragma unroll
      for (int g = 0; g < 4; ++g) dp[g * 64 + lane] = make_uint2(pack2(S[4 * g], S[4 * g + 1]), pack2(S[4 * g + 2], S[4 * g + 3]));
    }
    if (c + 1 < nc) issue_loads(c + 1, 0);
    else {
      issue_loads(nc - 1, 1);
#pragma unroll
      for (int g = 0; g < 4; ++g) rdump[g] = make_uint2(pack2(S[4 * g], S[4 * g + 1]), pack2(S[4 * g + 2], S[4 * g + 3]));
    }
    state_update(S, __expf(cumf[127]));
    __syncthreads();
  }
  store_state(S, 0);

  load_state(S, 1);
#pragma unroll
  for (int g = 0; g < 4; ++g)
    *(uint2*)(SbT + (ptile * 32 + l31) * LQ + ntile * 32 + 8 * g + 4 * h) =
        make_uint2(pack2(S[4 * g], S[4 * g + 1]), pack2(S[4 * g + 2], S[4 * g + 3]));
  int nextq = 0;
#pragma unroll 1
  for (int c = nc - 1; c >= 0; --c) {
    const int tok0 = seqbase + c * 128;
    finish_loads(c, 1);
    if (c == 0 && threadIdx.x == 0) nextq = atomicAdd(qctr, 1);
    if (c > 0) issue_loads(c - 1, 1);

    const u16* qrow = Qs + (strip * 32 + l31) * LQ + h * 8;
    constexpr bool SJ = SSD;
    constexpr int YT = SJ ? 2 : PT;
    f32x16 Y[YT];
    if constexpr (SJ) {
      const u16* Sx = half ? SbT : SfT;
      const float* ex = half ? ecb : ecf;
#pragma unroll
      for (int pt = 0; pt < 2; ++pt) {
        const int prow = pt * 32 + l31;
        bf16x8 fq[NKS], fs[NKS];
#pragma unroll
        for (int ks = 0; ks < NKS; ++ks) {
          fq[ks] = *(const bf16x8*)(qrow + ks * 16);
          fs[ks] = *(const bf16x8*)(Sx + prow * LQ + ks * 16 + h * 8);
        }
        __builtin_amdgcn_sched_barrier(0);
        f32x16 a1;
#pragma unroll
        for (int r = 0; r < 16; ++r) a1[r] = 0.f;
#pragma unroll
        for (int ks = 0; ks < NKS; ++ks) a1 = MFMA32(fq[ks], fs[ks], a1);
        __builtin_amdgcn_sched_barrier(0);
#pragma unroll
        for (int g = 0; g < 4; ++g) {
          const float4 ef = *(const float4*)(ex + strip * 32 + 8 * g + 4 * h);
          Y[pt][4 * g + 0] = ef.x * a1[4 * g + 0];
          Y[pt][4 * g + 1] = ef.y * a1[4 * g + 1];
          Y[pt][4 * g + 2] = ef.z * a1[4 * g + 2];
          Y[pt][4 * g + 3] = ef.w * a1[4 * g + 3];
        }
      }
    } else {
#pragma unroll
    for (int pt = 0; pt < PT; ++pt) {
      const int prow = (half * PT + pt) * 32 + l31;
      bf16x8 fq[NKS], fs[NKS];
      {
#pragma unroll
        for (int ks = 0; ks < NKS; ++ks) {
          fq[ks] = *(const bf16x8*)(qrow + ks * 16);
          fs[ks] = *(const bf16x8*)(SfT + prow * LQ + ks * 16 + h * 8);
        }
        __builtin_amdgcn_sched_barrier(0);
        f32x16 a1;
#pragma unroll
        for (int r = 0; r < 16; ++r) a1[r] = 0.f;
#pragma unroll
        for (int ks = 0; ks < NKS; ++ks) a1 = MFMA32(fq[ks], fs[ks], a1);
        __builtin_amdgcn_sched_barrier(0);
#pragma unroll
        for (int ks = 0; ks < NKS; ++ks) fs[ks] = *(const bf16x8*)(SbT + prow * LQ + ks * 16 + h * 8);
#pragma unroll
        for (int g = 0; g < 4; ++g) {
          const float4 ef = *(const float4*)(ecf + strip * 32 + 8 * g + 4 * h);
          Y[pt][4 * g + 0] = ef.x * a1[4 * g + 0];
          Y[pt][4 * g + 1] = ef.y * a1[4 * g + 1];
          Y[pt][4 * g + 2] = ef.z * a1[4 * g + 2];
          Y[pt][4 * g + 3] = ef.w * a1[4 * g + 3];
        }
      }
      {
        __builtin_amdgcn_sched_barrier(0);
        f32x16 a2;
#pragma unroll
        for (int r = 0; r < 16; ++r) a2[r] = 0.f;
#pragma unroll
        for (int ks = 0; ks < NKS; ++ks) a2 = MFMA32(fq[ks], fs[ks], a2);
        __builtin_amdgcn_sched_barrier(0);
#pragma unroll
        for (int g = 0; g < 4; ++g) {
          const float4 eb = *(const float4*)(ecb + strip * 32 + 8 * g + 4 * h);
          Y[pt][4 * g + 0] += eb.x * a2[4 * g + 0];
          Y[pt][4 * g + 1] += eb.y * a2[4 * g + 1];
          Y[pt][4 * g + 2] += eb.z * a2[4 * g + 2];
          Y[pt][4 * g + 3] += eb.w * a2[4 * g + 3];
        }
      }
    }
    }
    const int ii = strip * 32 + l31;
    const float cfi = cumf[ii], cbi = cumb[ii];

#pragma unroll 1
    for (int jj = 0; jj < (SJ ? 2 : 4); ++jj) {
      const int jt = SJ ? half * 2 + jj : jj;
      f32x16 G;
#pragma unroll
      for (int r = 0; r < 16; ++r) G[r] = 0.f;
      s16x4 tv[YT][4];
      {
        bf16x8 fk[NKS], fq[NKS];
#pragma unroll
        for (int ks = 0; ks < NKS; ++ks) {
          fk[ks] = *(const bf16x8*)(Ks + (jt * 32 + l31) * LQ + ks * 16 + h * 8);
          fq[ks] = *(const bf16x8*)(qrow + ks * 16);
        }
        __builtin_amdgcn_sched_barrier(0);
#pragma unroll
        for (int ks = 0; ks < NKS; ++ks) G = MFMA32(fk[ks], fq[ks], G);
        __builtin_amdgcn_sched_barrier(0);
#pragma unroll
        for (int pt = 0; pt < YT; ++pt) {
          const u16* vp = Vs + (jt * 32 + 4 * h + q4) * LV + (SJ ? pt : half * PT + pt) * 32 + 16 * blk + 4 * p4;
          tv[pt][0] = tr_read(vp);
          tv[pt][1] = tr_read(vp + 8 * LV);
          tv[pt][2] = tr_read(vp + 16 * LV);
          tv[pt][3] = tr_read(vp + 24 * LV);
        }
        __builtin_amdgcn_sched_barrier(0);
      }
      if (jt == strip) {
#pragma unroll
        for (int g = 0; g < 4; ++g) {
          const int jb = jt * 32 + 8 * g + 4 * h;
          const float4 cf4 = *(const float4*)(cumf + jb), cb4 = *(const float4*)(cumb + jb);
          const float4 df4 = *(const float4*)(dtf + jb), db4 = *(const float4*)(dtb + jb);
          const float cfa[4] = {cf4.x, cf4.y, cf4.z, cf4.w}, cba[4] = {cb4.x, cb4.y, cb4.z, cb4.w};
          const float dfa[4] = {df4.x, df4.y, df4.z, df4.w}, dba[4] = {db4.x, db4.y, db4.z, db4.w};
#pragma unroll
          for (int e = 0; e < 4; ++e) {
            const int j = jb + e;
            const float tf = __expf(cfi - cfa[e]) * dfa[e];
            const float tb = __expf(cbi - cba[e]) * dba[e];
            const float m = ((ii >= j) ? tf : 0.f) + ((ii <= j) ? tb : 0.f);
            float pv = G[4 * g + e] * m;
            if (SSD && ii == j) pv += Dh;
            G[4 * g + e] = pv;
          }
        }
      } else {
        const float ei = (jt < strip) ? __expf(cfi - cumf[strip * 32 - 1]) : __expf(cbi - cumb[strip * 32 + 32]);
#pragma unroll
        for (int g = 0; g < 4; ++g) {
          const float4 f4 = *(const float4*)(fct + strip * 128 + jt * 32 + 8 * g + 4 * h);
          G[4 * g + 0] *= ei * f4.x;
          G[4 * g + 1] *= ei * f4.y;
          G[4 * g + 2] *= ei * f4.z;
          G[4 * g + 3] *= ei * f4.w;
        }
      }
      const bf16x8 pf0 = pack8(G[0], G[1], G[2], G[3], G[4], G[5], G[6], G[7]);
      const bf16x8 pf1 = pack8(G[8], G[9], G[10], G[11], G[12], G[13], G[14], G[15]);
#pragma unroll
      for (int pt = 0; pt < YT; ++pt) {
        Y[pt] = MFMA32(pf0, cat8(tv[pt][0], tv[pt][1]), Y[pt]);
        Y[pt] = MFMA32(pf1, cat8(tv[pt][2], tv[pt][3]), Y[pt]);
      }
    }
    state_update(S, __expf(cumb[0]));
    constexpr int CPR = P / 8, NIT = 128 * CPR / THREADS;
    const int ec8 = tid % CPR, er0 = tid / CPR;
    const int ecol = SSD ? hd * 64 + ec8 * 8 : hd * 128 + ec8 * 8;
    uint4 gz[NIT];
#pragma unroll
    for (int i = 0; i < NIT; ++i)
      gz[i] = *(const uint4*)(u + (size_t)(tok0 + er0 + i * (THREADS / CPR)) * UC + (SSD ? 0 : 5120) + ecol);
    const float* nwp = SSD ? p.ssd_norm_w + ecol : p.ret_norm_w + ecol;
    const float4 n0 = *(const float4*)nwp, n1 = *(const float4*)(nwp + 4);
    const float nw[8] = {n0.x, n0.y, n0.z, n0.w, n1.x, n1.y, n1.z, n1.w};
    __syncthreads();
#pragma unroll
    for (int g = 0; g < 4; ++g)
      *(uint2*)(SbT + (ptile * 32 + l31) * LQ + ntile * 32 + 8 * g + 4 * h) =
          make_uint2(pack2(S[4 * g], S[4 * g + 1]), pack2(S[4 * g + 2], S[4 * g + 3]));
    constexpr int LY = P + 4;
    float* Yst = (float*)smem;
#pragma unroll
    for (int pt = 0; pt < YT; ++pt)
#pragma unroll
      for (int r = 0; r < 16; ++r)
        Yst[(SJ ? half * (128 * LY) : 0) + (strip * 32 + crow(r, h)) * LY + (SJ ? pt : half * PT + pt) * 32 + l31] = Y[pt][r];
    __syncthreads();
#pragma unroll
    for (int i = 0; i < NIT; ++i) {
      const int row = er0 + i * (THREADS / CPR);
      const float* yp = Yst + row * LY + ec8 * 8;
      const float4 y0 = *(const float4*)yp, y1 = *(const float4*)(yp + 4);
      float v[8] = {y0.x, y0.y, y0.z, y0.w, y1.x, y1.y, y1.z, y1.w};
      if constexpr (SJ) {
        const float4 z0 = *(const float4*)(yp + 128 * LY), z1 = *(const float4*)(yp + 128 * LY + 4);
        v[0] += z0.x; v[1] += z0.y; v[2] += z0.z; v[3] += z0.w;
        v[4] += z1.x; v[5] += z1.y; v[6] += z1.z; v[7] += z1.w;
      }
      const size_t tok = (size_t)(tok0 + row);
      const unsigned zu[4] = {gz[i].x, gz[i].y, gz[i].z, gz[i].w};
      if (SSD) {
        float sq = 0.f;
#pragma unroll
        for (int e = 0; e < 8; ++e) {
          const float z = (e & 1) ? hi_bf(zu[e >> 1]) : lo_bf(zu[e >> 1]);
          v[e] *= silu_f(z);
          sq += v[e] * v[e];
        }
        sq += __shfl_xor(sq, 1);
        sq += __shfl_xor(sq, 2);
        sq += __shfl_xor(sq, 4);
        if (ec8 == 0) ssq[tok * 16 + hd] = sq;
        *(uint4*)(mix + tok * 2048 + ecol) = make_uint4(pack2(v[0] * nw[0], v[1] * nw[1]), pack2(v[2] * nw[2], v[3] * nw[3]),
                                                        pack2(v[4] * nw[4], v[5] * nw[5]), pack2(v[6] * nw[6], v[7] * nw[7]));
      } else {
        float s = 0.f;
#pragma unroll
        for (int e = 0; e < 8; ++e) s += v[e];
        s += __shfl_xor(s, 1);
        s += __shfl_xor(s, 2);
        s += __shfl_xor(s, 4);
        s += __shfl_xor(s, 8);
        const float mean = s * (1.f / 128.f);
        float s2 = 0.f;
#pragma unroll
        for (int e = 0; e < 8; ++e) {
          v[e] -= mean;
          s2 += v[e] * v[e];
        }
        s2 += __shfl_xor(s2, 1);
        s2 += __shfl_xor(s2, 2);
        s2 += __shfl_xor(s2, 4);
        s2 += __shfl_xor(s2, 8);
        const float rstd = rsqrtf(s2 * (1.f / 128.f) + 1e-6f);
#pragma unroll
        for (int e = 0; e < 8; ++e) {
          const float gv = (e & 1) ? hi_bf(zu[e >> 1]) : lo_bf(zu[e >> 1]);
          v[e] = v[e] * rstd * nw[e] * silu_f(gv);
        }
        *(uint4*)(mix + tok * 2048 + 1024 + ecol) =
            make_uint4(pack2(v[0], v[1]), pack2(v[2], v[3]), pack2(v[4], v[5]), pack2(v[6], v[7]));
      }
    }
  }
  store_state(S, 1);
  if (threadIdx.x == 0) *s_item = nextq;
}

__device__ __forceinline__ void phase3(const Params& p, char* smem, const int ctr_idx) {
  int* s_item = (int*)(smem + SC_ITEM);
  int* ctr = (int*)(p.ws + OFF_CTR) + ctr_idx;
  if (threadIdx.x == 0) *s_item = atomicAdd(ctr, 1);
  __syncthreads();
#pragma unroll 1
  for (;;) {
    const int q = *s_item;
    __syncthreads();
    if (q >= 576) break;
    int kind, stream, bb, hd, unit0;
    if (q < 128) { kind = 0; stream = 1; bb = q >> 4; hd = q & 15; unit0 = q * 8; }
    else if (q < 192) { kind = 1; stream = 1; bb = (q - 128) >> 3; hd = (q - 128) & 7; unit0 = 1024 + (q - 128) * 8; }
    else if (q < 448) { kind = 0; stream = 0; bb = (q - 192) >> 4; hd = (q - 192) & 15; unit0 = 1536 + (q - 192) * 2; }
    else { kind = 1; stream = 0; bb = (q - 448) >> 3; hd = (q - 448) & 7; unit0 = 2048 + (q - 448) * 2; }
    if (kind == 0) scan_item<128, 64, true>(p, smem, stream, bb, hd, unit0, ctr, s_item);
    else scan_item<64, 128, false>(p, smem, stream, bb, hd, unit0, ctr, s_item);
    __syncthreads();
  }
}

__device__ __forceinline__ void phase5(const Params& p) {
  const int tid = otid(), lane = tid & 63, w = tid >> 6;
  const float* mod = (const float*)(p.ws + OFF_MOD);
  const float* ob = (const float*)(p.ws + OFF_OUTB);
  const float* ssq2 = (const float*)(p.ws + OFF_SSQ2);
  for (int row = blockIdx.x * 8 + w; row < NTOK; row += gridDim.x * 8) {
    const float* xr = (row < NPR) ? p.x_prompt + (size_t)row * DM : p.x_sample + (size_t)(row - NPR) * DM;
    const int mr = (row < NPR) ? 0 : 1 + ((row - NPR) >> 10);
    float s = (lane < 16) ? ssq2[(size_t)row * 16 + lane] : 0.f;
#pragma unroll
    for (int m = 8; m >= 1; m >>= 1) s += __shfl_xor(s, m);
    s = __shfl(s, 0);
    const float rstd = rsqrtf(s * (1.f / 1024.f) + 1e-6f);
#pragma unroll
    for (int i = 0; i < 4; ++i) {
      const int k = (i * 64 + lane) * 4;
      const float4 xv = *(const float4*)(xr + k);
      const float4 ov = *(const float4*)(ob + (size_t)row * DM + k);
      const float4 nw = *(const float4*)(p.norm_post_w + k);
      const float4 gt = *(const float4*)(mod + mr * 3072 + 2048 + k);
      float4 y;
      y.x = xv.x + gt.x * ov.x * rstd * nw.x;
      y.y = xv.y + gt.y * ov.y * rstd * nw.y;
      y.z = xv.z + gt.z * ov.z * rstd * nw.z;
      y.w = xv.w + gt.w * ov.w * rstd * nw.w;
      *(float4*)(p.out + (size_t)row * DM + k) = y;
    }
  }
}

__global__ void __launch_bounds__(THREADS) fwd_megakernel(Params p) {
  extern __shared__ __attribute__((aligned(16))) char smem[];
  cg::grid_group grid = cg::this_grid();
  const int G = gridDim.x;
  const int bx = blockIdx.x;
  const int rb = (G % 8 == 0) ? (bx % 8) * (G / 8) + bx / 8 : bx;

  unsigned* gbar = (unsigned*)(p.ws + OFF_CTR + 1024);
  unsigned epoch = 0u;
  volatile LAS unsigned* xst = (volatile LAS unsigned*)(smem + 153984);
  if (threadIdx.x == 0) { xst[0] = 0u; xst[1] = 0u; xst[2] = 0u; xst[3] = 0u; }
  __syncthreads();
  const XcdBarrier xb = xcd_barrier_post((unsigned*)(p.ws + OFF_CTR + 8192), xst);
  if (p.ws == nullptr) grid.sync();
  phase0(p, smem);
#if PROBE == 5
  phase0(p, smem);
  xcd_barrier(xb);
#endif
#if PROBE == 4
  for (int i = 0; i < 10; ++i) xcd_barrier(xb);
#endif
  phase1(p);
  xcd_barrier(xb);
#if PROBE == 6
  phase1(p);
  xcd_barrier(xb);
#endif
  {
    u32x4 sra[4], srb[4];
    bool have0 = false;
    for (int id = rb; id < 48 * 25; id += G) {
      const int band = id / 200, rem = id % 200;
      const int id2 = id + G;
      const bool has2 = id2 < 48 * 25;
      const int band2 = id2 / 200, rem2 = id2 % 200;
      gemm_tile<0, 4>(p, (const u16*)(p.ws + OFF_H), (const u16*)(p.ws + OFF_WTIN), 1024, band * 8 + (rem & 7), rem >> 3, smem, sra, srb,
                      have0, has2, band2 * 8 + (rem2 & 7), rem2 >> 3);
      have0 = has2;
    }
  }
  {
    const int nfull = (48 * 25) % G;
    const int nhelp = (nfull > 0) ? G - nfull : G;
    const int hb = (nfull > 0) ? rb - nfull : rb;
    if (hb >= 0)
      for (int q = hb; q < 512; q += nhelp)
        p0_transpose_item(p.w_out, 1024, (u16*)(p.ws + OFF_WTOUT), 2048, q / 16, q % 16, 1024, false, smem);
  }
  xcd_barrier(xb);
#if PROBE == 1
  for (int id = rb; id < 48 * 25; id += G) {
    const int band = id / 200, rem = id % 200;
    u32x4 sra[4], srb[4];
    gemm_tile<0, 4>(p, (const u16*)(p.ws + OFF_H), (const u16*)(p.ws + OFF_WTIN), 1024, band * 8 + (rem & 7), rem >> 3, smem, sra, srb, false, false, 0, 0);
  }
  xcd_barrier(xb);
#endif
  phase_conv(p);
  xcd_barrier(xb);
  phase3(p, smem, 0);
#if PROBE == 2
  phase3(p, smem, 1);
#endif
  xcd_barrier(xb);
#if PROBE == 3
  for (int id = rb; id < 64 * 4; id += G)
  {
    u32x4 sra[3], srb[4];
    gemm_tile<1, 3>(p, (const u16*)(p.ws + OFF_MIX), (const u16*)(p.ws + OFF_WTOUT), 2048, id >> 2, id & 3, smem, sra, srb, false, false, 0, 0);
  }
  xcd_barrier(xb);
#endif
  for (int id = rb; id < 64 * 4; id += G)
  {
    u32x4 sra[3], srb[4];
    gemm_tile<1, 3>(p, (const u16*)(p.ws + OFF_MIX), (const u16*)(p.ws + OFF_WTOUT), 2048, id >> 2, id & 3, smem, sra, srb, false, false, 0, 0);
  }
  xcd_barrier(xb);
  phase5(p);
#if PROBE == 7
  phase5(p);
#endif
}

extern "C" void kernel_launch(void* const* d_in, const int* in_sizes, int n_in, void* d_out, int out_size, void* d_ws,
                              size_t ws_size, hipStream_t stream) {
  static int grid_blocks = 0;
  if (!grid_blocks) {
    int dev = 0, cus = 0, per_cu = 0;
    hipGetDevice(&dev);
    hipDeviceGetAttribute(&cus, hipDeviceAttributeMultiprocessorCount, dev);
    hipFuncSetAttribute((const void*)fwd_megakernel, hipFuncAttributeMaxDynamicSharedMemorySize, SMEM_BYTES);
    hipOccupancyMaxActiveBlocksPerMultiprocessor(&per_cu, fwd_megakernel, THREADS, SMEM_BYTES);
    if (per_cu < 1) per_cu = 1;
    grid_blocks = cus * per_cu;
  }
  Params p{};
  const float* const* in = (const float* const*)d_in;
  p.x_prompt = in[0]; p.x_sample = in[1]; p.state_ssd = in[2]; p.state_ret = in[3]; p.c = in[4]; p.c_ctx = in[5];
  p.w_mod = in[6]; p.b_mod = in[7]; p.norm_pre_w = in[8]; p.norm_post_w = in[9]; p.w_in = in[10]; p.conv_w = in[11];
  p.conv_b = in[12]; p.A_log = in[13]; p.dt_bias = in[14]; p.ssd_D = in[15]; p.ssd_norm_w = in[16]; p.ret_decay = in[17];
  p.ret_norm_w = in[18]; p.w_out = in[19];
  p.out = (float*)d_out;
  p.ws = (char*)d_ws;
  hipMemsetAsync((char*)d_ws + OFF_CTR, 0, 8192 + 16384, stream);
  void* args[] = {&p};
  hipError_t e = hipLaunchCooperativeKernel((void*)fwd_megakernel, dim3(grid_blocks), dim3(THREADS), args, SMEM_BYTES, stream);
  if (e != hipSuccess) fprintf(stderr, "cooperative launch failed: %s (grid %d)\n", hipGetErrorString(e), grid_blocks);
}
```

```cpp
#include <hip/hip_runtime.h>
#include <hip/hip_cooperative_groups.h>
#include <cstdio>
namespace cg = cooperative_groups;

typedef unsigned short u16;
typedef __bf16 bf16v2 __attribute__((ext_vector_type(2)));
typedef float f32v2 __attribute__((ext_vector_type(2)));
typedef short s16x4 __attribute__((ext_vector_type(4)));
using bf16x8 = __attribute__((ext_vector_type(8))) short;
using f32x16 = __attribute__((ext_vector_type(16))) float;
using u32x4 = __attribute__((ext_vector_type(4))) unsigned;
#define DI __device__ __forceinline__
#define MFMA32(a, b, c) __builtin_amdgcn_mfma_f32_32x32x16_bf16((a), (b), (c), 0, 0, 0)

constexpr int NTOK = 12288;
constexpr int NPR = 4096;
constexpr int DM = 1024;
constexpr int INC = 6176;
constexpr int UC = 6144;
#ifndef PROBE
#define PROBE 0
#endif
constexpr int THREADS = 512;
constexpr int SMEM_BYTES = 152 * 1024;

constexpr size_t OFF_MOD = 0;
constexpr size_t OFF_ROPE = 131072;
constexpr size_t OFF_CTR = 393216;
constexpr size_t OFF_H = 524288;
constexpr size_t OFF_WTIN = OFF_H + 25165824;
constexpr size_t OFF_DUMP = OFF_H;
constexpr size_t OFF_WTOUT = OFF_WTIN + 13107200;
constexpr size_t OFF_U = OFF_WTOUT + 4194304;
constexpr size_t OFF_OUTB = OFF_U;
constexpr size_t OFF_DT = OFF_U + 150994944;
constexpr size_t OFF_MIX = OFF_DT + 1572864;
constexpr size_t OFF_SSQ = OFF_MIX + 50331648;
constexpr size_t OFF_SSQ2 = OFF_SSQ + 1572864;
constexpr size_t OFF_HALO = OFF_SSQ2 + 786432;

struct Params {
  const float *x_prompt, *x_sample, *state_ssd, *state_ret, *c, *c_ctx, *w_mod, *b_mod, *norm_pre_w, *norm_post_w,
      *w_in, *conv_w, *conv_b, *A_log, *dt_bias, *ssd_D, *ssd_norm_w, *ret_decay, *ret_norm_w, *w_out;
  float* out;
  char* ws;
};

DI float bf2f(u16 v) { return __uint_as_float(((unsigned)v) << 16); }
DI unsigned pack2(float a, float b) {
  f32v2 f = {a, b};
  bf16v2 r = __builtin_convertvector(f, bf16v2);
  return __builtin_bit_cast(unsigned, r);
}
DI u16 f2bf(float a) { return (u16)(pack2(a, 0.f) & 0xffffu); }
DI float lo_bf(unsigned v) { return __uint_as_float(v << 16); }
DI float hi_bf(unsigned v) { return __uint_as_float(v & 0xffff0000u); }
DI float silu_f(float v) { return v * __builtin_amdgcn_rcpf(1.f + __expf(-v)); }
DI int crow(int r, int h) { return (r & 3) + 8 * (r >> 2) + 4 * h; }
DI int otid() {
  int t = threadIdx.x;
  asm volatile("" : "+v"(t));
  return t;
}
DI s16x4 tr_read(const u16* p) {
  return __builtin_amdgcn_ds_read_tr16_b64_v4i16((s16x4 __attribute__((address_space(3)))*)(p));
}
DI bf16x8 cat8(s16x4 lo, s16x4 hi) { return __builtin_shufflevector(lo, hi, 0, 1, 2, 3, 4, 5, 6, 7); }
DI bf16x8 pack8(float a0, float a1, float a2, float a3, float a4, float a5, float a6, float a7) {
  uint4 v = make_uint4(pack2(a0, a1), pack2(a2, a3), pack2(a4, a5), pack2(a6, a7));
  return __builtin_bit_cast(bf16x8, v);
}


DI void grid_barrier(unsigned* bar, unsigned& epoch) {
  asm volatile("s_waitcnt vmcnt(0)" ::: "memory");
  __syncthreads();
  if (threadIdx.x == 0) {
    __builtin_amdgcn_fence(__ATOMIC_RELEASE, "agent");
    asm volatile("s_waitcnt vmcnt(0)" ::: "memory");
    const unsigned G = gridDim.x;
    const unsigned ng = (G % 8u == 0u) ? 8u : 1u;
    const unsigned gs = G / ng, g = blockIdx.x % ng, e1 = epoch + 1u;
    const unsigned old = __hip_atomic_fetch_add(&bar[64u * (1u + g)], 1u, __ATOMIC_RELAXED, __HIP_MEMORY_SCOPE_AGENT);
    if (old + 1u == gs * e1) {
      const unsigned o2 = __hip_atomic_fetch_add(&bar[0], 1u, __ATOMIC_RELAXED, __HIP_MEMORY_SCOPE_AGENT);
      if (o2 + 1u == ng * e1) __hip_atomic_fetch_add(&bar[64u * 16u], 1u, __ATOMIC_RELAXED, __HIP_MEMORY_SCOPE_AGENT);
    }
    while (__hip_atomic_load(&bar[64u * 16u], __ATOMIC_RELAXED, __HIP_MEMORY_SCOPE_AGENT) < e1) __builtin_amdgcn_s_sleep(1);
    __builtin_amdgcn_fence(__ATOMIC_ACQUIRE, "agent");
    asm volatile("s_waitcnt vmcnt(0)" ::: "memory");
  }
  __syncthreads();
  ++epoch;
}


#define XB_TMO      128
#define XB_XCNT(j)  (256  + 64 * (j))
#define XB_XSUB(j)  (1280 + 64 * (j))
#define XB_XGEN(j)  (2304 + 64 * (j))
#define XB_TOP      3328
#define XB_TOPGEN   3392
#define XB_SPIN_CAP (1u << 22)
#define LAS __attribute__((address_space(3)))
DI unsigned xb_ld(unsigned* p) { return __hip_atomic_load(p, __ATOMIC_RELAXED, __HIP_MEMORY_SCOPE_AGENT); }
DI unsigned xb_add(unsigned* p, unsigned v) { return __hip_atomic_fetch_add(p, v, __ATOMIC_RELAXED, __HIP_MEMORY_SCOPE_AGENT); }
DI unsigned xb_xcc_id() { return (unsigned)__builtin_amdgcn_s_getreg((3 << 11) | 20) & 0xFu; }
#define XB_SPIN(cond, bar) do { unsigned _sp = 0; while (cond) { __builtin_amdgcn_s_sleep(1); \
    if ((++_sp & 255u) == 0u) { if (xb_ld(&(bar)[XB_TMO])) break; if (_sp > XB_SPIN_CAP) { atomicAdd(&(bar)[XB_TMO], 1u); break; } } } } while (0)
struct XcdBarrier { unsigned* bar; unsigned x; volatile LAS unsigned* st; };
DI XcdBarrier xcd_barrier_post(unsigned* bar, volatile LAS unsigned* st) {
  XcdBarrier b; b.bar = bar; b.x = xb_xcc_id(); b.st = st;
  if (threadIdx.x == 0) (void)xb_add(&bar[XB_XCNT(b.x)], 1u);
  return b;
}
DI void xcd_barrier_complete(unsigned* bar, unsigned x, unsigned& nloc, unsigned& nx) {
  const unsigned G = gridDim.x;
  unsigned sum, cnt, mine, sp = 0u;
  for (;;) {
    sum = 0u; cnt = 0u; mine = 0u;
#pragma unroll
    for (unsigned j = 0; j < 16; ++j) { const unsigned c = xb_ld(&bar[XB_XCNT(j)]); sum += c; cnt += (c > 0u) ? 1u : 0u; mine = (j == x) ? c : mine; }
    if (sum == G) break;
    __builtin_amdgcn_s_sleep(1);
    if ((++sp & 255u) == 0u) { if (xb_ld(&bar[XB_TMO])) break; if (sp > XB_SPIN_CAP) { atomicAdd(&bar[XB_TMO], 1u); break; } }
  }
  nloc = mine > 0u ? mine : 1u; nx = cnt > 0u ? cnt : 1u;
}
DI void xcd_barrier(const XcdBarrier& b) {
  asm volatile("s_waitcnt vmcnt(0)" ::: "memory");
  __syncthreads();
  if (threadIdx.x == 0) {
    unsigned* bar = b.bar;
    __builtin_amdgcn_s_waitcnt(0);
    unsigned nloc = b.st[0], nx = b.st[1];
    if (nloc == 0u) { xcd_barrier_complete(bar, b.x, nloc, nx); b.st[0] = nloc; b.st[1] = nx; }
    const unsigned old = xb_add(&bar[XB_XSUB(b.x)], 1u);
    const unsigned gen = old / nloc;
    if (old + 1u == (gen + 1u) * nloc) {
      __builtin_amdgcn_fence(__ATOMIC_RELEASE, "agent");
      asm volatile("s_waitcnt vmcnt(0)" ::: "memory");
      const unsigned og = xb_add(&bar[XB_TOP], 1u);
      const unsigned tg = og / nx;
      if (og + 1u == (tg + 1u) * nx) xb_add(&bar[XB_TOPGEN], 1u);
      else XB_SPIN(xb_ld(&bar[XB_TOPGEN]) == tg, bar);
      __builtin_amdgcn_fence(__ATOMIC_ACQUIRE, "agent");
      xb_add(&bar[XB_XGEN(b.x)], 1u);
      asm volatile("s_waitcnt vmcnt(0)" ::: "memory");
    } else {
      XB_SPIN(xb_ld(&bar[XB_XGEN(b.x)]) == gen, bar);
      __builtin_amdgcn_fence(__ATOMIC_ACQUIRE, "agent");
      asm volatile("s_waitcnt vmcnt(0)" ::: "memory");
    }
  }
  __syncthreads();
}

__device__ __forceinline__ void p0_mod_item(const Params& p, char* smem, int it) {
  float* sc = (float*)smem;
  float* red = sc + 9 * 1024;
  const int tid = threadIdx.x, lane = tid & 63, w = tid >> 6;
  for (int idx = tid; idx < 9 * 1024; idx += THREADS) {
    int r = idx >> 10, k = idx & 1023;
    float v = (r == 0) ? p.c_ctx[k] : p.c[(r - 1) * 1024 + k];
    sc[idx] = v / (1.f + expf(-v));
  }
  __syncthreads();
  const int cg4 = tid & 7, kg = tid >> 3, n0 = it * 32;
  float acc[9][4];
#pragma unroll
  for (int r = 0; r < 9; ++r)
#pragma unroll
    for (int e = 0; e < 4; ++e) acc[r][e] = 0.f;
  float4 wv[16];
#pragma unroll
  for (int i = 0; i < 16; ++i) wv[i] = *(const float4*)(p.w_mod + (size_t)(kg * 16 + i) * 3072 + n0 + cg4 * 4);
#pragma unroll
  for (int i = 0; i < 16; ++i) {
#pragma unroll
    for (int r = 0; r < 9; ++r) {
      const float s = sc[r * 1024 + kg * 16 + i];
      acc[r][0] += s * wv[i].x; acc[r][1] += s * wv[i].y; acc[r][2] += s * wv[i].z; acc[r][3] += s * wv[i].w;
    }
  }
#pragma unroll
  for (int r = 0; r < 9; ++r)
#pragma unroll
    for (int e = 0; e < 4; ++e) {
      float v = acc[r][e];
      v += __shfl_xor(v, 8);
      v += __shfl_xor(v, 16);
      v += __shfl_xor(v, 32);
      acc[r][e] = v;
    }
  if (lane < 8) {
#pragma unroll
    for (int r = 0; r < 9; ++r)
#pragma unroll
      for (int e = 0; e < 4; ++e) red[(w * 9 + r) * 32 + lane * 4 + e] = acc[r][e];
  }
  __syncthreads();
  float* mod = (float*)(p.ws + OFF_MOD);
  if (tid < 9 * 32) {
    int r = tid >> 5, c2 = tid & 31;
    float s = p.b_mod[n0 + c2];
#pragma unroll
    for (int g = 0; g < 8; ++g) s += red[(g * 9 + r) * 32 + c2];
    mod[r * 3072 + n0 + c2] = s;
  }
  __syncthreads();
}

__device__ __forceinline__ void p0_transpose_item(const float* __restrict__ src, int lds_src, u16* __restrict__ dst, int ldk, int kt, int nt,
                                  int nvalid, bool permute, char* smem) {
  u16* T = (u16*)smem;
  const int tid = threadIdx.x, cc = tid & 63, kr = tid >> 6;
  const int n = nt * 64 + cc;
  int on = n;
  if (permute) on = (n < 3072) ? n : (n < 6144 ? n + 32 : n - 3072);
#pragma unroll
  for (int i = 0; i < 8; ++i) {
    int kk = kr + i * 8;
    float v = (n < nvalid) ? src[(size_t)(kt * 64 + kk) * lds_src + on] : 0.f;
    T[cc * 72 + kk] = f2bf(v);
  }
  __syncthreads();
  const int row = tid >> 3, c8 = tid & 7;
  uint4 v = *(const uint4*)(T + row * 72 + c8 * 8);
  *(uint4*)(dst + (size_t)(nt * 64 + row) * ldk + kt * 64 + c8 * 8) = v;
  __syncthreads();
}

__device__ __forceinline__ void phase0(const Params& p, char* smem) {
  const int tid = threadIdx.x;

  constexpr int N_MOD = 96, N_WIN = 1600, N_ROPE = 64;
  for (int it = blockIdx.x; it < N_MOD + N_WIN + N_ROPE; it += gridDim.x) {
    if (it < N_MOD) {
      p0_mod_item(p, smem, it);
    } else if (it < N_MOD + N_WIN) {
      int q = it - N_MOD;
      p0_transpose_item(p.w_in, INC, (u16*)(p.ws + OFF_WTIN), 1024, q / 100, q % 100, INC, true, smem);
    } else {
      int q = it - N_MOD - N_WIN;
      int idx = q * 512 + tid;
      int pos = idx >> 5, m = idx & 31, fm = m & 15;
      float inv = exp2f(-(float)(2 * fm) / 32.f * 13.287712379549449f);
      float coord = (float)((m < 16) ? (pos >> 6) : (pos & 63));
      float ang = coord * inv;
      float* tab = (float*)(p.ws + OFF_ROPE);
      tab[idx * 2] = __cosf(ang);
      tab[idx * 2 + 1] = __sinf(ang);
    }
  }
}

__device__ __forceinline__ void phase1(const Params& p) {
  const int tid = otid(), lane = tid & 63, w = tid >> 6;
  const float* mod = (const float*)(p.ws + OFF_MOD);
  u16* hb = (u16*)(p.ws + OFF_H);
  float4 nw[4];
#pragma unroll
  for (int i = 0; i < 4; ++i) nw[i] = *(const float4*)(p.norm_pre_w + (i * 64 + lane) * 4);
  const int rstep = gridDim.x * 8;
#pragma unroll 1
  for (int row0 = blockIdx.x * 8 + w; row0 < NTOK; row0 += 2 * rstep) {
    float4 v[2][4], sh[2][4], sc[2][4];
    int rows[2];
#pragma unroll
    for (int j = 0; j < 2; ++j) {
      const int row = row0 + j * rstep;
      rows[j] = row;
      if (row < NTOK) {
        const float* xr = (row < NPR) ? p.x_prompt + (size_t)row * DM : p.x_sample + (size_t)(row - NPR) * DM;
        const int mr = (row < NPR) ? 0 : 1 + ((row - NPR) >> 10);
#pragma unroll
        for (int i = 0; i < 4; ++i) {
          const int k = (i * 64 + lane) * 4;
          v[j][i] = *(const float4*)(xr + k);
          sh[j][i] = *(const float4*)(mod + mr * 3072 + k);
          sc[j][i] = *(const float4*)(mod + mr * 3072 + 1024 + k);
        }
      }
    }
#pragma unroll
    for (int j = 0; j < 2; ++j) {
      if (rows[j] < NTOK) {
        float ss = 0.f;
#pragma unroll
        for (int i = 0; i < 4; ++i) ss += v[j][i].x * v[j][i].x + v[j][i].y * v[j][i].y + v[j][i].z * v[j][i].z + v[j][i].w * v[j][i].w;
#pragma unroll
        for (int m = 32; m >= 1; m >>= 1) ss += __shfl_xor(ss, m);
        const float rstd = rsqrtf(ss * (1.f / 1024.f) + 1e-6f);
#pragma unroll
        for (int i = 0; i < 4; ++i) {
          const int k = (i * 64 + lane) * 4;
          const float h0 = v[j][i].x * rstd * nw[i].x * (1.f + sc[j][i].x) + sh[j][i].x;
          const float h1 = v[j][i].y * rstd * nw[i].y * (1.f + sc[j][i].y) + sh[j][i].y;
          const float h2 = v[j][i].z * rstd * nw[i].z * (1.f + sc[j][i].z) + sh[j][i].z;
          const float h3 = v[j][i].w * rstd * nw[i].w * (1.f + sc[j][i].w) + sh[j][i].w;
          *(uint2*)(hb + (size_t)rows[j] * DM + k) = make_uint2(pack2(h0, h1), pack2(h2, h3));
        }
      }
    }
  }
}

template <int MODE, int MT>
__device__ __forceinline__ void gemm_tile(const Params& p, const u16* __restrict__ A, const u16* __restrict__ B, const int K, const int mt,
                          const int nt, char* smem, u32x4 (&ra0)[MT], u32x4 (&rb0)[4], const bool have0, const bool has_next,
                          const int mt_next, const int nt_next) {
  constexpr int LDT = 72;
  constexpr int STAGE = 2 * 256 * LDT;
  u16* sm = (u16*)smem;
  int tid_ = threadIdx.x;
  asm volatile("" : "+v"(tid_));
  const int tid = tid_, lane = tid & 63, w = tid >> 6, wm = w >> 2, wn = w & 3, l31 = lane & 31, h = lane >> 5;
  constexpr int AROWS = 64 * MT;
  f32x16 acc[MT][2];
#pragma unroll
  for (int mi = 0; mi < MT; ++mi)
#pragma unroll
    for (int ni = 0; ni < 2; ++ni)
#pragma unroll
      for (int r = 0; r < 16; ++r) acc[mi][ni][r] = 0.f;
  const int srow = tid >> 3, sc8 = tid & 7;
  const u16* Ag = A + (size_t)(mt * AROWS + srow) * K + sc8 * 8;
  const u16* Bg = B + (size_t)(nt * 256 + srow) * K + sc8 * 8;
  const int nk = K / 64;
#define GLOAD(RA, RB, KT)                                                                                   \
  do {                                                                                                      \
    _Pragma("unroll") for (int i = 0; i < MT; ++i) RA[i] = *(const u32x4*)(Ag + (size_t)(i * 64) * K + (KT) * 64); \
    _Pragma("unroll") for (int i = 0; i < 4; ++i) RB[i] = *(const u32x4*)(Bg + (size_t)(i * 64) * K + (KT) * 64);  \
  } while (0)
#define SSTORE(RA, RB, ST)                                                                                  \
  do {                                                                                                      \
    u16* Ad = sm + (ST) * STAGE;                                                                            \
    _Pragma("unroll") for (int i = 0; i < MT; ++i) *(u32x4*)(Ad + (srow + i * 64) * LDT + sc8 * 8) = RA[i]; \
    _Pragma("unroll") for (int i = 0; i < 4; ++i) *(u32x4*)(Ad + 256 * LDT + (srow + i * 64) * LDT + sc8 * 8) = RB[i]; \
  } while (0)
#define LDFRAG(AF, BF, KS)                                                                                  \
  do {                                                                                                      \
    _Pragma("unroll") for (int mi = 0; mi < MT; ++mi) AF[mi] = *(const bf16x8*)(Abase + mi * 32 * LDT + (KS) * 16); \
    _Pragma("unroll") for (int ni = 0; ni < 2; ++ni) BF[ni] = *(const bf16x8*)(Bbase + ni * 32 * LDT + (KS) * 16);  \
  } while (0)
#define MMA(AF, BF)                                                                                         \
  do {                                                                                                      \
    _Pragma("unroll") for (int mi = 0; mi < MT; ++mi)                                                       \
    _Pragma("unroll") for (int ni = 0; ni < 2; ++ni) acc[mi][ni] = MFMA32(BF[ni], AF[mi], acc[mi][ni]);     \
  } while (0)
  auto compute = [&](const int st, const int kt) {
    const u16* Abase = sm + st * STAGE + (wm * (MT * 32) + l31) * LDT + h * 8;
    const u16* Bbase = sm + st * STAGE + 256 * LDT + (wn * 64 + l31) * LDT + h * 8;
    bf16x8 af0[MT], bf0[2], af1[MT], bf1[2];
    LDFRAG(af0, bf0, 0);
    __builtin_amdgcn_sched_barrier(0);
    LDFRAG(af1, bf1, 1);
    __builtin_amdgcn_sched_barrier(0);
    MMA(af0, bf0);
    __builtin_amdgcn_sched_barrier(0);
    LDFRAG(af0, bf0, 2);
    __builtin_amdgcn_sched_barrier(0);
    if (kt + 1 < nk) SSTORE(ra0, rb0, st ^ 1);
    __builtin_amdgcn_sched_barrier(0);
    MMA(af1, bf1);
    __builtin_amdgcn_sched_barrier(0);
    if (kt + 2 < nk) GLOAD(ra0, rb0, kt + 2);
    __builtin_amdgcn_sched_barrier(0);
    LDFRAG(af1, bf1, 3);
    __builtin_amdgcn_sched_barrier(0);
    MMA(af0, bf0);
    __builtin_amdgcn_sched_barrier(0);
    MMA(af1, bf1);
  };
  auto rowscale = [&]() {
    const float* ssq = (const float*)(p.ws + OFF_SSQ);
#pragma unroll
    for (int mi = 0; mi < MT; ++mi) {
      const int m = mt * AROWS + wm * (MT * 32) + mi * 32 + l31;
      float s = 0.f;
#pragma unroll
      for (int q = 0; q < 4; ++q) {
        float4 t = *(const float4*)(ssq + (size_t)m * 16 + q * 4);
        s += t.x + t.y + t.z + t.w;
      }
      const float rs = rsqrtf(s * (1.f / 1024.f) + 1e-6f);
#pragma unroll
      for (int ni = 0; ni < 2; ++ni)
#pragma unroll
        for (int r = 0; r < 16; ++r) acc[mi][ni][r] *= rs;
    }
  };
  if (!have0) GLOAD(ra0, rb0, 0);
  SSTORE(ra0, rb0, 0);
  GLOAD(ra0, rb0, 1);
  __syncthreads();
#pragma unroll 1
  for (int kt = 0; kt < nk; ++kt) {
    compute(kt & 1, kt);
    if (MODE == 1 && kt == 15) rowscale();
    __syncthreads();
  }
  if (has_next) {
    const u16* Ag2 = A + (size_t)(mt_next * AROWS + srow) * K + sc8 * 8;
    const u16* Bg2 = B + (size_t)(nt_next * 256 + srow) * K + sc8 * 8;
#pragma unroll
    for (int i = 0; i < MT; ++i) ra0[i] = *(const u32x4*)(Ag2 + (size_t)(i * 64) * K);
#pragma unroll
    for (int i = 0; i < 4; ++i) rb0[i] = *(const u32x4*)(Bg2 + (size_t)(i * 64) * K);
  }
#undef GLOAD
#undef SSTORE
#undef LDFRAG
#undef MMA
  if (MODE == 0) {
    if (nt < 24) {
      u16* u = (u16*)(p.ws + OFF_U);
      u16* cst = sm + w * (128 * 72);
#pragma unroll
      for (int mi = 0; mi < MT; ++mi) {
        const int m = mt * AROWS + wm * (MT * 32) + mi * 32 + l31;
#pragma unroll
        for (int ni = 0; ni < 2; ++ni)
#pragma unroll
          for (int g = 0; g < 4; ++g) {
            const int n = nt * 256 + wn * 64 + ni * 32 + 8 * g + 4 * h;
            const uint2 pk =
                make_uint2(pack2(acc[mi][ni][4 * g], acc[mi][ni][4 * g + 1]), pack2(acc[mi][ni][4 * g + 2], acc[mi][ni][4 * g + 3]));
            *(uint2*)(cst + (mi * 32 + l31) * 72 + ni * 32 + 8 * g + 4 * h) = pk;
            if (MT == 4 && nt >= 4 && nt < 12 && ((mi == 0 && l31 == 0) || (mi == 3 && l31 == 31)))
              *(uint2*)((u16*)(p.ws + OFF_HALO) + ((size_t)(m >> 7) * 2 + (mi == 3 ? 1 : 0)) * 2048 + (n - 1024)) = pk;
          }
      }
      {
        const int rr = lane >> 3, c8 = lane & 7;
        u16* ug = u + (size_t)(mt * AROWS + wm * (MT * 32) + rr) * UC + nt * 256 + wn * 64 + c8 * 8;
#pragma unroll
        for (int i = 0; i < MT * 4; ++i) {
          const u32x4 v = *(const u32x4*)(cst + (i * 8 + rr) * 72 + c8 * 8);
          *(u32x4*)(ug + (size_t)(i * 8) * UC) = v;
        }
      }
      __syncthreads();
    } else if (wn == 0) {
      float* dt = (float*)(p.ws + OFF_DT);
#pragma unroll
      for (int mi = 0; mi < MT; ++mi) {
        const int m = mt * AROWS + wm * (MT * 32) + mi * 32 + l31;
#pragma unroll
        for (int g = 0; g < 4; ++g)
          *(float4*)(dt + (size_t)m * 32 + 8 * g + 4 * h) =
              make_float4(acc[mi][0][4 * g], acc[mi][0][4 * g + 1], acc[mi][0][4 * g + 2], acc[mi][0][4 * g + 3]);
      }
    }
  } else {
    float* ob = (float*)(p.ws + OFF_OUTB);
    float* ssq2 = (float*)(p.ws + OFF_SSQ2);
    float* cst = (float*)smem + w * (MT * 32 * 36);
    float ssum[MT];
#pragma unroll
    for (int mi = 0; mi < MT; ++mi) ssum[mi] = 0.f;
#pragma unroll
    for (int ni = 0; ni < 2; ++ni) {
#pragma unroll
      for (int mi = 0; mi < MT; ++mi)
#pragma unroll
        for (int g = 0; g < 4; ++g) {
          const float4 v = make_float4(acc[mi][ni][4 * g], acc[mi][ni][4 * g + 1], acc[mi][ni][4 * g + 2], acc[mi][ni][4 * g + 3]);
          ssum[mi] += v.x * v.x + v.y * v.y + v.z * v.z + v.w * v.w;
          *(float4*)(cst + (mi * 32 + l31) * 36 + 8 * g + 4 * h) = v;
        }
      const int rr = lane >> 3, c4 = lane & 7;
      float* og = ob + (size_t)(mt * AROWS + wm * (MT * 32) + rr) * DM + nt * 256 + wn * 64 + ni * 32 + c4 * 4;
#pragma unroll
      for (int i = 0; i < MT * 4; ++i) {
        const float4 v = *(const float4*)(cst + (i * 8 + rr) * 36 + c4 * 4);
        *(float4*)(og + (size_t)(i * 8) * DM) = v;
      }
    }
#pragma unroll
    for (int mi = 0; mi < MT; ++mi) {
      const int m = mt * AROWS + wm * (MT * 32) + mi * 32 + l31;
      float s = ssum[mi];
      s += __shfl_xor(s, 32);
      if (h == 0) ssq2[(size_t)m * 16 + nt * 4 + wn] = s;
    }
    __syncthreads();
  }
}

__device__ __forceinline__ void phase_conv(const Params& p) {
  const int tid = otid();
  const int c8 = tid & 15, rg = tid >> 4;
  u16* u = (u16*)(p.ws + OFF_U);
  const u16* halo = (const u16*)(p.ws + OFF_HALO);
#pragma unroll 1
  for (int id = blockIdx.x; id < 96 * 16; id += gridDim.x) {
    const int c = id >> 4, strip = id & 15;
    const bool first = (c < 32) ? ((c & 1) == 0) : (((c - 32) & 7) == 0);
    const bool last = (c < 32) ? ((c & 1) == 1) : (((c - 32) & 7) == 7);
    const int ch = strip * 128 + c8 * 8;
    u16* up = u + (size_t)(c * 128 + rg * 4) * UC + 1024 + ch;
    u32x4 r[6];
    const u32x4 z4 = {0u, 0u, 0u, 0u};
#pragma unroll
    for (int i = 1; i < 5; ++i) r[i] = *(const u32x4*)(up + (ptrdiff_t)(i - 1) * UC);
    if (rg > 0) r[0] = *(const u32x4*)(up - UC);
    else r[0] = first ? z4 : *(const u32x4*)(halo + ((size_t)(c - 1) * 2 + 1) * 2048 + ch);
    if (rg < 31) r[5] = *(const u32x4*)(up + 4 * UC);
    else r[5] = last ? z4 : *(const u32x4*)(halo + ((size_t)(c + 1) * 2) * 2048 + ch);
    float w0[8], w1[8], w2[8], bs[8];
#pragma unroll
    for (int e = 0; e < 8; e += 4) {
      const float4 a = *(const float4*)(p.conv_w + ch + e), b = *(const float4*)(p.conv_w + 2048 + ch + e),
                   cc = *(const float4*)(p.conv_w + 4096 + ch + e), d = *(const float4*)(p.conv_b + ch + e);
      w0[e] = a.x; w0[e + 1] = a.y; w0[e + 2] = a.z; w0[e + 3] = a.w;
      w1[e] = b.x; w1[e + 1] = b.y; w1[e + 2] = b.z; w1[e + 3] = b.w;
      w2[e] = cc.x; w2[e + 1] = cc.y; w2[e + 2] = cc.z; w2[e + 3] = cc.w;
      bs[e] = d.x; bs[e + 1] = d.y; bs[e + 2] = d.z; bs[e + 3] = d.w;
    }
    u32x4 o[4];
#pragma unroll
    for (int i = 0; i < 4; ++i) {
      const unsigned pu[4] = {r[i][0], r[i][1], r[i][2], r[i][3]}, cu[4] = {r[i + 1][0], r[i + 1][1], r[i + 1][2], r[i + 1][3]},
                     nu[4] = {r[i + 2][0], r[i + 2][1], r[i + 2][2], r[i + 2][3]};
      unsigned ov[4];
#pragma unroll
      for (int e2 = 0; e2 < 4; ++e2) {
        const float v0 = w0[2 * e2] * lo_bf(pu[e2]) + w1[2 * e2] * lo_bf(cu[e2]) + w2[2 * e2] * lo_bf(nu[e2]) + bs[2 * e2];
        const float v1 = w0[2 * e2 + 1] * hi_bf(pu[e2]) + w1[2 * e2 + 1] * hi_bf(cu[e2]) + w2[2 * e2 + 1] * hi_bf(nu[e2]) + bs[2 * e2 + 1];
        ov[e2] = pack2(silu_f(v0), silu_f(v1));
      }
      o[i] = u32x4{ov[0], ov[1], ov[2], ov[3]};
    }
    __syncthreads();
#pragma unroll
    for (int i = 0; i < 4; ++i) *(u32x4*)(up + (ptrdiff_t)i * UC) = o[i];
  }
}

constexpr int SC_ARR = 143360;
constexpr int SC_ITEM = SC_ARR + 5632;
constexpr int SC_CW = SC_ARR + 6144;

template <int W>
DI void issue_rows(const u16* __restrict__ u, u32x4* r, const int ucol, const int tok0) {
  constexpr int PC = W / 8, RS = THREADS / PC, NI = 128 / RS;
  const int tid = otid();
  const int c8 = tid % PC, r0 = tid / PC;
  const u16* base = u + (size_t)(tok0 + r0) * UC + ucol + c8 * 8;
#pragma unroll
  for (int i = 0; i < NI; ++i) r[i] = *(const u32x4*)(base + (size_t)i * (RS * UC));
}
template <int W, bool WITHV, bool WITHW>
DI void finish_rows(const u32x4* r, u16* dst, u16* dstw, const int ld, const float* wgt) {
  constexpr int PC = W / 8, RS = THREADS / PC, NI = 128 / RS;
  const int tid = otid();
  const int c8 = tid % PC, r0 = tid / PC;
#pragma unroll
  for (int i = 0; i < NI; ++i) {
    const int row = r0 + RS * i;
    if (WITHV) *(u32x4*)(dst + row * ld + c8 * 8) = r[i];
    if (WITHW) {
      const float wg = wgt[row];
      const unsigned xu[4] = {r[i][0], r[i][1], r[i][2], r[i][3]};
      unsigned o[4];
#pragma unroll
      for (int e = 0; e < 4; ++e) o[e] = pack2(lo_bf(xu[e]) * wg, hi_bf(xu[e]) * wg);
      *(uint4*)(dstw + row * ld + c8 * 8) = make_uint4(o[0], o[1], o[2], o[3]);
    }
  }
}
DI void issue_qk(const u16* __restrict__ u, u32x4* r, const int ucol, const int tok0) {
  const int tid = otid();
  const int row = tid >> 2, pp = tid & 3;
  const int pa = (pp & 1) + (pp >> 1) * 4;
  const u16* up = u + (size_t)(tok0 + row) * UC + ucol;
  r[0] = *(const u32x4*)(up + pa * 8);
  r[1] = *(const u32x4*)(up + pa * 8 + 16);
}
DI void finish_qk(const u32x4* r, const float4* tb, u16* dst, const int ld, const bool rope, const float scale) {
  const int tid = otid();
  const int row = tid >> 2, pp = tid & 3;
  const int pa = (pp & 1) + (pp >> 1) * 4, pb = pa + 2;
  const unsigned au[4] = {r[0][0], r[0][1], r[0][2], r[0][3]}, bu[4] = {r[1][0], r[1][1], r[1][2], r[1][3]};
  const float tf[16] = {tb[0].x, tb[0].y, tb[0].z, tb[0].w, tb[1].x, tb[1].y, tb[1].z, tb[1].w,
                        tb[2].x, tb[2].y, tb[2].z, tb[2].w, tb[3].x, tb[3].y, tb[3].z, tb[3].w};
  float o1[8], o2[8];
#pragma unroll
  for (int e = 0; e < 8; ++e) {
    const float x1 = (e & 1) ? hi_bf(au[e >> 1]) : lo_bf(au[e >> 1]);
    const float x2 = (e & 1) ? hi_bf(bu[e >> 1]) : lo_bf(bu[e >> 1]);
    const float cs = rope ? tf[2 * e] : 1.f, sn = rope ? tf[2 * e + 1] : 0.f;
    o1[e] = (x1 * cs - x2 * sn) * scale;
    o2[e] = (x2 * cs + x1 * sn) * scale;
  }
  *(uint4*)(dst + row * ld + pa * 8) = make_uint4(pack2(o1[0], o1[1]), pack2(o1[2], o1[3]), pack2(o1[4], o1[5]), pack2(o1[6], o1[7]));
  *(uint4*)(dst + row * ld + pb * 8) = make_uint4(pack2(o2[0], o2[1]), pack2(o2[2], o2[3]), pack2(o2[4], o2[5]), pack2(o2[6], o2[7]));
}
template <int N, int P, bool SSD>
__device__ __forceinline__ void scan_item(const Params& p, char* smem, const int stream, const int b, const int hd, const int unit0, int* qctr, int* s_item) {
  constexpr int LQ = N + 8, LV = P + 8;
  constexpr int PT = P / 64, NKS = N / 16, NT = N / 32;
  constexpr int NQ = SSD ? 4 : 2;
  u16* Qs = (u16*)smem;
  u16* Ks = Qs + 128 * LQ;
  u16* Vs = Ks + 128 * LQ;
  u16* Vw = Vs + 128 * LV;
  u16* SfT = Vw + 128 * LV;
  u16* SbT = SfT + P * LQ;
  float* dtf = (float*)(smem + SC_ARR);
  float* dtb = dtf + 128;
  float* cumf = dtb + 128;
  float* cumb = cumf + 128;
  float* ecf = cumb + 128;
  float* ecb = ecf + 128;
  float* wgt = ecb + 128;
  float* fct = (float*)(smem + SC_CW);

  int tid_ = threadIdx.x;
  asm volatile("" : "+v"(tid_));
  const int tid = tid_, lane = tid & 63, w = __builtin_amdgcn_readfirstlane(tid >> 6), l31 = lane & 31, h = lane >> 5;
  const int strip = w & 3, half = w >> 2;
  const int ntile = w % NT, ptile = w / NT;
  const int q4 = (lane & 15) >> 2, p4 = lane & 3, blk = (lane >> 4) & 1;
  const int L = stream ? 1024 : 256, nc = L / 128;
  const int seqbase = stream ? NPR + b * 1024 : b * 256;
  char* wsb = p.ws;
  asm volatile("" : "+s"(wsb));
  const u16* u = (const u16*)(wsb + OFF_U);
  const float* dtraw = (const float*)(wsb + OFF_DT);
  u16* mix = (u16*)(wsb + OFF_MIX);
  float* ssq = (float*)(wsb + OFF_SSQ);
  uint2* dump = (uint2*)(wsb + OFF_DUMP);
  const float4* ropetab = (const float4*)(wsb + OFF_ROPE);

  float Dh = 0.f, lamf = 0.f, lamb = 0.f, bias_d = 0.f, A_d = 0.f;
  const int grp = hd >> 2;
  if (SSD) {
    Dh = p.ssd_D[hd];
    const int d = w & 1;
    bias_d = p.dt_bias[d * 16 + hd];
    A_d = expf(p.A_log[d * 16 + hd]);
  } else {
    lamf = -expf(p.ret_decay[hd]);
    lamb = -expf(p.ret_decay[8 + hd]);
  }

  u32x4 rq[NQ], rk[NQ], rx[4];
  uint2 rdump[4];
  float4 rt[4];
  float rd0 = 0.f, rd1 = 0.f;

  auto issue_loads = [&](const int c, const int sweep) {
    const int tok0 = seqbase + c * 128, t0 = c * 128;
    if (sweep) {
      const uint2* dp = dump + ((size_t)(unit0 + c) * 8 + w) * 256;
#pragma unroll
      for (int g = 0; g < 4; ++g) rdump[g] = dp[g * 64 + lane];
    }
    if (SSD) {
      if (sweep) issue_rows<128>(u, rq, 2560 + grp * 128, tok0);
      issue_rows<128>(u, rk, 2048 + grp * 128, tok0);
      issue_rows<64>(u, rx, 1024 + hd * 64, tok0);
      if (w < 2) {
        const int ol = otid() & 63;
        const int sj0 = (w & 1) ? 127 - 2 * ol : 2 * ol, sj1 = (w & 1) ? 126 - 2 * ol : 2 * ol + 1;
        rd0 = dtraw[(size_t)(tok0 + sj0) * 32 + w * 16 + hd];
        rd1 = dtraw[(size_t)(tok0 + sj1) * 32 + w * 16 + hd];
      }
    } else {
      if (sweep) issue_qk(u, rq, 3072 + hd * 64, tok0);
      issue_qk(u, rk, 3584 + hd * 64, tok0);
      issue_rows<128>(u, rx, 4096 + hd * 128, tok0);
      if (stream) {
        const int ot = otid();
        const int row = ot >> 2, pp = ot & 3;
        const float4* tp = ropetab + ((size_t)(t0 + row) * 32 + (pp >> 1) * 16 + (pp & 1) * 8) / 2;
#pragma unroll
        for (int i = 0; i < 4; ++i) rt[i] = tp[i];
      }
    }
  };

  auto finish_loads = [&](const int c, const int sweep) {
    if (SSD) {
      if (w < 2) {
        const int ol = otid() & 63;
        const int sj0 = (w & 1) ? 127 - 2 * ol : 2 * ol, sj1 = (w & 1) ? 126 - 2 * ol : 2 * ol + 1;
        const float raw0 = rd0 + bias_d, raw1 = rd1 + bias_d;
        const float dt0 = fmaxf(raw0, 0.f) + __logf(1.f + __expf(-fabsf(raw0)));
        const float dt1 = fmaxf(raw1, 0.f) + __logf(1.f + __expf(-fabsf(raw1)));
        const float la0 = -dt0 * A_d, la1 = -dt1 * A_d;
        float s = la0 + la1;
#pragma unroll
        for (int d = 1; d < 64; d <<= 1) {
          const float t = __shfl_up(s, d);
          if (lane >= d) s += t;
        }
        const float tot = __shfl(s, 63);
        const float c1 = s, c0 = s - la1;
        float* dta = w ? dtb : dtf;
        float* cua = w ? cumb : cumf;
        float* eca = w ? ecb : ecf;
        dta[sj0] = dt0; dta[sj1] = dt1;
        cua[sj0] = c0; cua[sj1] = c1;
        eca[sj0] = __expf(c0); eca[sj1] = __expf(c1);
        if (w == sweep) {
          wgt[sj0] = dt0 * __expf(tot - c0);
          wgt[sj1] = dt1 * __expf(tot - c1);
        }
      }
    } else {
      if (tid < 128) {
        const float cf = (float)(tid + 1) * lamf, cb = (float)(128 - tid) * lamb;
        dtf[tid] = 1.f; dtb[tid] = 1.f;
        cumf[tid] = cf; cumb[tid] = cb;
        ecf[tid] = __expf(cf); ecb[tid] = __expf(cb);
        wgt[tid] = sweep ? __expf((float)tid * lamb) : __expf((float)(127 - tid) * lamf);
      }
    }
    __syncthreads();
    if (sweep) {
      const int ot = otid();
      const int s = ot >> 7, j = ot & 127;
      float val = 0.f;
      if (j < s * 32) val = dtf[j] * __expf(cumf[s * 32 - 1] - cumf[j]);
      else if (j >= s * 32 + 32) val = dtb[j] * __expf(cumb[s * 32 + 32] - cumb[j]);
      fct[ot] = val;
    }
    if (SSD) {
      if (sweep) finish_rows<128, true, false>(rq, Qs, nullptr, LQ, nullptr);
      finish_rows<128, true, false>(rk, Ks, nullptr, LQ, nullptr);
      if (sweep) finish_rows<64, true, true>(rx, Vs, Vw, LV, wgt);
      else finish_rows<64, false, true>(rx, Vs, Vw, LV, wgt);
    } else {
      if (sweep) finish_qk(rq, rt, Qs, LQ, stream != 0, 1.f);
      finish_qk(rk, rt, Ks, LQ, stream != 0, 0.125f);
      if (sweep) finish_rows<128, true, true>(rx, Vs, Vw, LV, wgt);
      else finish_rows<128, false, true>(rx, Vs, Vw, LV, wgt);
    }
    if (sweep) {
#pragma unroll
      for (int g = 0; g < 4; ++g) *(uint2*)(SfT + (ptile * 32 + l31) * LQ + ntile * 32 + 8 * g + 4 * h) = rdump[g];
    }
    __syncthreads();
  };

  auto state_update = [&](f32x16& S, const float dec) {
#pragma unroll
    for (int r = 0; r < 16; ++r) S[r] *= dec;
    const u16* ka0 = Ks + (8 * h + q4) * LQ + ntile * 32 + 16 * blk + 4 * p4;
    const u16* vb0 = Vw + (8 * h + q4) * LV + ptile * 32 + 16 * blk + 4 * p4;
    s16x4 ta[8][2], tb[8][2];
#pragma unroll
    for (int ks = 0; ks < 8; ++ks) {
      ta[ks][0] = tr_read(ka0 + ks * 16 * LQ);
      ta[ks][1] = tr_read(ka0 + ks * 16 * LQ + 4 * LQ);
      tb[ks][0] = tr_read(vb0 + ks * 16 * LV);
      tb[ks][1] = tr_read(vb0 + ks * 16 * LV + 4 * LV);
    }
    __builtin_amdgcn_sched_barrier(0);
#pragma unroll
    for (int ks = 0; ks < 8; ++ks) S = MFMA32(cat8(ta[ks][0], ta[ks][1]), cat8(tb[ks][0], tb[ks][1]), S);
    __builtin_amdgcn_sched_barrier(0);
  };

  auto load_state = [&](f32x16& S, const int dir) {
    if (stream) {
      const float* sp = SSD ? p.state_ssd + ((size_t)((b * 2 + dir) * 16 + hd)) * 128 * 64
                            : p.state_ret + ((size_t)((b * 2 + dir) * 8 + hd)) * 64 * 128;
#pragma unroll
      for (int r = 0; r < 16; ++r) S[r] = sp[(ntile * 32 + crow(r, h)) * P + ptile * 32 + l31];
    } else {
#pragma unroll
      for (int r = 0; r < 16; ++r) S[r] = 0.f;
    }
  };
  auto store_state = [&](const f32x16& S, const int dir) {
    if (!stream) {
      float* op = SSD ? p.out + (size_t)NTOK * DM + ((size_t)((b * 2 + dir) * 16 + hd)) * 128 * 64
                      : p.out + (size_t)NTOK * DM + (size_t)16 * 2 * 16 * 128 * 64 + ((size_t)((b * 2 + dir) * 8 + hd)) * 64 * 128;
#pragma unroll
      for (int r = 0; r < 16; ++r) op[(ntile * 32 + crow(r, h)) * P + ptile * 32 + l31] = S[r];
    }
  };

  f32x16 S;
  issue_loads(0, 0);
  load_state(S, 0);
#pragma unroll 1
  for (int c = 0; c < nc; ++c) {
    finish_loads(c, 0);
    {
      uint2* dp = dump + ((size_t)(unit0 + c) * 8 + w) * 256;
#pragma unroll
      for (int g = 0; g < 4; ++g) dp[g * 64 + lane] = make_uint2(pack2(S[4 * g], S[4 * g + 1]), pack2(S[4 * g + 2], S[4 * g + 3]));
    }
    if (c + 1 < nc) issue_loads(c + 1, 0);
    else {
      issue_loads(nc - 1, 1);
#pragma unroll
      for (int g = 0; g < 4; ++g) rdump[g] = make_uint2(pack2(S[4 * g], S[4 * g + 1]), pack2(S[4 * g + 2], S[4 * g + 3]));
    }
    state_update(S, __expf(cumf[127]));
    __syncthreads();
  }
  store_state(S, 0);

  load_state(S, 1);
#pragma unroll
  for (int g = 0; g < 4; ++g)
    *(uint2*)(SbT + (ptile * 32 + l31) * LQ + ntile * 32 + 8 * g + 4 * h) =
        make_uint2(pack2(S[4 * g], S[4 * g + 1]), pack2(S[4 * g + 2], S[4 * g + 3]));
  int nextq = 0;
#pragma unroll 1
  for (int c = nc - 1; c >= 0; --c) {
    const int tok0 = seqbase + c * 128;
    finish_loads(c, 1);
    if (c == 0 && threadIdx.x == 0) nextq = atomicAdd(qctr, 1);
    if (c > 0) issue_loads(c - 1, 1);

    const u16* qrow = Qs + (strip * 32 + l31) * LQ + h * 8;
    constexpr bool SJ = SSD;
    constexpr int YT = SJ ? 2 : PT;
    f32x16 Y[YT];
    if constexpr (SJ) {
      const u16* Sx = half ? SbT : SfT;
      const float* ex = half ? ecb : ecf;
#pragma unroll
      for (int pt = 0; pt < 2; ++pt) {
        const int prow = pt * 32 + l31;
        bf16x8 fq[NKS], fs[NKS];
#pragma unroll
        for (int ks = 0; ks < NKS; ++ks) {
          fq[ks] = *(const bf16x8*)(qrow + ks * 16);
          fs[ks] = *(const bf16x8*)(Sx + prow * LQ + ks * 16 + h * 8);
        }
        __builtin_amdgcn_sched_barrier(0);
        f32x16 a1;
#pragma unroll
        for (int r = 0; r < 16; ++r) a1[r] = 0.f;
#pragma unroll
        for (int ks = 0; ks < NKS; ++ks) a1 = MFMA32(fq[ks], fs[ks], a1);
        __builtin_amdgcn_sched_barrier(0);
#pragma unroll
        for (int g = 0; g < 4; ++g) {
          const float4 ef = *(const float4*)(ex + strip * 32 + 8 * g + 4 * h);
          Y[pt][4 * g + 0] = ef.x * a1[4 * g + 0];
          Y[pt][4 * g + 1] = ef.y * a1[4 * g + 1];
          Y[pt][4 * g + 2] = ef.z * a1[4 * g + 2];
          Y[pt][4 * g + 3] = ef.w * a1[4 * g + 3];
        }
      }
    } else {
#pragma unroll
    for (int pt = 0; pt < PT; ++pt) {
      const int prow = (half * PT + pt) * 32 + l31;
      bf16x8 fq[NKS], fs[NKS];
      {
#pragma unroll
        for (int ks = 0; ks < NKS; ++ks) {
          fq[ks] = *(const bf16x8*)(qrow + ks * 16);
          fs[ks] = *(const bf16x8*)(SfT + prow * LQ + ks * 16 + h * 8);
        }
        __builtin_amdgcn_sched_barrier(0);
        f32x16 a1;
#pragma unroll
        for (int r = 0; r < 16; ++r) a1[r] = 0.f;
#pragma unroll
        for (int ks = 0; ks < NKS; ++ks) a1 = MFMA32(fq[ks], fs[ks], a1);
        __builtin_amdgcn_sched_barrier(0);
#pragma unroll
        for (int ks = 0; ks < NKS; ++ks) fs[ks] = *(const bf16x8*)(SbT + prow * LQ + ks * 16 + h * 8);
#pragma unroll
        for (int g = 0; g < 4; ++g) {
          const float4 ef = *(const float4*)(ecf + strip * 32 + 8 * g + 4 * h);
          Y[pt][4 * g + 0] = ef.x * a1[4 * g + 0];
          Y[pt][4 * g + 1] = ef.y * a1[4 * g + 1];
          Y[pt][4 * g + 2] = ef.z * a1[4 * g + 2];
          Y[pt][4 * g + 3] = ef.w * a1[4 * g + 3];
        }
      }
      {
        __builtin_amdgcn_sched_barrier(0);
        f32x16 a2;
#pragma unroll
        for (int r = 0; r < 16; ++r) a2[r] = 0.f;
#pragma unroll
        for (int ks = 0; ks < NKS; ++ks) a2 = MFMA32(fq[ks], fs[ks], a2);
        __builtin_amdgcn_sched_barrier(0);
#pragma unroll
        for (int g = 0; g < 4; ++g) {
          const float4 eb = *(const float4*)(ecb + strip * 32 + 8 * g + 4 * h);
          Y[pt][4 * g + 0] += eb.x * a2[4 * g + 0];
          Y[pt][4 * g + 1] += eb.y * a2[4 * g + 1];
          Y[pt][4 * g + 2] += eb.z * a2[4 * g + 2];
          Y[pt][4 * g + 3] += eb.w * a2[4 * g + 3];
        }
      }
    }
    }
    const int ii = strip * 32 + l31;
    const float cfi = cumf[ii], cbi = cumb[ii];

#pragma unroll 1
    for (int jj = 0; jj < (SJ ? 2 : 4); ++jj) {
      const int jt = SJ ? half * 2 + jj : jj;
      f32x16 G;
#pragma unroll
      for (int r = 0; r < 16; ++r) G[r] = 0.f;
      s16x4 tv[YT][4];
      {
        bf16x8 fk[NKS], fq[NKS];
#pragma unroll
        for (int ks = 0; ks < NKS; ++ks) {
          fk[ks] = *(const bf16x8*)(Ks + (jt * 32 + l31) * LQ + ks * 16 + h * 8);
          fq[ks] = *(const bf16x8*)(qrow + ks * 16);
        }
        __builtin_amdgcn_sched_barrier(0);
#pragma unroll
        for (int ks = 0; ks < NKS; ++ks) G = MFMA32(fk[ks], fq[ks], G);
        __builtin_amdgcn_sched_barrier(0);
#pragma unroll
        for (int pt = 0; pt < YT; ++pt) {
          const u16* vp = Vs + (jt * 32 + 4 * h + q4) * LV + (SJ ? pt : half * PT + pt) * 32 + 16 * blk + 4 * p4;
          tv[pt][0] = tr_read(vp);
          tv[pt][1] = tr_read(vp + 8 * LV);
          tv[pt][2] = tr_read(vp + 16 * LV);
          tv[pt][3] = tr_read(vp + 24 * LV);
        }
        __builtin_amdgcn_sched_barrier(0);
      }
      if (jt == strip) {
#pragma unroll
        for (int g = 0; g < 4; ++g) {
          const int jb = jt * 32 + 8 * g + 4 * h;
          const float4 cf4 = *(const float4*)(cumf + jb), cb4 = *(const float4*)(cumb + jb);
          const float4 df4 = *(const float4*)(dtf + jb), db4 = *(const float4*)(dtb + jb);
          const float cfa[4] = {cf4.x, cf4.y, cf4.z, cf4.w}, cba[4] = {cb4.x, cb4.y, cb4.z, cb4.w};
          const float dfa[4] = {df4.x, df4.y, df4.z, df4.w}, dba[4] = {db4.x, db4.y, db4.z, db4.w};
#pragma unroll
          for (int e = 0; e < 4; ++e) {
            const int j = jb + e;
            const float tf = __expf(cfi - cfa[e]) * dfa[e];
            const float tb = __expf(cbi - cba[e]) * dba[e];
            const float m = ((ii >= j) ? tf : 0.f) + ((ii <= j) ? tb : 0.f);
            float pv = G[4 * g + e] * m;
            if (SSD && ii == j) pv += Dh;
            G[4 * g + e] = pv;
          }
        }
      } else {
        const float ei = (jt < strip) ? __expf(cfi - cumf[strip * 32 - 1]) : __expf(cbi - cumb[strip * 32 + 32]);
#pragma unroll
        for (int g = 0; g < 4; ++g) {
          const float4 f4 = *(const float4*)(fct + strip * 128 + jt * 32 + 8 * g + 4 * h);
          G[4 * g + 0] *= ei * f4.x;
          G[4 * g + 1] *= ei * f4.y;
          G[4 * g + 2] *= ei * f4.z;
          G[4 * g + 3] *= ei * f4.w;
        }
      }
      const bf16x8 pf0 = pack8(G[0], G[1], G[2], G[3], G[4], G[5], G[6], G[7]);
      const bf16x8 pf1 = pack8(G[8], G[9], G[10], G[11], G[12], G[13], G[14], G[15]);
#pragma unroll
      for (int pt = 0; pt < YT; ++pt) {
        Y[pt] = MFMA32(pf0, cat8(tv[pt][0], tv[pt][1]), Y[pt]);
        Y[pt] = MFMA32(pf1, cat8(tv[pt][2], tv[pt][3]), Y[pt]);
      }
    }
    state_update(S, __expf(cumb[0]));
    constexpr int CPR = P / 8, NIT = 128 * CPR / THREADS;
    const int ec8 = tid % CPR, er0 = tid / CPR;
    const int ecol = SSD ? hd * 64 + ec8 * 8 : hd * 128 + ec8 * 8;
    uint4 gz[NIT];
#pragma unroll
    for (int i = 0; i < NIT; ++i)
      gz[i] = *(const uint4*)(u + (size_t)(tok0 + er0 + i * (THREADS / CPR)) * UC + (SSD ? 0 : 5120) + ecol);
    const float* nwp = SSD ? p.ssd_norm_w + ecol : p.ret_norm_w + ecol;
    const float4 n0 = *(const float4*)nwp, n1 = *(const float4*)(nwp + 4);
    const float nw[8] = {n0.x, n0.y, n0.z, n0.w, n1.x, n1.y, n1.z, n1.w};
    __syncthreads();
#pragma unroll
    for (int g = 0; g < 4; ++g)
      *(uint2*)(SbT + (ptile * 32 + l31) * LQ + ntile * 32 + 8 * g + 4 * h) =
          make_uint2(pack2(S[4 * g], S[4 * g + 1]), pack2(S[4 * g + 2], S[4 * g + 3]));
    constexpr int LY = P + 4;
    float* Yst = (float*)smem;
#pragma unroll
    for (int pt = 0; pt < YT; ++pt)
#pragma unroll
      for (int r = 0; r < 16; ++r)
        Yst[(SJ ? half * (128 * LY) : 0) + (strip * 32 + crow(r, h)) * LY + (SJ ? pt : half * PT + pt) * 32 + l31] = Y[pt][r];
    __syncthreads();
#pragma unroll
    for (int i = 0; i < NIT; ++i) {
      const int row = er0 + i * (THREADS / CPR);
      const float* yp = Yst + row * LY + ec8 * 8;
      const float4 y0 = *(const float4*)yp, y1 = *(const float4*)(yp + 4);
      float v[8] = {y0.x, y0.y, y0.z, y0.w, y1.x, y1.y, y1.z, y1.w};
      if constexpr (SJ) {
        const float4 z0 = *(const float4*)(yp + 128 * LY), z1 = *(const float4*)(yp + 128 * LY + 4);
        v[0] += z0.x; v[1] += z0.y; v[2] += z0.z; v[3] += z0.w;
        v[4] += z1.x; v[5] += z1.y; v[6] += z1.z; v[7] += z1.w;
      }
      const size_t tok = (size_t)(tok0 + row);
      const unsigned zu[4] = {gz[i].x, gz[i].y, gz[i].z, gz[i].w};
      if (SSD) {
        float sq = 0.f;
#pragma unroll
        for (int e = 0; e < 8; ++e) {
          const float z = (e & 1) ? hi_bf(zu[e >> 1]) : lo_bf(zu[e >> 1]);
          v[e] *= silu_f(z);
          sq += v[e] * v[e];
        }
        sq += __shfl_xor(sq, 1);
        sq += __shfl_xor(sq, 2);
        sq += __shfl_xor(sq, 4);
        if (ec8 == 0) ssq[tok * 16 + hd] = sq;
        *(uint4*)(mix + tok * 2048 + ecol) = make_uint4(pack2(v[0] * nw[0], v[1] * nw[1]), pack2(v[2] * nw[2], v[3] * nw[3]),
                                                        pack2(v[4] * nw[4], v[5] * nw[5]), pack2(v[6] * nw[6], v[7] * nw[7]));
      } else {
        float s = 0.f;
#pragma unroll
        for (int e = 0; e < 8; ++e) s += v[e];
        s += __shfl_xor(s, 1);
        s += __shfl_xor(s, 2);
        s += __shfl_xor(s, 4);
        s += __shfl_xor(s, 8);
        const float mean = s * (1.f / 128.f);
        float s2 = 0.f;
#pragma unroll
        for (int e = 0; e < 8; ++e) {
          v[e] -= mean;
          s2 += v[e] * v[e];
        }
        s2 += __shfl_xor(s2, 1);
        s2 += __shfl_xor(s2, 2);
        s2 += __shfl_xor(s2, 4);
        s2 += __shfl_xor(s2, 8);
        const float rstd = rsqrtf(s2 * (1.f / 128.f) + 1e-6f);
#pragma unroll
        for (int e = 0; e < 8; ++e) {
          const float gv = (e & 1) ? hi_bf(zu[e >> 1]) : lo_bf(zu[e >> 1]);
          v[e] = v[e] * rstd * nw[e] * silu_f(gv);
        }
        *(uint4*)(mix + tok * 2048 + 1024 + ecol) =
            make_uint4(pack2(v[0], v[1]), pack2(v[2], v[3]), pack2(v[4], v[5]), pack2(v[6], v[7]));
      }
    }
  }
  store_state(S, 1);
  if (threadIdx.x == 0) *s_item = nextq;
}

__device__ __forceinline__ void phase3(const Params& p, char* smem, const int ctr_idx) {
  int* s_item = (int*)(smem + SC_ITEM);
  int* ctr = (int*)(p.ws + OFF_CTR) + ctr_idx;
  if (threadIdx.x == 0) *s_item = atomicAdd(ctr, 1);
  __syncthreads();
#pragma unroll 1
  for (;;) {
    const int q = *s_item;
    __syncthreads();
    if (q >= 576) break;
    int kind, stream, bb, hd, unit0;
    if (q < 128) { kind = 0; stream = 1; bb = q >> 4; hd = q & 15; unit0 = q * 8; }
    else if (q < 192) { kind = 1; stream = 1; bb = (q - 128) >> 3; hd = (q - 128) & 7; unit0 = 1024 + (q - 128) * 8; }
    else if (q < 448) { kind = 0; stream = 0; bb = (q - 192) >> 4; hd = (q - 192) & 15; unit0 = 1536 + (q - 192) * 2; }
    else { kind = 1; stream = 0; bb = (q - 448) >> 3; hd = (q - 448) & 7; unit0 = 2048 + (q - 448) * 2; }
    if (kind == 0) scan_item<128, 64, true>(p, smem, stream, bb, hd, unit0, ctr, s_item);
    else scan_item<64, 128, false>(p, smem, stream, bb, hd, unit0, ctr, s_item);
    __syncthreads();
  }
}

__device__ __forceinline__ void phase5(const Params& p) {
  const int tid = otid(), lane = tid & 63, w = tid >> 6;
  const float* mod = (const float*)(p.ws + OFF_MOD);
  const float* ob = (const float*)(p.ws + OFF_OUTB);
  const float* ssq2 = (const float*)(p.ws + OFF_SSQ2);
  for (int row = blockIdx.x * 8 + w; row < NTOK; row += gridDim.x * 8) {
    const float* xr = (row < NPR) ? p.x_prompt + (size_t)row * DM : p.x_sample + (size_t)(row - NPR) * DM;
    const int mr = (row < NPR) ? 0 : 1 + ((row - NPR) >> 10);
    float s = (lane < 16) ? ssq2[(size_t)row * 16 + lane] : 0.f;
#pragma unroll
    for (int m = 8; m >= 1; m >>= 1) s += __shfl_xor(s, m);
    s = __shfl(s, 0);
    const float rstd = rsqrtf(s * (1.f / 1024.f) + 1e-6f);
#pragma unroll
    for (int i = 0; i < 4; ++i) {
      const int k = (i * 64 + lane) * 4;
      const float4 xv = *(const float4*)(xr + k);
      const float4 ov = *(const float4*)(ob + (size_t)row * DM + k);
      const float4 nw = *(const float4*)(p.norm_post_w + k);
      const float4 gt = *(const float4*)(mod + mr * 3072 + 2048 + k);
      float4 y;
      y.x = xv.x + gt.x * ov.x * rstd * nw.x;
      y.y = xv.y + gt.y * ov.y * rstd * nw.y;
      y.z = xv.z + gt.z * ov.z * rstd * nw.z;
      y.w = xv.w + gt.w * ov.w * rstd * nw.w;
      *(float4*)(p.out + (size_t)row * DM + k) = y;
    }
  }
}

__global__ void __launch_bounds__(THREADS) fwd_megakernel(Params p) {
  extern __shared__ __attribute__((aligned(16))) char smem[];
  cg::grid_group grid = cg::this_grid();
  const int G = gridDim.x;
  const int bx = blockIdx.x;
  const int rb = (G % 8 == 0) ? (bx % 8) * (G / 8) + bx / 8 : bx;

  unsigned* gbar = (unsigned*)(p.ws + OFF_CTR + 1024);
  unsigned epoch = 0u;
  volatile LAS unsigned* xst = (volatile LAS unsigned*)(smem + 153984);
  if (threadIdx.x == 0) { xst[0] = 0u; xst[1] = 0u; xst[2] = 0u; xst[3] = 0u; }
  __syncthreads();
  const XcdBarrier xb = xcd_barrier_post((unsigned*)(p.ws + OFF_CTR + 8192), xst);
  if (p.ws == nullptr) grid.sync();
  phase0(p, smem);
  xcd_barrier(xb);
#if PROBE == 5
  phase0(p, smem);
  xcd_barrier(xb);
#endif
#if PROBE == 4
  for (int i = 0; i < 10; ++i) xcd_barrier(xb);
#endif
  phase1(p);
  xcd_barrier(xb);
#if PROBE == 6
  phase1(p);
  xcd_barrier(xb);
#endif
  {
    u32x4 sra[4], srb[4];
    bool have0 = false;
    for (int id = rb; id < 48 * 25; id += G) {
      const int band = id / 200, rem = id % 200;
      const int id2 = id + G;
      const bool has2 = id2 < 48 * 25;
      const int band2 = id2 / 200, rem2 = id2 % 200;
      gemm_tile<0, 4>(p, (const u16*)(p.ws + OFF_H), (const u16*)(p.ws + OFF_WTIN), 1024, band * 8 + (rem & 7), rem >> 3, smem, sra, srb,
                      have0, has2, band2 * 8 + (rem2 & 7), rem2 >> 3);
      have0 = has2;
    }
  }
  {
    const int nfull = (48 * 25) % G;
    const int nhelp = (nfull > 0) ? G - nfull : G;
    const int hb = (nfull > 0) ? rb - nfull : rb;
    if (hb >= 0)
      for (int q = hb; q < 512; q += nhelp)
        p0_transpose_item(p.w_out, 1024, (u16*)(p.ws + OFF_WTOUT), 2048, q / 16, q % 16, 1024, false, smem);
  }
  xcd_barrier(xb);
#if PROBE == 1
  for (int id = rb; id < 48 * 25; id += G) {
    const int band = id / 200, rem = id % 200;
    u32x4 sra[4], srb[4];
    gemm_tile<0, 4>(p, (const u16*)(p.ws + OFF_H), (const u16*)(p.ws + OFF_WTIN), 1024, band * 8 + (rem & 7), rem >> 3, smem, sra, srb, false, false, 0, 0);
  }
  xcd_barrier(xb);
#endif
  phase_conv(p);
  xcd_barrier(xb);
  phase3(p, smem, 0);
#if PROBE == 2
  phase3(p, smem, 1);
#endif
  xcd_barrier(xb);
#if PROBE == 3
  for (int id = rb; id < 64 * 4; id += G)
  {
    u32x4 sra[3], srb[4];
    gemm_tile<1, 3>(p, (const u16*)(p.ws + OFF_MIX), (const u16*)(p.ws + OFF_WTOUT), 2048, id >> 2, id & 3, smem, sra, srb, false, false, 0, 0);
  }
  xcd_barrier(xb);
#endif
  for (int id = rb; id < 64 * 4; id += G)
  {
    u32x4 sra[3], srb[4];
    gemm_tile<1, 3>(p, (const u16*)(p.ws + OFF_MIX), (const u16*)(p.ws + OFF_WTOUT), 2048, id >> 2, id & 3, smem, sra, srb, false, false, 0, 0);
  }
  xcd_barrier(xb);
  phase5(p);
#if PROBE == 7
  phase5(p);
#endif
}

extern "C" void kernel_launch(void* const* d_in, const int* in_sizes, int n_in, void* d_out, int out_size, void* d_ws,
                              size_t ws_size, hipStream_t stream) {
  static int grid_blocks = 0;
  if (!grid_blocks) {
    int dev = 0, cus = 0, per_cu = 0;
    hipGetDevice(&dev);
    hipDeviceGetAttribute(&cus, hipDeviceAttributeMultiprocessorCount, dev);
    hipFuncSetAttribute((const void*)fwd_megakernel, hipFuncAttributeMaxDynamicSharedMemorySize, SMEM_BYTES);
    hipOccupancyMaxActiveBlocksPerMultiprocessor(&per_cu, fwd_megakernel, THREADS, SMEM_BYTES);
    if (per_cu < 1) per_cu = 1;
    grid_blocks = cus * per_cu;
  }
  Params p{};
  const float* const* in = (const float* const*)d_in;
  p.x_prompt = in[0]; p.x_sample = in[1]; p.state_ssd = in[2]; p.state_ret = in[3]; p.c = in[4]; p.c_ctx = in[5];
  p.w_mod = in[6]; p.b_mod = in[7]; p.norm_pre_w = in[8]; p.norm_post_w = in[9]; p.w_in = in[10]; p.conv_w = in[11];
  p.conv_b = in[12]; p.A_log = in[13]; p.dt_bias = in[14]; p.ssd_D = in[15]; p.ssd_norm_w = in[16]; p.ret_decay = in[17];
  p.ret_norm_w = in[18]; p.w_out = in[19];
  p.out = (float*)d_out;
  p.ws = (char*)d_ws;
  hipMemsetAsync((char*)d_ws + OFF_CTR, 0, 8192 + 16384, stream);
  void* args[] = {&p};
  hipError_t e = hipLaunchCooperativeKernel((void*)fwd_megakernel, dim3(grid_blocks), dim3(THREADS), args, SMEM_BYTES, stream);
  if (e != hipSuccess) fprintf(stderr, "cooperative launch failed: %s (grid %d)\n", hipGetErrorString(e), grid_blocks);
}
```

```cpp
#include <hip/hip_runtime.h>
#include <hip/hip_cooperative_groups.h>
#include <cstdio>
namespace cg = cooperative_groups;

typedef unsigned short u16;
typedef __bf16 bf16v2 __attribute__((ext_vector_type(2)));
typedef float f32v2 __attribute__((ext_vector_type(2)));
typedef short s16x4 __attribute__((ext_vector_type(4)));
using bf16x8 = __attribute__((ext_vector_type(8))) short;
using f32x16 = __attribute__((ext_vector_type(16))) float;
using f32x4n = __attribute__((ext_vector_type(4))) float;
using u32x4 = __attribute__((ext_vector_type(4))) unsigned;
#define DI __device__ __forceinline__
#define MFMA32(a, b, c) __builtin_amdgcn_mfma_f32_32x32x16_bf16((a), (b), (c), 0, 0, 0)

constexpr int NTOK = 12288;
constexpr int NPR = 4096;
constexpr int DM = 1024;
constexpr int INC = 6176;
constexpr int UC = 6144;
#ifndef PROBE
#define PROBE 0
#endif
constexpr int THREADS = 512;
constexpr int SMEM_BYTES = 152 * 1024;

constexpr size_t OFF_MOD = 0;
constexpr size_t OFF_ROPE = 131072;
constexpr size_t OFF_CTR = 393216;
constexpr size_t OFF_H = 524288;
constexpr size_t OFF_WTIN = OFF_H + 25165824;
constexpr size_t OFF_DUMP = OFF_H;
constexpr size_t OFF_WTOUT = OFF_WTIN + 13107200;
constexpr size_t OFF_U = OFF_WTOUT + 4194304;
constexpr size_t OFF_OUTB = OFF_U;
constexpr size_t OFF_DT = OFF_U + 150994944;
constexpr size_t OFF_MIX = OFF_DT + 1572864;
constexpr size_t OFF_SSQ = OFF_MIX + 50331648;
constexpr size_t OFF_SSQ2 = OFF_SSQ + 1572864;
constexpr size_t OFF_HALO = OFF_SSQ2 + 786432;

struct Params {
  const float *x_prompt, *x_sample, *state_ssd, *state_ret, *c, *c_ctx, *w_mod, *b_mod, *norm_pre_w, *norm_post_w,
      *w_in, *conv_w, *conv_b, *A_log, *dt_bias, *ssd_D, *ssd_norm_w, *ret_decay, *ret_norm_w, *w_out;
  float* out;
  char* ws;
};

DI float bf2f(u16 v) { return __uint_as_float(((unsigned)v) << 16); }
DI unsigned pack2(float a, float b) {
  f32v2 f = {a, b};
  bf16v2 r = __builtin_convertvector(f, bf16v2);
  return __builtin_bit_cast(unsigned, r);
}
DI u16 f2bf(float a) { return (u16)(pack2(a, 0.f) & 0xffffu); }
DI float lo_bf(unsigned v) { return __uint_as_float(v << 16); }
DI float hi_bf(unsigned v) { return __uint_as_float(v & 0xffff0000u); }
DI float silu_f(float v) { return v * __builtin_amdgcn_rcpf(1.f + __expf(-v)); }
DI int crow(int r, int h) { return (r & 3) + 8 * (r >> 2) + 4 * h; }
DI int otid() {
  int t = threadIdx.x;
  asm volatile("" : "+v"(t));
  return t;
}
DI s16x4 tr_read(const u16* p) {
  return __builtin_amdgcn_ds_read_tr16_b64_v4i16((s16x4 __attribute__((address_space(3)))*)(p));
}
DI bf16x8 cat8(s16x4 lo, s16x4 hi) { return __builtin_shufflevector(lo, hi, 0, 1, 2, 3, 4, 5, 6, 7); }
DI bf16x8 pack8(float a0, float a1, float a2, float a3, float a4, float a5, float a6, float a7) {
  uint4 v = make_uint4(pack2(a0, a1), pack2(a2, a3), pack2(a4, a5), pack2(a6, a7));
  return __builtin_bit_cast(bf16x8, v);
}


DI void grid_barrier(unsigned* bar, unsigned& epoch) {
  asm volatile("s_waitcnt vmcnt(0)" ::: "memory");
  __syncthreads();
  if (threadIdx.x == 0) {
    __builtin_amdgcn_fence(__ATOMIC_RELEASE, "agent");
    asm volatile("s_waitcnt vmcnt(0)" ::: "memory");
    const unsigned G = gridDim.x;
    const unsigned ng = (G % 8u == 0u) ? 8u : 1u;
    const unsigned gs = G / ng, g = blockIdx.x % ng, e1 = epoch + 1u;
    const unsigned old = __hip_atomic_fetch_add(&bar[64u * (1u + g)], 1u, __ATOMIC_RELAXED, __HIP_MEMORY_SCOPE_AGENT);
    if (old + 1u == gs * e1) {
      const unsigned o2 = __hip_atomic_fetch_add(&bar[0], 1u, __ATOMIC_RELAXED, __HIP_MEMORY_SCOPE_AGENT);
      if (o2 + 1u == ng * e1) __hip_atomic_fetch_add(&bar[64u * 16u], 1u, __ATOMIC_RELAXED, __HIP_MEMORY_SCOPE_AGENT);
    }
    while (__hip_atomic_load(&bar[64u * 16u], __ATOMIC_RELAXED, __HIP_MEMORY_SCOPE_AGENT) < e1) __builtin_amdgcn_s_sleep(1);
    __builtin_amdgcn_fence(__ATOMIC_ACQUIRE, "agent");
    asm volatile("s_waitcnt vmcnt(0)" ::: "memory");
  }
  __syncthreads();
  ++epoch;
}


#define XB_TMO      128
#define XB_XCNT(j)  (256  + 64 * (j))
#define XB_XSUB(j)  (1280 + 64 * (j))
#define XB_XGEN(j)  (2304 + 64 * (j))
#define XB_TOP      3328
#define XB_TOPGEN   3392
#define XB_SPIN_CAP (1u << 22)
#define LAS __attribute__((address_space(3)))
DI unsigned xb_ld(unsigned* p) { return __hip_atomic_load(p, __ATOMIC_RELAXED, __HIP_MEMORY_SCOPE_AGENT); }
DI unsigned xb_add(unsigned* p, unsigned v) { return __hip_atomic_fetch_add(p, v, __ATOMIC_RELAXED, __HIP_MEMORY_SCOPE_AGENT); }
DI unsigned xb_xcc_id() { return (unsigned)__builtin_amdgcn_s_getreg((3 << 11) | 20) & 0xFu; }
#define XB_SPIN(cond, bar) do { unsigned _sp = 0; while (cond) { __builtin_amdgcn_s_sleep(1); \
    if ((++_sp & 255u) == 0u) { if (xb_ld(&(bar)[XB_TMO])) break; if (_sp > XB_SPIN_CAP) { atomicAdd(&(bar)[XB_TMO], 1u); break; } } } } while (0)
struct XcdBarrier { unsigned* bar; unsigned x; volatile LAS unsigned* st; };
DI XcdBarrier xcd_barrier_post(unsigned* bar, volatile LAS unsigned* st) {
  XcdBarrier b; b.bar = bar; b.x = xb_xcc_id(); b.st = st;
  if (threadIdx.x == 0) (void)xb_add(&bar[XB_XCNT(b.x)], 1u);
  return b;
}
DI void xcd_barrier_complete(unsigned* bar, unsigned x, unsigned& nloc, unsigned& nx) {
  const unsigned G = gridDim.x;
  unsigned sum, cnt, mine, sp = 0u;
  for (;;) {
    sum = 0u; cnt = 0u; mine = 0u;
#pragma unroll
    for (unsigned j = 0; j < 16; ++j) { const unsigned c = xb_ld(&bar[XB_XCNT(j)]); sum += c; cnt += (c > 0u) ? 1u : 0u; mine = (j == x) ? c : mine; }
    if (sum == G) break;
    __builtin_amdgcn_s_sleep(1);
    if ((++sp & 255u) == 0u) { if (xb_ld(&bar[XB_TMO])) break; if (sp > XB_SPIN_CAP) { atomicAdd(&bar[XB_TMO], 1u); break; } }
  }
  nloc = mine > 0u ? mine : 1u; nx = cnt > 0u ? cnt : 1u;
}
DI void xcd_barrier(const XcdBarrier& b) {
  asm volatile("s_waitcnt vmcnt(0)" ::: "memory");
  __syncthreads();
  if (threadIdx.x == 0) {
    unsigned* bar = b.bar;
    __builtin_amdgcn_s_waitcnt(0);
    unsigned nloc = b.st[0], nx = b.st[1];
    if (nloc == 0u) { xcd_barrier_complete(bar, b.x, nloc, nx); b.st[0] = nloc; b.st[1] = nx; }
    const unsigned old = xb_add(&bar[XB_XSUB(b.x)], 1u);
    const unsigned gen = old / nloc;
    if (old + 1u == (gen + 1u) * nloc) {
      __builtin_amdgcn_fence(__ATOMIC_RELEASE, "agent");
      asm volatile("s_waitcnt vmcnt(0)" ::: "memory");
      const unsigned og = xb_add(&bar[XB_TOP], 1u);
      const unsigned tg = og / nx;
      if (og + 1u == (tg + 1u) * nx) xb_add(&bar[XB_TOPGEN], 1u);
      else XB_SPIN(xb_ld(&bar[XB_TOPGEN]) == tg, bar);
      __builtin_amdgcn_fence(__ATOMIC_ACQUIRE, "agent");
      xb_add(&bar[XB_XGEN(b.x)], 1u);
      asm volatile("s_waitcnt vmcnt(0)" ::: "memory");
    } else {
      XB_SPIN(xb_ld(&bar[XB_XGEN(b.x)]) == gen, bar);
      __builtin_amdgcn_fence(__ATOMIC_ACQUIRE, "agent");
      asm volatile("s_waitcnt vmcnt(0)" ::: "memory");
    }
  }
  __syncthreads();
}

__device__ __forceinline__ void p0_mod_item(const Params& p, char* smem, int it) {
  float* sc = (float*)smem;
  float* red = sc + 9 * 1024;
  const int tid = threadIdx.x, lane = tid & 63, w = tid >> 6;
  for (int idx = tid; idx < 9 * 1024; idx += THREADS) {
    int r = idx >> 10, k = idx & 1023;
    float v = (r == 0) ? p.c_ctx[k] : p.c[(r - 1) * 1024 + k];
    sc[idx] = v / (1.f + expf(-v));
  }
  __syncthreads();
  const int cg4 = tid & 7, kg = tid >> 3, n0 = it * 32;
  float acc[9][4];
#pragma unroll
  for (int r = 0; r < 9; ++r)
#pragma unroll
    for (int e = 0; e < 4; ++e) acc[r][e] = 0.f;
  float4 wv[16];
#pragma unroll
  for (int i = 0; i < 16; ++i) wv[i] = *(const float4*)(p.w_mod + (size_t)(kg * 16 + i) * 3072 + n0 + cg4 * 4);
#pragma unroll
  for (int i = 0; i < 16; ++i) {
#pragma unroll
    for (int r = 0; r < 9; ++r) {
      const float s = sc[r * 1024 + kg * 16 + i];
      acc[r][0] += s * wv[i].x; acc[r][1] += s * wv[i].y; acc[r][2] += s * wv[i].z; acc[r][3] += s * wv[i].w;
    }
  }
#pragma unroll
  for (int r = 0; r < 9; ++r)
#pragma unroll
    for (int e = 0; e < 4; ++e) {
      float v = acc[r][e];
      v += __shfl_xor(v, 8);
      v += __shfl_xor(v, 16);
      v += __shfl_xor(v, 32);
      acc[r][e] = v;
    }
  if (lane < 8) {
#pragma unroll
    for (int r = 0; r < 9; ++r)
#pragma unroll
      for (int e = 0; e < 4; ++e) red[(w * 9 + r) * 32 + lane * 4 + e] = acc[r][e];
  }
  __syncthreads();
  float* mod = (float*)(p.ws + OFF_MOD);
  if (tid < 9 * 32) {
    int r = tid >> 5, c2 = tid & 31;
    float s = p.b_mod[n0 + c2];
#pragma unroll
    for (int g = 0; g < 8; ++g) s += red[(g * 9 + r) * 32 + c2];
    mod[r * 3072 + n0 + c2] = s;
  }
  __syncthreads();
}

__device__ __forceinline__ void p0_transpose_item(const float* __restrict__ src, int lds_src, u16* __restrict__ dst, int ldk, int kt, int nt,
                                  int nvalid, bool permute, char* smem) {
  u16* T = (u16*)smem;
  const int tid = threadIdx.x, cc = tid & 63, kr = tid >> 6;
  const int n = nt * 64 + cc;
  int on = n;
  if (permute) on = (n < 3072) ? n : (n < 6144 ? n + 32 : n - 3072);
#pragma unroll
  for (int i = 0; i < 8; ++i) {
    int kk = kr + i * 8;
    float v = (n < nvalid) ? src[(size_t)(kt * 64 + kk) * lds_src + on] : 0.f;
    T[cc * 72 + kk] = f2bf(v);
  }
  __syncthreads();
  const int row = tid >> 3, c8 = tid & 7;
  uint4 v = *(const uint4*)(T + row * 72 + c8 * 8);
  *(uint4*)(dst + (size_t)(nt * 64 + row) * ldk + kt * 64 + c8 * 8) = v;
  __syncthreads();
}

__device__ __forceinline__ void phase0(const Params& p, char* smem) {
  const int tid = threadIdx.x;

  constexpr int N_MOD = 96, N_WIN = 1600, N_ROPE = 64;
  for (int it = blockIdx.x; it < N_MOD + N_WIN + N_ROPE; it += gridDim.x) {
    if (it < N_MOD) {
      p0_mod_item(p, smem, it);
    } else if (it < N_MOD + N_WIN) {
      int q = it - N_MOD;
      p0_transpose_item(p.w_in, INC, (u16*)(p.ws + OFF_WTIN), 1024, q / 100, q % 100, INC, true, smem);
    } else {
      int q = it - N_MOD - N_WIN;
      int idx = q * 512 + tid;
      int pos = idx >> 5, m = idx & 31, fm = m & 15;
      float inv = exp2f(-(float)(2 * fm) / 32.f * 13.287712379549449f);
      float coord = (float)((m < 16) ? (pos >> 6) : (pos & 63));
      float ang = coord * inv;
      float* tab = (float*)(p.ws + OFF_ROPE);
      tab[idx * 2] = __cosf(ang);
      tab[idx * 2 + 1] = __sinf(ang);
    }
  }
}

__device__ __forceinline__ void phase1(const Params& p) {
  const int tid = otid(), lane = tid & 63, w = tid >> 6;
  const float* mod = (const float*)(p.ws + OFF_MOD);
  u16* hb = (u16*)(p.ws + OFF_H);
  float4 nw[4];
#pragma unroll
  for (int i = 0; i < 4; ++i) nw[i] = *(const float4*)(p.norm_pre_w + (i * 64 + lane) * 4);
  const int rstep = gridDim.x * 8;
#pragma unroll 1
  for (int row0 = blockIdx.x * 8 + w; row0 < NTOK; row0 += 2 * rstep) {
    float4 v[2][4], sh[2][4], sc[2][4];
    int rows[2];
#pragma unroll
    for (int j = 0; j < 2; ++j) {
      const int row = row0 + j * rstep;
      rows[j] = row;
      if (row < NTOK) {
        const float* xr = (row < NPR) ? p.x_prompt + (size_t)row * DM : p.x_sample + (size_t)(row - NPR) * DM;
        const int mr = (row < NPR) ? 0 : 1 + ((row - NPR) >> 10);
#pragma unroll
        for (int i = 0; i < 4; ++i) {
          const int k = (i * 64 + lane) * 4;
          { const f32x4n t_ = __builtin_nontemporal_load((const f32x4n*)(xr + k)); v[j][i] = make_float4(t_[0], t_[1], t_[2], t_[3]); }
          sh[j][i] = *(const float4*)(mod + mr * 3072 + k);
          sc[j][i] = *(const float4*)(mod + mr * 3072 + 1024 + k);
        }
      }
    }
#pragma unroll
    for (int j = 0; j < 2; ++j) {
      if (rows[j] < NTOK) {
        float ss = 0.f;
#pragma unroll
        for (int i = 0; i < 4; ++i) ss += v[j][i].x * v[j][i].x + v[j][i].y * v[j][i].y + v[j][i].z * v[j][i].z + v[j][i].w * v[j][i].w;
#pragma unroll
        for (int m = 32; m >= 1; m >>= 1) ss += __shfl_xor(ss, m);
        const float rstd = rsqrtf(ss * (1.f / 1024.f) + 1e-6f);
#pragma unroll
        for (int i = 0; i < 4; ++i) {
          const int k = (i * 64 + lane) * 4;
          const float h0 = v[j][i].x * rstd * nw[i].x * (1.f + sc[j][i].x) + sh[j][i].x;
          const float h1 = v[j][i].y * rstd * nw[i].y * (1.f + sc[j][i].y) + sh[j][i].y;
          const float h2 = v[j][i].z * rstd * nw[i].z * (1.f + sc[j][i].z) + sh[j][i].z;
          const float h3 = v[j][i].w * rstd * nw[i].w * (1.f + sc[j][i].w) + sh[j][i].w;
          *(uint2*)(hb + (size_t)rows[j] * DM + k) = make_uint2(pack2(h0, h1), pack2(h2, h3));
        }
      }
    }
  }
}

template <int MODE, int MT>
__device__ __forceinline__ void gemm_tile(const Params& p, const u16* __restrict__ A, const u16* __restrict__ B, const int K, const int mt,
                          const int nt, char* smem, u32x4 (&ra0)[MT], u32x4 (&rb0)[4], const bool have0, const bool has_next,
                          const int mt_next, const int nt_next) {
  constexpr int LDT = 72;
  constexpr int STAGE = 2 * 256 * LDT;
  u16* sm = (u16*)smem;
  int tid_ = threadIdx.x;
  asm volatile("" : "+v"(tid_));
  const int tid = tid_, lane = tid & 63, w = tid >> 6, wm = w >> 2, wn = w & 3, l31 = lane & 31, h = lane >> 5;
  constexpr int AROWS = 64 * MT;
  f32x16 acc[MT][2];
#pragma unroll
  for (int mi = 0; mi < MT; ++mi)
#pragma unroll
    for (int ni = 0; ni < 2; ++ni)
#pragma unroll
      for (int r = 0; r < 16; ++r) acc[mi][ni][r] = 0.f;
  const int srow = tid >> 3, sc8 = tid & 7;
  const u16* Ag = A + (size_t)(mt * AROWS + srow) * K + sc8 * 8;
  const u16* Bg = B + (size_t)(nt * 256 + srow) * K + sc8 * 8;
  const int nk = K / 64;
#define GLOAD(RA, RB, KT)                                                                                   \
  do {                                                                                                      \
    _Pragma("unroll") for (int i = 0; i < MT; ++i) RA[i] = *(const u32x4*)(Ag + (size_t)(i * 64) * K + (KT) * 64); \
    _Pragma("unroll") for (int i = 0; i < 4; ++i) RB[i] = *(const u32x4*)(Bg + (size_t)(i * 64) * K + (KT) * 64);  \
  } while (0)
#define SSTORE(RA, RB, ST)                                                                                  \
  do {                                                                                                      \
    u16* Ad = sm + (ST) * STAGE;                                                                            \
    _Pragma("unroll") for (int i = 0; i < MT; ++i) *(u32x4*)(Ad + (srow + i * 64) * LDT + sc8 * 8) = RA[i]; \
    _Pragma("unroll") for (int i = 0; i < 4; ++i) *(u32x4*)(Ad + 256 * LDT + (srow + i * 64) * LDT + sc8 * 8) = RB[i]; \
  } while (0)
#define LDFRAG(AF, BF, KS)                                                                                  \
  do {                                                                                                      \
    _Pragma("unroll") for (int mi = 0; mi < MT; ++mi) AF[mi] = *(const bf16x8*)(Abase + mi * 32 * LDT + (KS) * 16); \
    _Pragma("unroll") for (int ni = 0; ni < 2; ++ni) BF[ni] = *(const bf16x8*)(Bbase + ni * 32 * LDT + (KS) * 16);  \
  } while (0)
#define MMA(AF, BF)                                                                                         \
  do {                                                                                                      \
    _Pragma("unroll") for (int mi = 0; mi < MT; ++mi)                                                       \
    _Pragma("unroll") for (int ni = 0; ni < 2; ++ni) acc[mi][ni] = MFMA32(BF[ni], AF[mi], acc[mi][ni]);     \
  } while (0)
  auto compute = [&](const int st, const int kt) {
    const u16* Abase = sm + st * STAGE + (wm * (MT * 32) + l31) * LDT + h * 8;
    const u16* Bbase = sm + st * STAGE + 256 * LDT + (wn * 64 + l31) * LDT + h * 8;
    bf16x8 af0[MT], bf0[2], af1[MT], bf1[2];
    LDFRAG(af0, bf0, 0);
    __builtin_amdgcn_sched_barrier(0);
    LDFRAG(af1, bf1, 1);
    __builtin_amdgcn_sched_barrier(0);
    MMA(af0, bf0);
    __builtin_amdgcn_sched_barrier(0);
    LDFRAG(af0, bf0, 2);
    __builtin_amdgcn_sched_barrier(0);
    if (kt + 1 < nk) SSTORE(ra0, rb0, st ^ 1);
    __builtin_amdgcn_sched_barrier(0);
    MMA(af1, bf1);
    __builtin_amdgcn_sched_barrier(0);
    if (kt + 2 < nk) GLOAD(ra0, rb0, kt + 2);
    __builtin_amdgcn_sched_barrier(0);
    LDFRAG(af1, bf1, 3);
    __builtin_amdgcn_sched_barrier(0);
    MMA(af0, bf0);
    __builtin_amdgcn_sched_barrier(0);
    MMA(af1, bf1);
  };
  auto rowscale = [&]() {
    const float* ssq = (const float*)(p.ws + OFF_SSQ);
#pragma unroll
    for (int mi = 0; mi < MT; ++mi) {
      const int m = mt * AROWS + wm * (MT * 32) + mi * 32 + l31;
      float s = 0.f;
#pragma unroll
      for (int q = 0; q < 4; ++q) {
        float4 t = *(const float4*)(ssq + (size_t)m * 16 + q * 4);
        s += t.x + t.y + t.z + t.w;
      }
      const float rs = rsqrtf(s * (1.f / 1024.f) + 1e-6f);
#pragma unroll
      for (int ni = 0; ni < 2; ++ni)
#pragma unroll
        for (int r = 0; r < 16; ++r) acc[mi][ni][r] *= rs;
    }
  };
  if (!have0) GLOAD(ra0, rb0, 0);
  SSTORE(ra0, rb0, 0);
  GLOAD(ra0, rb0, 1);
  __syncthreads();
#pragma unroll 1
  for (int kt = 0; kt < nk; ++kt) {
    compute(kt & 1, kt);
    if (MODE == 1 && kt == 15) rowscale();
    __syncthreads();
  }
  if (has_next) {
    const u16* Ag2 = A + (size_t)(mt_next * AROWS + srow) * K + sc8 * 8;
    const u16* Bg2 = B + (size_t)(nt_next * 256 + srow) * K + sc8 * 8;
#pragma unroll
    for (int i = 0; i < MT; ++i) ra0[i] = *(const u32x4*)(Ag2 + (size_t)(i * 64) * K);
#pragma unroll
    for (int i = 0; i < 4; ++i) rb0[i] = *(const u32x4*)(Bg2 + (size_t)(i * 64) * K);
  }
#undef GLOAD
#undef SSTORE
#undef LDFRAG
#undef MMA
  if (MODE == 0) {
    if (nt < 24) {
      u16* u = (u16*)(p.ws + OFF_U);
      u16* cst = sm + w * (128 * 72);
#pragma unroll
      for (int mi = 0; mi < MT; ++mi) {
        const int m = mt * AROWS + wm * (MT * 32) + mi * 32 + l31;
#pragma unroll
        for (int ni = 0; ni < 2; ++ni)
#pragma unroll
          for (int g = 0; g < 4; ++g) {
            const int n = nt * 256 + wn * 64 + ni * 32 + 8 * g + 4 * h;
            const uint2 pk =
                make_uint2(pack2(acc[mi][ni][4 * g], acc[mi][ni][4 * g + 1]), pack2(acc[mi][ni][4 * g + 2], acc[mi][ni][4 * g + 3]));
            *(uint2*)(cst + (mi * 32 + l31) * 72 + ni * 32 + 8 * g + 4 * h) = pk;
            if (MT == 4 && nt >= 4 && nt < 12 && ((mi == 0 && l31 == 0) || (mi == 3 && l31 == 31)))
              *(uint2*)((u16*)(p.ws + OFF_HALO) + ((size_t)(m >> 7) * 2 + (mi == 3 ? 1 : 0)) * 2048 + (n - 1024)) = pk;
          }
      }
      {
        const int rr = lane >> 3, c8 = lane & 7;
        u16* ug = u + (size_t)(mt * AROWS + wm * (MT * 32) + rr) * UC + nt * 256 + wn * 64 + c8 * 8;
#pragma unroll
        for (int i = 0; i < MT * 4; ++i) {
          const u32x4 v = *(const u32x4*)(cst + (i * 8 + rr) * 72 + c8 * 8);
          *(u32x4*)(ug + (size_t)(i * 8) * UC) = v;
        }
      }
      __syncthreads();
    } else if (wn == 0) {
      float* dt = (float*)(p.ws + OFF_DT);
#pragma unroll
      for (int mi = 0; mi < MT; ++mi) {
        const int m = mt * AROWS + wm * (MT * 32) + mi * 32 + l31;
#pragma unroll
        for (int g = 0; g < 4; ++g)
          *(float4*)(dt + (size_t)m * 32 + 8 * g + 4 * h) =
              make_float4(acc[mi][0][4 * g], acc[mi][0][4 * g + 1], acc[mi][0][4 * g + 2], acc[mi][0][4 * g + 3]);
      }
    }
  } else {
    float* ob = (float*)(p.ws + OFF_OUTB);
    float* ssq2 = (float*)(p.ws + OFF_SSQ2);
    float* cst = (float*)smem + w * (MT * 32 * 36);
    float ssum[MT];
#pragma unroll
    for (int mi = 0; mi < MT; ++mi) ssum[mi] = 0.f;
#pragma unroll
    for (int ni = 0; ni < 2; ++ni) {
#pragma unroll
      for (int mi = 0; mi < MT; ++mi)
#pragma unroll
        for (int g = 0; g < 4; ++g) {
          const float4 v = make_float4(acc[mi][ni][4 * g], acc[mi][ni][4 * g + 1], acc[mi][ni][4 * g + 2], acc[mi][ni][4 * g + 3]);
          ssum[mi] += v.x * v.x + v.y * v.y + v.z * v.z + v.w * v.w;
          *(float4*)(cst + (mi * 32 + l31) * 36 + 8 * g + 4 * h) = v;
        }
      const int rr = lane >> 3, c4 = lane & 7;
      float* og = ob + (size_t)(mt * AROWS + wm * (MT * 32) + rr) * DM + nt * 256 + wn * 64 + ni * 32 + c4 * 4;
#pragma unroll
      for (int i = 0; i < MT * 4; ++i) {
        const float4 v = *(const float4*)(cst + (i * 8 + rr) * 36 + c4 * 4);
        *(float4*)(og + (size_t)(i * 8) * DM) = v;
      }
    }
#pragma unroll
    for (int mi = 0; mi < MT; ++mi) {
      const int m = mt * AROWS + wm * (MT * 32) + mi * 32 + l31;
      float s = ssum[mi];
      s += __shfl_xor(s, 32);
      if (h == 0) ssq2[(size_t)m * 16 + nt * 4 + wn] = s;
    }
    __syncthreads();
  }
}

__device__ __forceinline__ void phase_conv(const Params& p) {
  const int tid = otid();
  const int c8 = tid & 15, rg = tid >> 4;
  u16* u = (u16*)(p.ws + OFF_U);
  const u16* halo = (const u16*)(p.ws + OFF_HALO);
#pragma unroll 1
  for (int id = blockIdx.x; id < 96 * 16; id += gridDim.x) {
    const int c = id >> 4, strip = id & 15;
    const bool first = (c < 32) ? ((c & 1) == 0) : (((c - 32) & 7) == 0);
    const bool last = (c < 32) ? ((c & 1) == 1) : (((c - 32) & 7) == 7);
    const int ch = strip * 128 + c8 * 8;
    u16* up = u + (size_t)(c * 128 + rg * 4) * UC + 1024 + ch;
    u32x4 r[6];
    const u32x4 z4 = {0u, 0u, 0u, 0u};
#pragma unroll
    for (int i = 1; i < 5; ++i) r[i] = *(const u32x4*)(up + (ptrdiff_t)(i - 1) * UC);
    if (rg > 0) r[0] = *(const u32x4*)(up - UC);
    else r[0] = first ? z4 : *(const u32x4*)(halo + ((size_t)(c - 1) * 2 + 1) * 2048 + ch);
    if (rg < 31) r[5] = *(const u32x4*)(up + 4 * UC);
    else r[5] = last ? z4 : *(const u32x4*)(halo + ((size_t)(c + 1) * 2) * 2048 + ch);
    float w0[8], w1[8], w2[8], bs[8];
#pragma unroll
    for (int e = 0; e < 8; e += 4) {
      const float4 a = *(const float4*)(p.conv_w + ch + e), b = *(const float4*)(p.conv_w + 2048 + ch + e),
                   cc = *(const float4*)(p.conv_w + 4096 + ch + e), d = *(const float4*)(p.conv_b + ch + e);
      w0[e] = a.x; w0[e + 1] = a.y; w0[e + 2] = a.z; w0[e + 3] = a.w;
      w1[e] = b.x; w1[e + 1] = b.y; w1[e + 2] = b.z; w1[e + 3] = b.w;
      w2[e] = cc.x; w2[e + 1] = cc.y; w2[e + 2] = cc.z; w2[e + 3] = cc.w;
      bs[e] = d.x; bs[e + 1] = d.y; bs[e + 2] = d.z; bs[e + 3] = d.w;
    }
    u32x4 o[4];
#pragma unroll
    for (int i = 0; i < 4; ++i) {
      const unsigned pu[4] = {r[i][0], r[i][1], r[i][2], r[i][3]}, cu[4] = {r[i + 1][0], r[i + 1][1], r[i + 1][2], r[i + 1][3]},
                     nu[4] = {r[i + 2][0], r[i + 2][1], r[i + 2][2], r[i + 2][3]};
      unsigned ov[4];
#pragma unroll
      for (int e2 = 0; e2 < 4; ++e2) {
        const float v0 = w0[2 * e2] * lo_bf(pu[e2]) + w1[2 * e2] * lo_bf(cu[e2]) + w2[2 * e2] * lo_bf(nu[e2]) + bs[2 * e2];
        const float v1 = w0[2 * e2 + 1] * hi_bf(pu[e2]) + w1[2 * e2 + 1] * hi_bf(cu[e2]) + w2[2 * e2 + 1] * hi_bf(nu[e2]) + bs[2 * e2 + 1];
        ov[e2] = pack2(silu_f(v0), silu_f(v1));
      }
      o[i] = u32x4{ov[0], ov[1], ov[2], ov[3]};
    }
    __syncthreads();
#pragma unroll
    for (int i = 0; i < 4; ++i) *(u32x4*)(up + (ptrdiff_t)i * UC) = o[i];
  }
}

constexpr int SC_ARR = 143360;
constexpr int SC_ITEM = SC_ARR + 5632;
constexpr int SC_CW = SC_ARR + 6144;

template <int W>
DI void issue_rows(const u16* __restrict__ u, u32x4* r, const int ucol, const int tok0) {
  constexpr int PC = W / 8, RS = THREADS / PC, NI = 128 / RS;
  const int tid = otid();
  const int c8 = tid % PC, r0 = tid / PC;
  const u16* base = u + (size_t)(tok0 + r0) * UC + ucol + c8 * 8;
#pragma unroll
  for (int i = 0; i < NI; ++i) r[i] = *(const u32x4*)(base + (size_t)i * (RS * UC));
}
template <int W, bool WITHV, bool WITHW>
DI void finish_rows(const u32x4* r, u16* dst, u16* dstw, const int ld, const float* wgt) {
  constexpr int PC = W / 8, RS = THREADS / PC, NI = 128 / RS;
  const int tid = otid();
  const int c8 = tid % PC, r0 = tid / PC;
#pragma unroll
  for (int i = 0; i < NI; ++i) {
    const int row = r0 + RS * i;
    if (WITHV) *(u32x4*)(dst + row * ld + c8 * 8) = r[i];
    if (WITHW) {
      const float wg = wgt[row];
      const unsigned xu[4] = {r[i][0], r[i][1], r[i][2], r[i][3]};
      unsigned o[4];
#pragma unroll
      for (int e = 0; e < 4; ++e) o[e] = pack2(lo_bf(xu[e]) * wg, hi_bf(xu[e]) * wg);
      *(uint4*)(dstw + row * ld + c8 * 8) = make_uint4(o[0], o[1], o[2], o[3]);
    }
  }
}
DI void issue_qk(const u16* __restrict__ u, u32x4* r, const int ucol, const int tok0) {
  const int tid = otid();
  const int row = tid >> 2, pp = tid & 3;
  const int pa = (pp & 1) + (pp >> 1) * 4;
  const u16* up = u + (size_t)(tok0 + row) * UC + ucol;
  r[0] = *(const u32x4*)(up + pa * 8);
  r[1] = *(const u32x4*)(up + pa * 8 + 16);
}
DI void finish_qk(const u32x4* r, const float4* tb, u16* dst, const int ld, const bool rope, const float scale) {
  const int tid = otid();
  const int row = tid >> 2, pp = tid & 3;
  const int pa = (pp & 1) + (pp >> 1) * 4, pb = pa + 2;
  const unsigned au[4] = {r[0][0], r[0][1], r[0][2], r[0][3]}, bu[4] = {r[1][0], r[1][1], r[1][2], r[1][3]};
  const float tf[16] = {tb[0].x, tb[0].y, tb[0].z, tb[0].w, tb[1].x, tb[1].y, tb[1].z, tb[1].w,
                        tb[2].x, tb[2].y, tb[2].z, tb[2].w, tb[3].x, tb[3].y, tb[3].z, tb[3].w};
  float o1[8], o2[8];
#pragma unroll
  for (int e = 0; e < 8; ++e) {
    const float x1 = (e & 1) ? hi_bf(au[e >> 1]) : lo_bf(au[e >> 1]);
    const float x2 = (e & 1) ? hi_bf(bu[e >> 1]) : lo_bf(bu[e >> 1]);
    const float cs = rope ? tf[2 * e] : 1.f, sn = rope ? tf[2 * e + 1] : 0.f;
    o1[e] = (x1 * cs - x2 * sn) * scale;
    o2[e] = (x2 * cs + x1 * sn) * scale;
  }
  *(uint4*)(dst + row * ld + pa * 8) = make_uint4(pack2(o1[0], o1[1]), pack2(o1[2], o1[3]), pack2(o1[4], o1[5]), pack2(o1[6], o1[7]));
  *(uint4*)(dst + row * ld + pb * 8) = make_uint4(pack2(o2[0], o2[1]), pack2(o2[2], o2[3]), pack2(o2[4], o2[5]), pack2(o2[6], o2[7]));
}
template <int N, int P, bool SSD>
__device__ __forceinline__ void scan_item(const Params& p, char* smem, const int stream, const int b, const int hd, const int unit0, int* qctr, int* s_item) {
  constexpr int LQ = N + 8, LV = P + 8;
  constexpr int PT = P / 64, NKS = N / 16, NT = N / 32;
  constexpr int NQ = SSD ? 4 : 2;
  u16* Qs = (u16*)smem;
  u16* Ks = Qs + 128 * LQ;
  u16* Vs = Ks + 128 * LQ;
  u16* Vw = Vs + 128 * LV;
  u16* SfT = Vw + 128 * LV;
  u16* SbT = SfT + P * LQ;
  float* dtf = (float*)(smem + SC_ARR);
  float* dtb = dtf + 128;
  float* cumf = dtb + 128;
  float* cumb = cumf + 128;
  float* ecf = cumb + 128;
  float* ecb = ecf + 128;
  float* wgt = ecb + 128;
  float* fct = (float*)(smem + SC_CW);

  int tid_ = threadIdx.x;
  asm volatile("" : "+v"(tid_));
  const int tid = tid_, lane = tid & 63, w = __builtin_amdgcn_readfirstlane(tid >> 6), l31 = lane & 31, h = lane >> 5;
  const int strip = w & 3, half = w >> 2;
  const int ntile = w % NT, ptile = w / NT;
  const int q4 = (lane & 15) >> 2, p4 = lane & 3, blk = (lane >> 4) & 1;
  const int L = stream ? 1024 : 256, nc = L / 128;
  const int seqbase = stream ? NPR + b * 1024 : b * 256;
  char* wsb = p.ws;
  asm volatile("" : "+s"(wsb));
  const u16* u = (const u16*)(wsb + OFF_U);
  const float* dtraw = (const float*)(wsb + OFF_DT);
  u16* mix = (u16*)(wsb + OFF_MIX);
  float* ssq = (float*)(wsb + OFF_SSQ);
  uint2* dump = (uint2*)(wsb + OFF_DUMP);
  const float4* ropetab = (const float4*)(wsb + OFF_ROPE);

  float Dh = 0.f, lamf = 0.f, lamb = 0.f, bias_d = 0.f, A_d = 0.f;
  const int grp = hd >> 2;
  if (SSD) {
    Dh = p.ssd_D[hd];
    const int d = w & 1;
    bias_d = p.dt_bias[d * 16 + hd];
    A_d = expf(p.A_log[d * 16 + hd]);
  } else {
    lamf = -expf(p.ret_decay[hd]);
    lamb = -expf(p.ret_decay[8 + hd]);
  }

  u32x4 rq[NQ], rk[NQ], rx[4];
  uint2 rdump[4];
  float4 rt[4];
  float rd0 = 0.f, rd1 = 0.f;

  auto issue_loads = [&](const int c, const int sweep) {
    const int tok0 = seqbase + c * 128, t0 = c * 128;
    if (sweep) {
      const uint2* dp = dump + ((size_t)(unit0 + c) * 8 + w) * 256;
#pragma unroll
      for (int g = 0; g < 4; ++g) rdump[g] = dp[g * 64 + lane];
    }
    if (SSD) {
      if (sweep) issue_rows<128>(u, rq, 2560 + grp * 128, tok0);
      issue_rows<128>(u, rk, 2048 + grp * 128, tok0);
      issue_rows<64>(u, rx, 1024 + hd * 64, tok0);
      if (w < 2) {
        const int ol = otid() & 63;
        const int sj0 = (w & 1) ? 127 - 2 * ol : 2 * ol, sj1 = (w & 1) ? 126 - 2 * ol : 2 * ol + 1;
        rd0 = dtraw[(size_t)(tok0 + sj0) * 32 + w * 16 + hd];
        rd1 = dtraw[(size_t)(tok0 + sj1) * 32 + w * 16 + hd];
      }
    } else {
      if (sweep) issue_qk(u, rq, 3072 + hd * 64, tok0);
      issue_qk(u, rk, 3584 + hd * 64, tok0);
      issue_rows<128>(u, rx, 4096 + hd * 128, tok0);
      if (stream) {
        const int ot = otid();
        const int row = ot >> 2, pp = ot & 3;
        const float4* tp = ropetab + ((size_t)(t0 + row) * 32 + (pp >> 1) * 16 + (pp & 1) * 8) / 2;
#pragma unroll
        for (int i = 0; i < 4; ++i) rt[i] = tp[i];
      }
    }
  };

  auto finish_loads = [&](const int c, const int sweep) {
    if (SSD) {
      if (w < 2) {
        const int ol = otid() & 63;
        const int sj0 = (w & 1) ? 127 - 2 * ol : 2 * ol, sj1 = (w & 1) ? 126 - 2 * ol : 2 * ol + 1;
        const float raw0 = rd0 + bias_d, raw1 = rd1 + bias_d;
        const float dt0 = fmaxf(raw0, 0.f) + __logf(1.f + __expf(-fabsf(raw0)));
        const float dt1 = fmaxf(raw1, 0.f) + __logf(1.f + __expf(-fabsf(raw1)));
        const float la0 = -dt0 * A_d, la1 = -dt1 * A_d;
        float s = la0 + la1;
#pragma unroll
        for (int d = 1; d < 64; d <<= 1) {
          const float t = __shfl_up(s, d);
          if (lane >= d) s += t;
        }
        const float tot = __shfl(s, 63);
        const float c1 = s, c0 = s - la1;
        float* dta = w ? dtb : dtf;
        float* cua = w ? cumb : cumf;
        float* eca = w ? ecb : ecf;
        dta[sj0] = dt0; dta[sj1] = dt1;
        cua[sj0] = c0; cua[sj1] = c1;
        eca[sj0] = __expf(c0); eca[sj1] = __expf(c1);
        if (w == sweep) {
          wgt[sj0] = dt0 * __expf(tot - c0);
          wgt[sj1] = dt1 * __expf(tot - c1);
        }
      }
    } else {
      if (tid < 128) {
        const float cf = (float)(tid + 1) * lamf, cb = (float)(128 - tid) * lamb;
        dtf[tid] = 1.f; dtb[tid] = 1.f;
        cumf[tid] = cf; cumb[tid] = cb;
        ecf[tid] = __expf(cf); ecb[tid] = __expf(cb);
        wgt[tid] = sweep ? __expf((float)tid * lamb) : __expf((float)(127 - tid) * lamf);
      }
    }
    __syncthreads();
    if (sweep) {
      const int ot = otid();
      const int s = ot >> 7, j = ot & 127;
      float val = 0.f;
      if (j < s * 32) val = dtf[j] * __expf(cumf[s * 32 - 1] - cumf[j]);
      else if (j >= s * 32 + 32) val = dtb[j] * __expf(cumb[s * 32 + 32] - cumb[j]);
      fct[ot] = val;
    }
    if (SSD) {
      if (sweep) finish_rows<128, true, false>(rq, Qs, nullptr, LQ, nullptr);
      finish_rows<128, true, false>(rk, Ks, nullptr, LQ, nullptr);
      if (sweep) finish_rows<64, true, true>(rx, Vs, Vw, LV, wgt);
      else finish_rows<64, false, true>(rx, Vs, Vw, LV, wgt);
    } else {
      if (sweep) finish_qk(rq, rt, Qs, LQ, stream != 0, 1.f);
      finish_qk(rk, rt, Ks, LQ, stream != 0, 0.125f);
      if (sweep) finish_rows<128, true, true>(rx, Vs, Vw, LV, wgt);
      else finish_rows<128, false, true>(rx, Vs, Vw, LV, wgt);
    }
    if (sweep) {
#pragma unroll
      for (int g = 0; g < 4; ++g) *(uint2*)(SfT + (ptile * 32 + l31) * LQ + ntile * 32 + 8 * g + 4 * h) = rdump[g];
    }
    __syncthreads();
  };

  auto state_update = [&](f32x16& S, const float dec) {
#pragma unroll
    for (int r = 0; r < 16; ++r) S[r] *= dec;
    const u16* ka0 = Ks + (8 * h + q4) * LQ + ntile * 32 + 16 * blk + 4 * p4;
    const u16* vb0 = Vw + (8 * h + q4) * LV + ptile * 32 + 16 * blk + 4 * p4;
    s16x4 ta[8][2], tb[8][2];
#pragma unroll
    for (int ks = 0; ks < 8; ++ks) {
      ta[ks][0] = tr_read(ka0 + ks * 16 * LQ);
      ta[ks][1] = tr_read(ka0 + ks * 16 * LQ + 4 * LQ);
      tb[ks][0] = tr_read(vb0 + ks * 16 * LV);
      tb[ks][1] = tr_read(vb0 + ks * 16 * LV + 4 * LV);
    }
    __builtin_amdgcn_sched_barrier(0);
#pragma unroll
    for (int ks = 0; ks < 8; ++ks) S = MFMA32(cat8(ta[ks][0], ta[ks][1]), cat8(tb[ks][0], tb[ks][1]), S);
    __builtin_amdgcn_sched_barrier(0);
  };

  auto load_state = [&](f32x16& S, const int dir) {
    if (stream) {
      const float* sp = SSD ? p.state_ssd + ((size_t)((b * 2 + dir) * 16 + hd)) * 128 * 64
                            : p.state_ret + ((size_t)((b * 2 + dir) * 8 + hd)) * 64 * 128;
#pragma unroll
      for (int r = 0; r < 16; ++r) S[r] = sp[(ntile * 32 + crow(r, h)) * P + ptile * 32 + l31];
    } else {
#pragma unroll
      for (int r = 0; r < 16; ++r) S[r] = 0.f;
    }
  };
  auto store_state = [&](const f32x16& S, const int dir) {
    if (!stream) {
      float* op = SSD ? p.out + (size_t)NTOK * DM + ((size_t)((b * 2 + dir) * 16 + hd)) * 128 * 64
                      : p.out + (size_t)NTOK * DM + (size_t)16 * 2 * 16 * 128 * 64 + ((size_t)((b * 2 + dir) * 8 + hd)) * 64 * 128;
#pragma unroll
      for (int r = 0; r < 16; ++r) op[(ntile * 32 + crow(r, h)) * P + ptile * 32 + l31] = S[r];
    }
  };

  f32x16 S;
  issue_loads(0, 0);
  load_state(S, 0);
#pragma unroll 1
  for (int c = 0; c < nc; ++c) {
    finish_loads(c, 0);
    {
      uint2* dp = dump + ((size_t)(unit0 + c) * 8 + w) * 256;
#pragma unroll
      for (int g = 0; g < 4; ++g) dp[g * 64 + lane] = make_uint2(pack2(S[4 * g], S[4 * g + 1]), pack2(S[4 * g + 2], S[4 * g + 3]));
    }
    if (c + 1 < nc) issue_loads(c + 1, 0);
    else {
      issue_loads(nc - 1, 1);
#pragma unroll
      for (int g = 0; g < 4; ++g) rdump[g] = make_uint2(pack2(S[4 * g], S[4 * g + 1]), pack2(S[4 * g + 2], S[4 * g + 3]));
    }
    state_update(S, __expf(cumf[127]));
    __syncthreads();
  }
  store_state(S, 0);

  load_state(S, 1);
#pragma unroll
  for (int g = 0; g < 4; ++g)
    *(uint2*)(SbT + (ptile * 32 + l31) * LQ + ntile * 32 + 8 * g + 4 * h) =
        make_uint2(pack2(S[4 * g], S[4 * g + 1]), pack2(S[4 * g + 2], S[4 * g + 3]));
  int nextq = 0;
#pragma unroll 1
  for (int c = nc - 1; c >= 0; --c) {
    const int tok0 = seqbase + c * 128;
    finish_loads(c, 1);
    if (c == 0 && threadIdx.x == 0) nextq = atomicAdd(qctr, 1);
    if (c > 0) issue_loads(c - 1, 1);

    const u16* qrow = Qs + (strip * 32 + l31) * LQ + h * 8;
    constexpr bool SJ = SSD;
    constexpr int YT = SJ ? 2 : PT;
    f32x16 Y[YT];
    if constexpr (SJ) {
      const u16* Sx = half ? SbT : SfT;
      const float* ex = half ? ecb : ecf;
#pragma unroll
      for (int pt = 0; pt < 2; ++pt) {
        const int prow = pt * 32 + l31;
        bf16x8 fq[NKS], fs[NKS];
#pragma unroll
        for (int ks = 0; ks < NKS; ++ks) {
          fq[ks] = *(const bf16x8*)(qrow + ks * 16);
          fs[ks] = *(const bf16x8*)(Sx + prow * LQ + ks * 16 + h * 8);
        }
        __builtin_amdgcn_sched_barrier(0);
        f32x16 a1;
#pragma unroll
        for (int r = 0; r < 16; ++r) a1[r] = 0.f;
#pragma unroll
        for (int ks = 0; ks < NKS; ++ks) a1 = MFMA32(fq[ks], fs[ks], a1);
        __builtin_amdgcn_sched_barrier(0);
#pragma unroll
        for (int g = 0; g < 4; ++g) {
          const float4 ef = *(const float4*)(ex + strip * 32 + 8 * g + 4 * h);
          Y[pt][4 * g + 0] = ef.x * a1[4 * g + 0];
          Y[pt][4 * g + 1] = ef.y * a1[4 * g + 1];
          Y[pt][4 * g + 2] = ef.z * a1[4 * g + 2];
          Y[pt][4 * g + 3] = ef.w * a1[4 * g + 3];
        }
      }
    } else {
#pragma unroll
    for (int pt = 0; pt < PT; ++pt) {
      const int prow = (half * PT + pt) * 32 + l31;
      bf16x8 fq[NKS], fs[NKS];
      {
#pragma unroll
        for (int ks = 0; ks < NKS; ++ks) {
          fq[ks] = *(const bf16x8*)(qrow + ks * 16);
          fs[ks] = *(const bf16x8*)(SfT + prow * LQ + ks * 16 + h * 8);
        }
        __builtin_amdgcn_sched_barrier(0);
        f32x16 a1;
#pragma unroll
        for (int r = 0; r < 16; ++r) a1[r] = 0.f;
#pragma unroll
        for (int ks = 0; ks < NKS; ++ks) a1 = MFMA32(fq[ks], fs[ks], a1);
        __builtin_amdgcn_sched_barrier(0);
#pragma unroll
        for (int ks = 0; ks < NKS; ++ks) fs[ks] = *(const bf16x8*)(SbT + prow * LQ + ks * 16 + h * 8);
#pragma unroll
        for (int g = 0; g < 4; ++g) {
          const float4 ef = *(const float4*)(ecf + strip * 32 + 8 * g + 4 * h);
          Y[pt][4 * g + 0] = ef.x * a1[4 * g + 0];
          Y[pt][4 * g + 1] = ef.y * a1[4 * g + 1];
          Y[pt][4 * g + 2] = ef.z * a1[4 * g + 2];
          Y[pt][4 * g + 3] = ef.w * a1[4 * g + 3];
        }
      }
      {
        __builtin_amdgcn_sched_barrier(0);
        f32x16 a2;
#pragma unroll
        for (int r = 0; r < 16; ++r) a2[r] = 0.f;
#pragma unroll
        for (int ks = 0; ks < NKS; ++ks) a2 = MFMA32(fq[ks], fs[ks], a2);
        __builtin_amdgcn_sched_barrier(0);
#pragma unroll
        for (int g = 0; g < 4; ++g) {
          const float4 eb = *(const float4*)(ecb + strip * 32 + 8 * g + 4 * h);
          Y[pt][4 * g + 0] += eb.x * a2[4 * g + 0];
          Y[pt][4 * g + 1] += eb.y * a2[4 * g + 1];
          Y[pt][4 * g + 2] += eb.z * a2[4 * g + 2];
          Y[pt][4 * g + 3] += eb.w * a2[4 * g + 3];
        }
      }
    }
    }
    const int ii = strip * 32 + l31;
    const float cfi = cumf[ii], cbi = cumb[ii];

#pragma unroll 1
    for (int jj = 0; jj < (SJ ? 2 : 4); ++jj) {
      const int jt = SJ ? half * 2 + jj : jj;
      f32x16 G;
#pragma unroll
      for (int r = 0; r < 16; ++r) G[r] = 0.f;
      s16x4 tv[YT][4];
      {
        bf16x8 fk[NKS], fq[NKS];
#pragma unroll
        for (int ks = 0; ks < NKS; ++ks) {
          fk[ks] = *(const bf16x8*)(Ks + (jt * 32 + l31) * LQ + ks * 16 + h * 8);
          fq[ks] = *(const bf16x8*)(qrow + ks * 16);
        }
        __builtin_amdgcn_sched_barrier(0);
#pragma unroll
        for (int ks = 0; ks < NKS; ++ks) G = MFMA32(fk[ks], fq[ks], G);
        __builtin_amdgcn_sched_barrier(0);
#pragma unroll
        for (int pt = 0; pt < YT; ++pt) {
          const u16* vp = Vs + (jt * 32 + 4 * h + q4) * LV + (SJ ? pt : half * PT + pt) * 32 + 16 * blk + 4 * p4;
          tv[pt][0] = tr_read(vp);
          tv[pt][1] = tr_read(vp + 8 * LV);
          tv[pt][2] = tr_read(vp + 16 * LV);
          tv[pt][3] = tr_read(vp + 24 * LV);
        }
        __builtin_amdgcn_sched_barrier(0);
      }
      if (jt == strip) {
#pragma unroll
        for (int g = 0; g < 4; ++g) {
          const int jb = jt * 32 + 8 * g + 4 * h;
          const float4 cf4 = *(const float4*)(cumf + jb), cb4 = *(const float4*)(cumb + jb);
          const float4 df4 = *(const float4*)(dtf + jb), db4 = *(const float4*)(dtb + jb);
          const float cfa[4] = {cf4.x, cf4.y, cf4.z, cf4.w}, cba[4] = {cb4.x, cb4.y, cb4.z, cb4.w};
          const float dfa[4] = {df4.x, df4.y, df4.z, df4.w}, dba[4] = {db4.x, db4.y, db4.z, db4.w};
#pragma unroll
          for (int e = 0; e < 4; ++e) {
            const int j = jb + e;
            const float tf = __expf(cfi - cfa[e]) * dfa[e];
            const float tb = __expf(cbi - cba[e]) * dba[e];
            const float m = ((ii >= j) ? tf : 0.f) + ((ii <= j) ? tb : 0.f);
            float pv = G[4 * g + e] * m;
            if (SSD && ii == j) pv += Dh;
            G[4 * g + e] = pv;
          }
        }
      } else {
        const float ei = (jt < strip) ? __expf(cfi - cumf[strip * 32 - 1]) : __expf(cbi - cumb[strip * 32 + 32]);
#pragma unroll
        for (int g = 0; g < 4; ++g) {
          const float4 f4 = *(const float4*)(fct + strip * 128 + jt * 32 + 8 * g + 4 * h);
          G[4 * g + 0] *= ei * f4.x;
          G[4 * g + 1] *= ei * f4.y;
          G[4 * g + 2] *= ei * f4.z;
          G[4 * g + 3] *= ei * f4.w;
        }
      }
      const bf16x8 pf0 = pack8(G[0], G[1], G[2], G[3], G[4], G[5], G[6], G[7]);
      const bf16x8 pf1 = pack8(G[8], G[9], G[10], G[11], G[12], G[13], G[14], G[15]);
#pragma unroll
      for (int pt = 0; pt < YT; ++pt) {
        Y[pt] = MFMA32(pf0, cat8(tv[pt][0], tv[pt][1]), Y[pt]);
        Y[pt] = MFMA32(pf1, cat8(tv[pt][2], tv[pt][3]), Y[pt]);
      }
    }
    state_update(S, __expf(cumb[0]));
    constexpr int CPR = P / 8, NIT = 128 * CPR / THREADS;
    const int ec8 = tid % CPR, er0 = tid / CPR;
    const int ecol = SSD ? hd * 64 + ec8 * 8 : hd * 128 + ec8 * 8;
    uint4 gz[NIT];
#pragma unroll
    for (int i = 0; i < NIT; ++i)
      gz[i] = *(const uint4*)(u + (size_t)(tok0 + er0 + i * (THREADS / CPR)) * UC + (SSD ? 0 : 5120) + ecol);
    const float* nwp = SSD ? p.ssd_norm_w + ecol : p.ret_norm_w + ecol;
    const float4 n0 = *(const float4*)nwp, n1 = *(const float4*)(nwp + 4);
    const float nw[8] = {n0.x, n0.y, n0.z, n0.w, n1.x, n1.y, n1.z, n1.w};
    __syncthreads();
#pragma unroll
    for (int g = 0; g < 4; ++g)
      *(uint2*)(SbT + (ptile * 32 + l31) * LQ + ntile * 32 + 8 * g + 4 * h) =
          make_uint2(pack2(S[4 * g], S[4 * g + 1]), pack2(S[4 * g + 2], S[4 * g + 3]));
    constexpr int LY = P + 4;
    float* Yst = (float*)smem;
#pragma unroll
    for (int pt = 0; pt < YT; ++pt)
#pragma unroll
      for (int r = 0; r < 16; ++r)
        Yst[(SJ ? half * (128 * LY) : 0) + (strip * 32 + crow(r, h)) * LY + (SJ ? pt : half * PT + pt) * 32 + l31] = Y[pt][r];
    __syncthreads();
#pragma unroll
    for (int i = 0; i < NIT; ++i) {
      const int row = er0 + i * (THREADS / CPR);
      const float* yp = Yst + row * LY + ec8 * 8;
      const float4 y0 = *(const float4*)yp, y1 = *(const float4*)(yp + 4);
      float v[8] = {y0.x, y0.y, y0.z, y0.w, y1.x, y1.y, y1.z, y1.w};
      if constexpr (SJ) {
        const float4 z0 = *(const float4*)(yp + 128 * LY), z1 = *(const float4*)(yp + 128 * LY + 4);
        v[0] += z0.x; v[1] += z0.y; v[2] += z0.z; v[3] += z0.w;
        v[4] += z1.x; v[5] += z1.y; v[6] += z1.z; v[7] += z1.w;
      }
      const size_t tok = (size_t)(tok0 + row);
      const unsigned zu[4] = {gz[i].x, gz[i].y, gz[i].z, gz[i].w};
      if (SSD) {
        float sq = 0.f;
#pragma unroll
        for (int e = 0; e < 8; ++e) {
          const float z = (e & 1) ? hi_bf(zu[e >> 1]) : lo_bf(zu[e >> 1]);
          v[e] *= silu_f(z);
          sq += v[e] * v[e];
        }
        sq += __shfl_xor(sq, 1);
        sq += __shfl_xor(sq, 2);
        sq += __shfl_xor(sq, 4);
        if (ec8 == 0) ssq[tok * 16 + hd] = sq;
        *(uint4*)(mix + tok * 2048 + ecol) = make_uint4(pack2(v[0] * nw[0], v[1] * nw[1]), pack2(v[2] * nw[2], v[3] * nw[3]),
                                                        pack2(v[4] * nw[4], v[5] * nw[5]), pack2(v[6] * nw[6], v[7] * nw[7]));
      } else {
        float s = 0.f;
#pragma unroll
        for (int e = 0; e < 8; ++e) s += v[e];
        s += __shfl_xor(s, 1);
        s += __shfl_xor(s, 2);
        s += __shfl_xor(s, 4);
        s += __shfl_xor(s, 8);
        const float mean = s * (1.f / 128.f);
        float s2 = 0.f;
#pragma unroll
        for (int e = 0; e < 8; ++e) {
          v[e] -= mean;
          s2 += v[e] * v[e];
        }
        s2 += __shfl_xor(s2, 1);
        s2 += __shfl_xor(s2, 2);
        s2 += __shfl_xor(s2, 4);
        s2 += __shfl_xor(s2, 8);
        const float rstd = rsqrtf(s2 * (1.f / 128.f) + 1e-6f);
#pragma unroll
        for (int e = 0; e < 8; ++e) {
          const float gv = (e & 1) ? hi_bf(zu[e >> 1]) : lo_bf(zu[e >> 1]);
          v[e] = v[e] * rstd * nw[e] * silu_f(gv);
        }
        *(uint4*)(mix + tok * 2048 + 1024 + ecol) =
            make_uint4(pack2(v[0], v[1]), pack2(v[2], v[3]), pack2(v[4], v[5]), pack2(v[6], v[7]));
      }
    }
  }
  store_state(S, 1);
  if (threadIdx.x == 0) *s_item = nextq;
}

__device__ __forceinline__ void phase3(const Params& p, char* smem, const int ctr_idx) {
  int* s_item = (int*)(smem + SC_ITEM);
  int* ctr = (int*)(p.ws + OFF_CTR) + ctr_idx;
  if (threadIdx.x == 0) *s_item = atomicAdd(ctr, 1);
  __syncthreads();
#pragma unroll 1
  for (;;) {
    const int q = *s_item;
    __syncthreads();
    if (q >= 576) break;
    int kind, stream, bb, hd, unit0;
    if (q < 128) { kind = 0; stream = 1; bb = q >> 4; hd = q & 15; unit0 = q * 8; }
    else if (q < 192) { kind = 1; stream = 1; bb = (q - 128) >> 3; hd = (q - 128) & 7; unit0 = 1024 + (q - 128) * 8; }
    else if (q < 448) { kind = 0; stream = 0; bb = (q - 192) >> 4; hd = (q - 192) & 15; unit0 = 1536 + (q - 192) * 2; }
    else { kind = 1; stream = 0; bb = (q - 448) >> 3; hd = (q - 448) & 7; unit0 = 2048 + (q - 448) * 2; }
    if (kind == 0) scan_item<128, 64, true>(p, smem, stream, bb, hd, unit0, ctr, s_item);
    else scan_item<64, 128, false>(p, smem, stream, bb, hd, unit0, ctr, s_item);
    __syncthreads();
  }
}

__device__ __forceinline__ void phase5(const Params& p) {
  const int tid = otid(), lane = tid & 63, w = tid >> 6;
  const float* mod = (const float*)(p.ws + OFF_MOD);
  const float* ob = (const float*)(p.ws + OFF_OUTB);
  const float* ssq2 = (const float*)(p.ws + OFF_SSQ2);
  for (int row = blockIdx.x * 8 + w; row < NTOK; row += gridDim.x * 8) {
    const float* xr = (row < NPR) ? p.x_prompt + (size_t)row * DM : p.x_sample + (size_t)(row - NPR) * DM;
    const int mr = (row < NPR) ? 0 : 1 + ((row - NPR) >> 10);
    float s = (lane < 16) ? ssq2[(size_t)row * 16 + lane] : 0.f;
#pragma unroll
    for (int m = 8; m >= 1; m >>= 1) s += __shfl_xor(s, m);
    s = __shfl(s, 0);
    const float rstd = rsqrtf(s * (1.f / 1024.f) + 1e-6f);
#pragma unroll
    for (int i = 0; i < 4; ++i) {
      const int k = (i * 64 + lane) * 4;
      const float4 xv = *(const float4*)(xr + k);
      const float4 ov = *(const float4*)(ob + (size_t)row * DM + k);
      const float4 nw = *(const float4*)(p.norm_post_w + k);
      const float4 gt = *(const float4*)(mod + mr * 3072 + 2048 + k);
      float4 y;
      y.x = xv.x + gt.x * ov.x * rstd * nw.x;
      y.y = xv.y + gt.y * ov.y * rstd * nw.y;
      y.z = xv.z + gt.z * ov.z * rstd * nw.z;
      y.w = xv.w + gt.w * ov.w * rstd * nw.w;
      *(float4*)(p.out + (size_t)row * DM + k) = y;
    }
  }
}

__global__ void __launch_bounds__(THREADS) fwd_megakernel(Params p) {
  extern __shared__ __attribute__((aligned(16))) char smem[];
  cg::grid_group grid = cg::this_grid();
  const int G = gridDim.x;
  const int bx = blockIdx.x;
  const int rb = (G % 8 == 0) ? (bx % 8) * (G / 8) + bx / 8 : bx;

  unsigned* gbar = (unsigned*)(p.ws + OFF_CTR + 1024);
  unsigned epoch = 0u;
  volatile LAS unsigned* xst = (volatile LAS unsigned*)(smem + 153984);
  if (threadIdx.x == 0) { xst[0] = 0u; xst[1] = 0u; xst[2] = 0u; xst[3] = 0u; }
  __syncthreads();
  const XcdBarrier xb = xcd_barrier_post((unsigned*)(p.ws + OFF_CTR + 8192), xst);
  if (p.ws == nullptr) grid.sync();
  phase0(p, smem);
  xcd_barrier(xb);
#if PROBE == 5
  phase0(p, smem);
  xcd_barrier(xb);
#endif
#if PROBE == 4
  for (int i = 0; i < 10; ++i) xcd_barrier(xb);
#endif
  phase1(p);
  xcd_barrier(xb);
#if PROBE == 6
  phase1(p);
  xcd_barrier(xb);
#endif
  {
    u32x4 sra[4], srb[4];
    bool have0 = false;
    for (int id = rb; id < 48 * 25; id += G) {
      const int band = id / 200, rem = id % 200;
      const int id2 = id + G;
      const bool has2 = id2 < 48 * 25;
      const int band2 = id2 / 200, rem2 = id2 % 200;
      gemm_tile<0, 4>(p, (const u16*)(p.ws + OFF_H), (const u16*)(p.ws + OFF_WTIN), 1024, band * 8 + (rem & 7), rem >> 3, smem, sra, srb,
                      have0, has2, band2 * 8 + (rem2 & 7), rem2 >> 3);
      have0 = has2;
    }
  }
  {
    const int nfull = (48 * 25) % G;
    const int nhelp = (nfull > 0) ? G - nfull : G;
    const int hb = (nfull > 0) ? rb - nfull : rb;
    if (hb >= 0)
      for (int q = hb; q < 512; q += nhelp)
        p0_transpose_item(p.w_out, 1024, (u16*)(p.ws + OFF_WTOUT), 2048, q / 16, q % 16, 1024, false, smem);
  }
  xcd_barrier(xb);
#if PROBE == 1
  for (int id = rb; id < 48 * 25; id += G) {
    const int band = id / 200, rem = id % 200;
    u32x4 sra[4], srb[4];
    gemm_tile<0, 4>(p, (const u16*)(p.ws + OFF_H), (const u16*)(p.ws + OFF_WTIN), 1024, band * 8 + (rem & 7), rem >> 3, smem, sra, srb, false, false, 0, 0);
  }
  xcd_barrier(xb);
#endif
  phase_conv(p);
  xcd_barrier(xb);
  phase3(p, smem, 0);
#if PROBE == 2
  phase3(p, smem, 1);
#endif
  xcd_barrier(xb);
#if PROBE == 3
  for (int id = rb; id < 64 * 4; id += G)
  {
    u32x4 sra[3], srb[4];
    gemm_tile<1, 3>(p, (const u16*)(p.ws + OFF_MIX), (const u16*)(p.ws + OFF_WTOUT), 2048, id >> 2, id & 3, smem, sra, srb, false, false, 0, 0);
  }
  xcd_barrier(xb);
#endif
  for (int id = rb; id < 64 * 4; id += G)
  {
    u32x4 sra[3], srb[4];
    gemm_tile<1, 3>(p, (const u16*)(p.ws + OFF_MIX), (const u16*)(p.ws + OFF_WTOUT), 2048, id >> 2, id & 3, smem, sra, srb, false, false, 0, 0);
  }
  xcd_barrier(xb);
  phase5(p);
#if PROBE == 7
  phase5(p);
#endif
}

extern "C" void kernel_launch(void* const* d_in, const int* in_sizes, int n_in, void* d_out, int out_size, void* d_ws,
                              size_t ws_size, hipStream_t stream) {
  static int grid_blocks = 0;
  if (!grid_blocks) {
    int dev = 0, cus = 0, per_cu = 0;
    hipGetDevice(&dev);
    hipDeviceGetAttribute(&cus, hipDeviceAttributeMultiprocessorCount, dev);
    hipFuncSetAttribute((const void*)fwd_megakernel, hipFuncAttributeMaxDynamicSharedMemorySize, SMEM_BYTES);
    hipOccupancyMaxActiveBlocksPerMultiprocessor(&per_cu, fwd_megakernel, THREADS, SMEM_BYTES);
    if (per_cu < 1) per_cu = 1;
    grid_blocks = cus * per_cu;
  }
  Params p{};
  const float* const* in = (const float* const*)d_in;
  p.x_prompt = in[0]; p.x_sample = in[1]; p.state_ssd = in[2]; p.state_ret = in[3]; p.c = in[4]; p.c_ctx = in[5];
  p.w_mod = in[6]; p.b_mod = in[7]; p.norm_pre_w = in[8]; p.norm_post_w = in[9]; p.w_in = in[10]; p.conv_w = in[11];
  p.conv_b = in[12]; p.A_log = in[13]; p.dt_bias = in[14]; p.ssd_D = in[15]; p.ssd_norm_w = in[16]; p.ret_decay = in[17];
  p.ret_norm_w = in[18]; p.w_out = in[19];
  p.out = (float*)d_out;
  p.ws = (char*)d_ws;
  hipMemsetAsync((char*)d_ws + OFF_CTR, 0, 8192 + 16384, stream);
  void* args[] = {&p};
  hipError_t e = hipLaunchCooperativeKernel((void*)fwd_megakernel, dim3(grid_blocks), dim3(THREADS), args, SMEM_BYTES, stream);
  if (e != hipSuccess) fprintf(stderr, "cooperative launch failed: %s (grid %d)\n", hipGetErrorString(e), grid_blocks);
}
```

```cpp
#include <hip/hip_runtime.h>
#include <hip/hip_cooperative_groups.h>
#include <cstdio>
namespace cg = cooperative_groups;

typedef unsigned short u16;
typedef __bf16 bf16v2 __attribute__((ext_vector_type(2)));
typedef float f32v2 __attribute__((ext_vector_type(2)));
typedef short s16x4 __attribute__((ext_vector_type(4)));
using bf16x8 = __attribute__((ext_vector_type(8))) short;
using f32x16 = __attribute__((ext_vector_type(16))) float;
using f32x4n = __attribute__((ext_vector_type(4))) float;
using u32x4 = __attribute__((ext_vector_type(4))) unsigned;
#define DI __device__ __forceinline__
#define MFMA32(a, b, c) __builtin_amdgcn_mfma_f32_32x32x16_bf16((a), (b), (c), 0, 0, 0)

constexpr int NTOK = 12288;
constexpr int NPR = 4096;
constexpr int DM = 1024;
constexpr int INC = 6176;
constexpr int UC = 6144;
#ifndef PROBE
#define PROBE 0
#endif
constexpr int THREADS = 512;
constexpr int SMEM_BYTES = 152 * 1024;

constexpr size_t OFF_MOD = 0;
constexpr size_t OFF_ROPE = 131072;
constexpr size_t OFF_CTR = 393216;
constexpr size_t OFF_H = 524288;
constexpr size_t OFF_WTIN = OFF_H + 25165824;
constexpr size_t OFF_DUMP = OFF_H;
constexpr size_t OFF_WTOUT = OFF_WTIN + 13107200;
constexpr size_t OFF_U = OFF_WTOUT + 4194304;
constexpr size_t OFF_OUTB = OFF_U;
constexpr size_t OFF_DT = OFF_U + 150994944;
constexpr size_t OFF_MIX = OFF_DT + 1572864;
constexpr size_t OFF_SSQ = OFF_MIX + 50331648;
constexpr size_t OFF_SSQ2 = OFF_SSQ + 1572864;
constexpr size_t OFF_HALO = OFF_SSQ2 + 786432;

struct Params {
  const float *x_prompt, *x_sample, *state_ssd, *state_ret, *c, *c_ctx, *w_mod, *b_mod, *norm_pre_w, *norm_post_w,
      *w_in, *conv_w, *conv_b, *A_log, *dt_bias, *ssd_D, *ssd_norm_w, *ret_decay, *ret_norm_w, *w_out;
  float* out;
  char* ws;
};

DI float bf2f(u16 v) { return __uint_as_float(((unsigned)v) << 16); }
DI unsigned pack2(float a, float b) {
  f32v2 f = {a, b};
  bf16v2 r = __builtin_convertvector(f, bf16v2);
  return __builtin_bit_cast(unsigned, r);
}
DI u16 f2bf(float a) { return (u16)(pack2(a, 0.f) & 0xffffu); }
DI float lo_bf(unsigned v) { return __uint_as_float(v << 16); }
DI float hi_bf(unsigned v) { return __uint_as_float(v & 0xffff0000u); }
DI float silu_f(float v) { return v * __builtin_amdgcn_rcpf(1.f + __expf(-v)); }
DI int crow(int r, int h) { return (r & 3) + 8 * (r >> 2) + 4 * h; }
DI int otid() {
  int t = threadIdx.x;
  asm volatile("" : "+v"(t));
  return t;
}
DI s16x4 tr_read(const u16* p) {
  return __builtin_amdgcn_ds_read_tr16_b64_v4i16((s16x4 __attribute__((address_space(3)))*)(p));
}
DI bf16x8 cat8(s16x4 lo, s16x4 hi) { return __builtin_shufflevector(lo, hi, 0, 1, 2, 3, 4, 5, 6, 7); }
DI bf16x8 pack8(float a0, float a1, float a2, float a3, float a4, float a5, float a6, float a7) {
  uint4 v = make_uint4(pack2(a0, a1), pack2(a2, a3), pack2(a4, a5), pack2(a6, a7));
  return __builtin_bit_cast(bf16x8, v);
}


DI void grid_barrier(unsigned* bar, unsigned& epoch) {
  asm volatile("s_waitcnt vmcnt(0)" ::: "memory");
  __syncthreads();
  if (threadIdx.x == 0) {
    __builtin_amdgcn_fence(__ATOMIC_RELEASE, "agent");
    asm volatile("s_waitcnt vmcnt(0)" ::: "memory");
    const unsigned G = gridDim.x;
    const unsigned ng = (G % 8u == 0u) ? 8u : 1u;
    const unsigned gs = G / ng, g = blockIdx.x % ng, e1 = epoch + 1u;
    const unsigned old = __hip_atomic_fetch_add(&bar[64u * (1u + g)], 1u, __ATOMIC_RELAXED, __HIP_MEMORY_SCOPE_AGENT);
    if (old + 1u == gs * e1) {
      const unsigned o2 = __hip_atomic_fetch_add(&bar[0], 1u, __ATOMIC_RELAXED, __HIP_MEMORY_SCOPE_AGENT);
      if (o2 + 1u == ng * e1) __hip_atomic_fetch_add(&bar[64u * 16u], 1u, __ATOMIC_RELAXED, __HIP_MEMORY_SCOPE_AGENT);
    }
    while (__hip_atomic_load(&bar[64u * 16u], __ATOMIC_RELAXED, __HIP_MEMORY_SCOPE_AGENT) < e1) __builtin_amdgcn_s_sleep(1);
    __builtin_amdgcn_fence(__ATOMIC_ACQUIRE, "agent");
    asm volatile("s_waitcnt vmcnt(0)" ::: "memory");
  }
  __syncthreads();
  ++epoch;
}


#define XB_TMO      128
#define XB_XCNT(j)  (256  + 64 * (j))
#define XB_XSUB(j)  (1280 + 64 * (j))
#define XB_XGEN(j)  (2304 + 64 * (j))
#define XB_TOP      3328
#define XB_TOPGEN   3392
#define XB_SPIN_CAP (1u << 22)
#define LAS __attribute__((address_space(3)))
DI unsigned xb_ld(unsigned* p) { return __hip_atomic_load(p, __ATOMIC_RELAXED, __HIP_MEMORY_SCOPE_AGENT); }
DI unsigned xb_add(unsigned* p, unsigned v) { return __hip_atomic_fetch_add(p, v, __ATOMIC_RELAXED, __HIP_MEMORY_SCOPE_AGENT); }
DI unsigned xb_xcc_id() { return (unsigned)__builtin_amdgcn_s_getreg((3 << 11) | 20) & 0xFu; }
#define XB_SPIN(cond, bar) do { unsigned _sp = 0; while (cond) { __builtin_amdgcn_s_sleep(1); \
    if ((++_sp & 255u) == 0u) { if (xb_ld(&(bar)[XB_TMO])) break; if (_sp > XB_SPIN_CAP) { atomicAdd(&(bar)[XB_TMO], 1u); break; } } } } while (0)
struct XcdBarrier { unsigned* bar; unsigned x; volatile LAS unsigned* st; };
DI XcdBarrier xcd_barrier_post(unsigned* bar, volatile LAS unsigned* st) {
  XcdBarrier b; b.bar = bar; b.x = xb_xcc_id(); b.st = st;
  if (threadIdx.x == 0) (void)xb_add(&bar[XB_XCNT(b.x)], 1u);
  return b;
}
DI void xcd_barrier_complete(unsigned* bar, unsigned x, unsigned& nloc, unsigned& nx) {
  const unsigned G = gridDim.x;
  unsigned sum, cnt, mine, sp = 0u;
  for (;;) {
    sum = 0u; cnt = 0u; mine = 0u;
#pragma unroll
    for (unsigned j = 0; j < 16; ++j) { const unsigned c = xb_ld(&bar[XB_XCNT(j)]); sum += c; cnt += (c > 0u) ? 1u : 0u; mine = (j == x) ? c : mine; }
    if (sum == G) break;
    __builtin_amdgcn_s_sleep(1);
    if ((++sp & 255u) == 0u) { if (xb_ld(&bar[XB_TMO])) break; if (sp > XB_SPIN_CAP) { atomicAdd(&bar[XB_TMO], 1u); break; } }
  }
  nloc = mine > 0u ? mine : 1u; nx = cnt > 0u ? cnt : 1u;
}
DI void xcd_barrier(const XcdBarrier& b) {
  asm volatile("s_waitcnt vmcnt(0)" ::: "memory");
  __syncthreads();
  if (threadIdx.x == 0) {
    unsigned* bar = b.bar;
    __builtin_amdgcn_s_waitcnt(0);
    unsigned nloc = b.st[0], nx = b.st[1];
    if (nloc == 0u) { xcd_barrier_complete(bar, b.x, nloc, nx); b.st[0] = nloc; b.st[1] = nx; }
    const unsigned old = xb_add(&bar[XB_XSUB(b.x)], 1u);
    const unsigned gen = old / nloc;
    if (old + 1u == (gen + 1u) * nloc) {
      __builtin_amdgcn_fence(__ATOMIC_RELEASE, "agent");
      asm volatile("s_waitcnt vmcnt(0)" ::: "memory");
      const unsigned og = xb_add(&bar[XB_TOP], 1u);
      const unsigned tg = og / nx;
      if (og + 1u == (tg + 1u) * nx) xb_add(&bar[XB_TOPGEN], 1u);
      else XB_SPIN(xb_ld(&bar[XB_TOPGEN]) == tg, bar);
      __builtin_amdgcn_fence(__ATOMIC_ACQUIRE, "agent");
      xb_add(&bar[XB_XGEN(b.x)], 1u);
      asm volatile("s_waitcnt vmcnt(0)" ::: "memory");
    } else {
      XB_SPIN(xb_ld(&bar[XB_XGEN(b.x)]) == gen, bar);
      __builtin_amdgcn_fence(__ATOMIC_ACQUIRE, "agent");
      asm volatile("s_waitcnt vmcnt(0)" ::: "memory");
    }
  }
  __syncthreads();
}

__device__ __forceinline__ void p0_mod_item(const Params& p, char* smem, int it) {
  float* sc = (float*)smem;
  float* red = sc + 9 * 1024;
  const int tid = threadIdx.x, lane = tid & 63, w = tid >> 6;
  for (int idx = tid; idx < 9 * 1024; idx += THREADS) {
    int r = idx >> 10, k = idx & 1023;
    float v = (r == 0) ? p.c_ctx[k] : p.c[(r - 1) * 1024 + k];
    sc[idx] = v / (1.f + expf(-v));
  }
  __syncthreads();
  const int cg4 = tid & 7, kg = tid >> 3, n0 = it * 32;
  float acc[9][4];
#pragma unroll
  for (int r = 0; r < 9; ++r)
#pragma unroll
    for (int e = 0; e < 4; ++e) acc[r][e] = 0.f;
  float4 wv[16];
#pragma unroll
  for (int i = 0; i < 16; ++i) { const f32x4n t_ = __builtin_nontemporal_load((const f32x4n*)(p.w_mod + (size_t)(kg * 16 + i) * 3072 + n0 + cg4 * 4)); wv[i] = make_float4(t_[0], t_[1], t_[2], t_[3]); }
#pragma unroll
  for (int i = 0; i < 16; ++i) {
#pragma unroll
    for (int r = 0; r < 9; ++r) {
      const float s = sc[r * 1024 + kg * 16 + i];
      acc[r][0] += s * wv[i].x; acc[r][1] += s * wv[i].y; acc[r][2] += s * wv[i].z; acc[r][3] += s * wv[i].w;
    }
  }
#pragma unroll
  for (int r = 0; r < 9; ++r)
#pragma unroll
    for (int e = 0; e < 4; ++e) {
      float v = acc[r][e];
      v += __shfl_xor(v, 8);
      v += __shfl_xor(v, 16);
      v += __shfl_xor(v, 32);
      acc[r][e] = v;
    }
  if (lane < 8) {
#pragma unroll
    for (int r = 0; r < 9; ++r)
#pragma unroll
      for (int e = 0; e < 4; ++e) red[(w * 9 + r) * 32 + lane * 4 + e] = acc[r][e];
  }
  __syncthreads();
  float* mod = (float*)(p.ws + OFF_MOD);
  if (tid < 9 * 32) {
    int r = tid >> 5, c2 = tid & 31;
    float s = p.b_mod[n0 + c2];
#pragma unroll
    for (int g = 0; g < 8; ++g) s += red[(g * 9 + r) * 32 + c2];
    mod[r * 3072 + n0 + c2] = s;
  }
  __syncthreads();
}

__device__ __forceinline__ void p0_transpose_item(const float* __restrict__ src, int lds_src, u16* __restrict__ dst, int ldk, int kt, int nt,
                                  int nvalid, bool permute, char* smem) {
  u16* T = (u16*)smem;
  const int tid = threadIdx.x, cc = tid & 63, kr = tid >> 6;
  const int n = nt * 64 + cc;
  int on = n;
  if (permute) on = (n < 3072) ? n : (n < 6144 ? n + 32 : n - 3072);
#pragma unroll
  for (int i = 0; i < 8; ++i) {
    int kk = kr + i * 8;
    float v = (n < nvalid) ? __builtin_nontemporal_load(src + (size_t)(kt * 64 + kk) * lds_src + on) : 0.f;
    T[cc * 72 + kk] = f2bf(v);
  }
  __syncthreads();
  const int row = tid >> 3, c8 = tid & 7;
  uint4 v = *(const uint4*)(T + row * 72 + c8 * 8);
  *(uint4*)(dst + (size_t)(nt * 64 + row) * ldk + kt * 64 + c8 * 8) = v;
  __syncthreads();
}

__device__ __forceinline__ void phase0(const Params& p, char* smem) {
  const int tid = threadIdx.x;

  constexpr int N_MOD = 96, N_WIN = 1600, N_ROPE = 64;
  for (int it = blockIdx.x; it < N_MOD + N_WIN + N_ROPE; it += gridDim.x) {
    if (it < N_MOD) {
      p0_mod_item(p, smem, it);
    } else if (it < N_MOD + N_WIN) {
      int q = it - N_MOD;
      p0_transpose_item(p.w_in, INC, (u16*)(p.ws + OFF_WTIN), 1024, q / 100, q % 100, INC, true, smem);
    } else {
      int q = it - N_MOD - N_WIN;
      int idx = q * 512 + tid;
      int pos = idx >> 5, m = idx & 31, fm = m & 15;
      float inv = exp2f(-(float)(2 * fm) / 32.f * 13.287712379549449f);
      float coord = (float)((m < 16) ? (pos >> 6) : (pos & 63));
      float ang = coord * inv;
      float* tab = (float*)(p.ws + OFF_ROPE);
      tab[idx * 2] = __cosf(ang);
      tab[idx * 2 + 1] = __sinf(ang);
    }
  }
}

__device__ __forceinline__ void phase1(const Params& p) {
  const int tid = otid(), lane = tid & 63, w = tid >> 6;
  const float* mod = (const float*)(p.ws + OFF_MOD);
  u16* hb = (u16*)(p.ws + OFF_H);
  float4 nw[4];
#pragma unroll
  for (int i = 0; i < 4; ++i) nw[i] = *(const float4*)(p.norm_pre_w + (i * 64 + lane) * 4);
  const int rstep = gridDim.x * 8;
#pragma unroll 1
  for (int row0 = blockIdx.x * 8 + w; row0 < NTOK; row0 += 2 * rstep) {
    float4 v[2][4], sh[2][4], sc[2][4];
    int rows[2];
#pragma unroll
    for (int j = 0; j < 2; ++j) {
      const int row = row0 + j * rstep;
      rows[j] = row;
      if (row < NTOK) {
        const float* xr = (row < NPR) ? p.x_prompt + (size_t)row * DM : p.x_sample + (size_t)(row - NPR) * DM;
        const int mr = (row < NPR) ? 0 : 1 + ((row - NPR) >> 10);
#pragma unroll
        for (int i = 0; i < 4; ++i) {
          const int k = (i * 64 + lane) * 4;
          { const f32x4n t_ = __builtin_nontemporal_load((const f32x4n*)(xr + k)); v[j][i] = make_float4(t_[0], t_[1], t_[2], t_[3]); }
          sh[j][i] = *(const float4*)(mod + mr * 3072 + k);
          sc[j][i] = *(const float4*)(mod + mr * 3072 + 1024 + k);
        }
      }
    }
#pragma unroll
    for (int j = 0; j < 2; ++j) {
      if (rows[j] < NTOK) {
        float ss = 0.f;
#pragma unroll
        for (int i = 0; i < 4; ++i) ss += v[j][i].x * v[j][i].x + v[j][i].y * v[j][i].y + v[j][i].z * v[j][i].z + v[j][i].w * v[j][i].w;
#pragma unroll
        for (int m = 32; m >= 1; m >>= 1) ss += __shfl_xor(ss, m);
        const float rstd = rsqrtf(ss * (1.f / 1024.f) + 1e-6f);
#pragma unroll
        for (int i = 0; i < 4; ++i) {
          const int k = (i * 64 + lane) * 4;
          const float h0 = v[j][i].x * rstd * nw[i].x * (1.f + sc[j][i].x) + sh[j][i].x;
          const float h1 = v[j][i].y * rstd * nw[i].y * (1.f + sc[j][i].y) + sh[j][i].y;
          const float h2 = v[j][i].z * rstd * nw[i].z * (1.f + sc[j][i].z) + sh[j][i].z;
          const float h3 = v[j][i].w * rstd * nw[i].w * (1.f + sc[j][i].w) + sh[j][i].w;
          *(uint2*)(hb + (size_t)rows[j] * DM + k) = make_uint2(pack2(h0, h1), pack2(h2, h3));
        }
      }
    }
  }
}

template <int MODE, int MT>
__device__ __forceinline__ void gemm_tile(const Params& p, const u16* __restrict__ A, const u16* __restrict__ B, const int K, const int mt,
                          const int nt, char* smem, u32x4 (&ra0)[MT], u32x4 (&rb0)[4], const bool have0, const bool has_next,
                          const int mt_next, const int nt_next) {
  constexpr int LDT = 72;
  constexpr int STAGE = 2 * 256 * LDT;
  u16* sm = (u16*)smem;
  int tid_ = threadIdx.x;
  asm volatile("" : "+v"(tid_));
  const int tid = tid_, lane = tid & 63, w = tid >> 6, wm = w >> 2, wn = w & 3, l31 = lane & 31, h = lane >> 5;
  constexpr int AROWS = 64 * MT;
  f32x16 acc[MT][2];
#pragma unroll
  for (int mi = 0; mi < MT; ++mi)
#pragma unroll
    for (int ni = 0; ni < 2; ++ni)
#pragma unroll
      for (int r = 0; r < 16; ++r) acc[mi][ni][r] = 0.f;
  const int srow = tid >> 3, sc8 = tid & 7;
  const u16* Ag = A + (size_t)(mt * AROWS + srow) * K + sc8 * 8;
  const u16* Bg = B + (size_t)(nt * 256 + srow) * K + sc8 * 8;
  const int nk = K / 64;
#define GLOAD(RA, RB, KT)                                                                                   \
  do {                                                                                                      \
    _Pragma("unroll") for (int i = 0; i < MT; ++i) RA[i] = *(const u32x4*)(Ag + (size_t)(i * 64) * K + (KT) * 64); \
    _Pragma("unroll") for (int i = 0; i < 4; ++i) RB[i] = *(const u32x4*)(Bg + (size_t)(i * 64) * K + (KT) * 64);  \
  } while (0)
#define SSTORE(RA, RB, ST)                                                                                  \
  do {                                                                                                      \
    u16* Ad = sm + (ST) * STAGE;                                                                            \
    _Pragma("unroll") for (int i = 0; i < MT; ++i) *(u32x4*)(Ad + (srow + i * 64) * LDT + sc8 * 8) = RA[i]; \
    _Pragma("unroll") for (int i = 0; i < 4; ++i) *(u32x4*)(Ad + 256 * LDT + (srow + i * 64) * LDT + sc8 * 8) = RB[i]; \
  } while (0)
#define LDFRAG(AF, BF, KS)                                                                                  \
  do {                                                                                                      \
    _Pragma("unroll") for (int mi = 0; mi < MT; ++mi) AF[mi] = *(const bf16x8*)(Abase + mi * 32 * LDT + (KS) * 16); \
    _Pragma("unroll") for (int ni = 0; ni < 2; ++ni) BF[ni] = *(const bf16x8*)(Bbase + ni * 32 * LDT + (KS) * 16);  \
  } while (0)
#define MMA(AF, BF)                                                                                         \
  do {                                                                                                      \
    _Pragma("unroll") for (int mi = 0; mi < MT; ++mi)                                                       \
    _Pragma("unroll") for (int ni = 0; ni < 2; ++ni) acc[mi][ni] = MFMA32(BF[ni], AF[mi], acc[mi][ni]);     \
  } while (0)
  auto compute = [&](const int st, const int kt) {
    const u16* Abase = sm + st * STAGE + (wm * (MT * 32) + l31) * LDT + h * 8;
    const u16* Bbase = sm + st * STAGE + 256 * LDT + (wn * 64 + l31) * LDT + h * 8;
    bf16x8 af0[MT], bf0[2], af1[MT], bf1[2];
    LDFRAG(af0, bf0, 0);
    __builtin_amdgcn_sched_barrier(0);
    LDFRAG(af1, bf1, 1);
    __builtin_amdgcn_sched_barrier(0);
    MMA(af0, bf0);
    __builtin_amdgcn_sched_barrier(0);
    LDFRAG(af0, bf0, 2);
    __builtin_amdgcn_sched_barrier(0);
    if (kt + 1 < nk) SSTORE(ra0, rb0, st ^ 1);
    __builtin_amdgcn_sched_barrier(0);
    MMA(af1, bf1);
    __builtin_amdgcn_sched_barrier(0);
    if (kt + 2 < nk) GLOAD(ra0, rb0, kt + 2);
    __builtin_amdgcn_sched_barrier(0);
    LDFRAG(af1, bf1, 3);
    __builtin_amdgcn_sched_barrier(0);
    MMA(af0, bf0);
    __builtin_amdgcn_sched_barrier(0);
    MMA(af1, bf1);
  };
  auto rowscale = [&]() {
    const float* ssq = (const float*)(p.ws + OFF_SSQ);
#pragma unroll
    for (int mi = 0; mi < MT; ++mi) {
      const int m = mt * AROWS + wm * (MT * 32) + mi * 32 + l31;
      float s = 0.f;
#pragma unroll
      for (int q = 0; q < 4; ++q) {
        float4 t = *(const float4*)(ssq + (size_t)m * 16 + q * 4);
        s += t.x + t.y + t.z + t.w;
      }
      const float rs = rsqrtf(s * (1.f / 1024.f) + 1e-6f);
#pragma unroll
      for (int ni = 0; ni < 2; ++ni)
#pragma unroll
        for (int r = 0; r < 16; ++r) acc[mi][ni][r] *= rs;
    }
  };
  if (!have0) GLOAD(ra0, rb0, 0);
  SSTORE(ra0, rb0, 0);
  GLOAD(ra0, rb0, 1);
  __syncthreads();
#pragma unroll 1
  for (int kt = 0; kt < nk; ++kt) {
    compute(kt & 1, kt);
    if (MODE == 1 && kt == 15) rowscale();
    __syncthreads();
  }
  if (has_next) {
    const u16* Ag2 = A + (size_t)(mt_next * AROWS + srow) * K + sc8 * 8;
    const u16* Bg2 = B + (size_t)(nt_next * 256 + srow) * K + sc8 * 8;
#pragma unroll
    for (int i = 0; i < MT; ++i) ra0[i] = *(const u32x4*)(Ag2 + (size_t)(i * 64) * K);
#pragma unroll
    for (int i = 0; i < 4; ++i) rb0[i] = *(const u32x4*)(Bg2 + (size_t)(i * 64) * K);
  }
#undef GLOAD
#undef SSTORE
#undef LDFRAG
#undef MMA
  if (MODE == 0) {
    if (nt < 24) {
      u16* u = (u16*)(p.ws + OFF_U);
      u16* cst = sm + w * (128 * 72);
#pragma unroll
      for (int mi = 0; mi < MT; ++mi) {
        const int m = mt * AROWS + wm * (MT * 32) + mi * 32 + l31;
#pragma unroll
        for (int ni = 0; ni < 2; ++ni)
#pragma unroll
          for (int g = 0; g < 4; ++g) {
            const int n = nt * 256 + wn * 64 + ni * 32 + 8 * g + 4 * h;
            const uint2 pk =
                make_uint2(pack2(acc[mi][ni][4 * g], acc[mi][ni][4 * g + 1]), pack2(acc[mi][ni][4 * g + 2], acc[mi][ni][4 * g + 3]));
            *(uint2*)(cst + (mi * 32 + l31) * 72 + ni * 32 + 8 * g + 4 * h) = pk;
            if (MT == 4 && nt >= 4 && nt < 12 && ((mi == 0 && l31 == 0) || (mi == 3 && l31 == 31)))
              *(uint2*)((u16*)(p.ws + OFF_HALO) + ((size_t)(m >> 7) * 2 + (mi == 3 ? 1 : 0)) * 2048 + (n - 1024)) = pk;
          }
      }
      {
        const int rr = lane >> 3, c8 = lane & 7;
        u16* ug = u + (size_t)(mt * AROWS + wm * (MT * 32) + rr) * UC + nt * 256 + wn * 64 + c8 * 8;
#pragma unroll
        for (int i = 0; i < MT * 4; ++i) {
          const u32x4 v = *(const u32x4*)(cst + (i * 8 + rr) * 72 + c8 * 8);
          *(u32x4*)(ug + (size_t)(i * 8) * UC) = v;
        }
      }
      __syncthreads();
    } else if (wn == 0) {
      float* dt = (float*)(p.ws + OFF_DT);
#pragma unroll
      for (int mi = 0; mi < MT; ++mi) {
        const int m = mt * AROWS + wm * (MT * 32) + mi * 32 + l31;
#pragma unroll
        for (int g = 0; g < 4; ++g)
          *(float4*)(dt + (size_t)m * 32 + 8 * g + 4 * h) =
              make_float4(acc[mi][0][4 * g], acc[mi][0][4 * g + 1], acc[mi][0][4 * g + 2], acc[mi][0][4 * g + 3]);
      }
    }
  } else {
    float* ob = (float*)(p.ws + OFF_OUTB);
    float* ssq2 = (float*)(p.ws + OFF_SSQ2);
    float* cst = (float*)smem + w * (MT * 32 * 36);
    float ssum[MT];
#pragma unroll
    for (int mi = 0; mi < MT; ++mi) ssum[mi] = 0.f;
#pragma unroll
    for (int ni = 0; ni < 2; ++ni) {
#pragma unroll
      for (int mi = 0; mi < MT; ++mi)
#pragma unroll
        for (int g = 0; g < 4; ++g) {
          const float4 v = make_float4(acc[mi][ni][4 * g], acc[mi][ni][4 * g + 1], acc[mi][ni][4 * g + 2], acc[mi][ni][4 * g + 3]);
          ssum[mi] += v.x * v.x + v.y * v.y + v.z * v.z + v.w * v.w;
          *(float4*)(cst + (mi * 32 + l31) * 36 + 8 * g + 4 * h) = v;
        }
      const int rr = lane >> 3, c4 = lane & 7;
      float* og = ob + (size_t)(mt * AROWS + wm * (MT * 32) + rr) * DM + nt * 256 + wn * 64 + ni * 32 + c4 * 4;
#pragma unroll
      for (int i = 0; i < MT * 4; ++i) {
        const float4 v = *(const float4*)(cst + (i * 8 + rr) * 36 + c4 * 4);
        *(float4*)(og + (size_t)(i * 8) * DM) = v;
      }
    }
#pragma unroll
    for (int mi = 0; mi < MT; ++mi) {
      const int m = mt * AROWS + wm * (MT * 32) + mi * 32 + l31;
      float s = ssum[mi];
      s += __shfl_xor(s, 32);
      if (h == 0) ssq2[(size_t)m * 16 + nt * 4 + wn] = s;
    }
    __syncthreads();
  }
}

__device__ __forceinline__ void phase_conv(const Params& p) {
  const int tid = otid();
  const int c8 = tid & 15, rg = tid >> 4;
  u16* u = (u16*)(p.ws + OFF_U);
  const u16* halo = (const u16*)(p.ws + OFF_HALO);
#pragma unroll 1
  for (int id = blockIdx.x; id < 96 * 16; id += gridDim.x) {
    const int c = id >> 4, strip = id & 15;
    const bool first = (c < 32) ? ((c & 1) == 0) : (((c - 32) & 7) == 0);
    const bool last = (c < 32) ? ((c & 1) == 1) : (((c - 32) & 7) == 7);
    const int ch = strip * 128 + c8 * 8;
    u16* up = u + (size_t)(c * 128 + rg * 4) * UC + 1024 + ch;
    u32x4 r[6];
    const u32x4 z4 = {0u, 0u, 0u, 0u};
#pragma unroll
    for (int i = 1; i < 5; ++i) r[i] = *(const u32x4*)(up + (ptrdiff_t)(i - 1) * UC);
    if (rg > 0) r[0] = *(const u32x4*)(up - UC);
    else r[0] = first ? z4 : *(const u32x4*)(halo + ((size_t)(c - 1) * 2 + 1) * 2048 + ch);
    if (rg < 31) r[5] = *(const u32x4*)(up + 4 * UC);
    else r[5] = last ? z4 : *(const u32x4*)(halo + ((size_t)(c + 1) * 2) * 2048 + ch);
    float w0[8], w1[8], w2[8], bs[8];
#pragma unroll
    for (int e = 0; e < 8; e += 4) {
      const float4 a = *(const float4*)(p.conv_w + ch + e), b = *(const float4*)(p.conv_w + 2048 + ch + e),
                   cc = *(const float4*)(p.conv_w + 4096 + ch + e), d = *(const float4*)(p.conv_b + ch + e);
      w0[e] = a.x; w0[e + 1] = a.y; w0[e + 2] = a.z; w0[e + 3] = a.w;
      w1[e] = b.x; w1[e + 1] = b.y; w1[e + 2] = b.z; w1[e + 3] = b.w;
      w2[e] = cc.x; w2[e + 1] = cc.y; w2[e + 2] = cc.z; w2[e + 3] = cc.w;
      bs[e] = d.x; bs[e + 1] = d.y; bs[e + 2] = d.z; bs[e + 3] = d.w;
    }
    u32x4 o[4];
#pragma unroll
    for (int i = 0; i < 4; ++i) {
      const unsigned pu[4] = {r[i][0], r[i][1], r[i][2], r[i][3]}, cu[4] = {r[i + 1][0], r[i + 1][1], r[i + 1][2], r[i + 1][3]},
                     nu[4] = {r[i + 2][0], r[i + 2][1], r[i + 2][2], r[i + 2][3]};
      unsigned ov[4];
#pragma unroll
      for (int e2 = 0; e2 < 4; ++e2) {
        const float v0 = w0[2 * e2] * lo_bf(pu[e2]) + w1[2 * e2] * lo_bf(cu[e2]) + w2[2 * e2] * lo_bf(nu[e2]) + bs[2 * e2];
        const float v1 = w0[2 * e2 + 1] * hi_bf(pu[e2]) + w1[2 * e2 + 1] * hi_bf(cu[e2]) + w2[2 * e2 + 1] * hi_bf(nu[e2]) + bs[2 * e2 + 1];
        ov[e2] = pack2(silu_f(v0), silu_f(v1));
      }
      o[i] = u32x4{ov[0], ov[1], ov[2], ov[3]};
    }
    __syncthreads();
#pragma unroll
    for (int i = 0; i < 4; ++i) *(u32x4*)(up + (ptrdiff_t)i * UC) = o[i];
  }
}

constexpr int SC_ARR = 143360;
constexpr int SC_ITEM = SC_ARR + 5632;
constexpr int SC_CW = SC_ARR + 6144;

template <int W>
DI void issue_rows(const u16* __restrict__ u, u32x4* r, const int ucol, const int tok0) {
  constexpr int PC = W / 8, RS = THREADS / PC, NI = 128 / RS;
  const int tid = otid();
  const int c8 = tid % PC, r0 = tid / PC;
  const u16* base = u + (size_t)(tok0 + r0) * UC + ucol + c8 * 8;
#pragma unroll
  for (int i = 0; i < NI; ++i) r[i] = *(const u32x4*)(base + (size_t)i * (RS * UC));
}
template <int W, bool WITHV, bool WITHW>
DI void finish_rows(const u32x4* r, u16* dst, u16* dstw, const int ld, const float* wgt) {
  constexpr int PC = W / 8, RS = THREADS / PC, NI = 128 / RS;
  const int tid = otid();
  const int c8 = tid % PC, r0 = tid / PC;
#pragma unroll
  for (int i = 0; i < NI; ++i) {
    const int row = r0 + RS * i;
    if (WITHV) *(u32x4*)(dst + row * ld + c8 * 8) = r[i];
    if (WITHW) {
      const float wg = wgt[row];
      const unsigned xu[4] = {r[i][0], r[i][1], r[i][2], r[i][3]};
      unsigned o[4];
#pragma unroll
      for (int e = 0; e < 4; ++e) o[e] = pack2(lo_bf(xu[e]) * wg, hi_bf(xu[e]) * wg);
      *(uint4*)(dstw + row * ld + c8 * 8) = make_uint4(o[0], o[1], o[2], o[3]);
    }
  }
}
DI void issue_qk(const u16* __restrict__ u, u32x4* r, const int ucol, const int tok0) {
  const int tid = otid();
  const int row = tid >> 2, pp = tid & 3;
  const int pa = (pp & 1) + (pp >> 1) * 4;
  const u16* up = u + (size_t)(tok0 + row) * UC + ucol;
  r[0] = *(const u32x4*)(up + pa * 8);
  r[1] = *(const u32x4*)(up + pa * 8 + 16);
}
DI void finish_qk(const u32x4* r, const float4* tb, u16* dst, const int ld, const bool rope, const float scale) {
  const int tid = otid();
  const int row = tid >> 2, pp = tid & 3;
  const int pa = (pp & 1) + (pp >> 1) * 4, pb = pa + 2;
  const unsigned au[4] = {r[0][0], r[0][1], r[0][2], r[0][3]}, bu[4] = {r[1][0], r[1][1], r[1][2], r[1][3]};
  const float tf[16] = {tb[0].x, tb[0].y, tb[0].z, tb[0].w, tb[1].x, tb[1].y, tb[1].z, tb[1].w,
                        tb[2].x, tb[2].y, tb[2].z, tb[2].w, tb[3].x, tb[3].y, tb[3].z, tb[3].w};
  float o1[8], o2[8];
#pragma unroll
  for (int e = 0; e < 8; ++e) {
    const float x1 = (e & 1) ? hi_bf(au[e >> 1]) : lo_bf(au[e >> 1]);
    const float x2 = (e & 1) ? hi_bf(bu[e >> 1]) : lo_bf(bu[e >> 1]);
    const float cs = rope ? tf[2 * e] : 1.f, sn = rope ? tf[2 * e + 1] : 0.f;
    o1[e] = (x1 * cs - x2 * sn) * scale;
    o2[e] = (x2 * cs + x1 * sn) * scale;
  }
  *(uint4*)(dst + row * ld + pa * 8) = make_uint4(pack2(o1[0], o1[1]), pack2(o1[2], o1[3]), pack2(o1[4], o1[5]), pack2(o1[6], o1[7]));
  *(uint4*)(dst + row * ld + pb * 8) = make_uint4(pack2(o2[0], o2[1]), pack2(o2[2], o2[3]), pack2(o2[4], o2[5]), pack2(o2[6], o2[7]));
}
template <int N, int P, bool SSD>
__device__ __forceinline__ void scan_item(const Params& p, char* smem, const int stream, const int b, const int hd, const int unit0, int* qctr, int* s_item) {
  constexpr int LQ = N + 8, LV = P + 8;
  constexpr int PT = P / 64, NKS = N / 16, NT = N / 32;
  constexpr int NQ = SSD ? 4 : 2;
  u16* Qs = (u16*)smem;
  u16* Ks = Qs + 128 * LQ;
  u16* Vs = Ks + 128 * LQ;
  u16* Vw = Vs + 128 * LV;
  u16* SfT = Vw + 128 * LV;
  u16* SbT = SfT + P * LQ;
  float* dtf = (float*)(smem + SC_ARR);
  float* dtb = dtf + 128;
  float* cumf = dtb + 128;
  float* cumb = cumf + 128;
  float* ecf = cumb + 128;
  float* ecb = ecf + 128;
  float* wgt = ecb + 128;
  float* fct = (float*)(smem + SC_CW);

  int tid_ = threadIdx.x;
  asm volatile("" : "+v"(tid_));
  const int tid = tid_, lane = tid & 63, w = __builtin_amdgcn_readfirstlane(tid >> 6), l31 = lane & 31, h = lane >> 5;
  const int strip = w & 3, half = w >> 2;
  const int ntile = w % NT, ptile = w / NT;
  const int q4 = (lane & 15) >> 2, p4 = lane & 3, blk = (lane >> 4) & 1;
  const int L = stream ? 1024 : 256, nc = L / 128;
  const int seqbase = stream ? NPR + b * 1024 : b * 256;
  char* wsb = p.ws;
  asm volatile("" : "+s"(wsb));
  const u16* u = (const u16*)(wsb + OFF_U);
  const float* dtraw = (const float*)(wsb + OFF_DT);
  u16* mix = (u16*)(wsb + OFF_MIX);
  float* ssq = (float*)(wsb + OFF_SSQ);
  uint2* dump = (uint2*)(wsb + OFF_DUMP);
  const float4* ropetab = (const float4*)(wsb + OFF_ROPE);

  float Dh = 0.f, lamf = 0.f, lamb = 0.f, bias_d = 0.f, A_d = 0.f;
  const int grp = hd >> 2;
  if (SSD) {
    Dh = p.ssd_D[hd];
    const int d = w & 1;
    bias_d = p.dt_bias[d * 16 + hd];
    A_d = expf(p.A_log[d * 16 + hd]);
  } else {
    lamf = -expf(p.ret_decay[hd]);
    lamb = -expf(p.ret_decay[8 + hd]);
  }

  u32x4 rq[NQ], rk[NQ], rx[4];
  uint2 rdump[4];
  float4 rt[4];
  float rd0 = 0.f, rd1 = 0.f;

  auto issue_loads = [&](const int c, const int sweep) {
    const int tok0 = seqbase + c * 128, t0 = c * 128;
    if (sweep) {
      const uint2* dp = dump + ((size_t)(unit0 + c) * 8 + w) * 256;
#pragma unroll
      for (int g = 0; g < 4; ++g) rdump[g] = dp[g * 64 + lane];
    }
    if (SSD) {
      if (sweep) issue_rows<128>(u, rq, 2560 + grp * 128, tok0);
      issue_rows<128>(u, rk, 2048 + grp * 128, tok0);
      issue_rows<64>(u, rx, 1024 + hd * 64, tok0);
      if (w < 2) {
        const int ol = otid() & 63;
        const int sj0 = (w & 1) ? 127 - 2 * ol : 2 * ol, sj1 = (w & 1) ? 126 - 2 * ol : 2 * ol + 1;
        rd0 = dtraw[(size_t)(tok0 + sj0) * 32 + w * 16 + hd];
        rd1 = dtraw[(size_t)(tok0 + sj1) * 32 + w * 16 + hd];
      }
    } else {
      if (sweep) issue_qk(u, rq, 3072 + hd * 64, tok0);
      issue_qk(u, rk, 3584 + hd * 64, tok0);
      issue_rows<128>(u, rx, 4096 + hd * 128, tok0);
      if (stream) {
        const int ot = otid();
        const int row = ot >> 2, pp = ot & 3;
        const float4* tp = ropetab + ((size_t)(t0 + row) * 32 + (pp >> 1) * 16 + (pp & 1) * 8) / 2;
#pragma unroll
        for (int i = 0; i < 4; ++i) rt[i] = tp[i];
      }
    }
  };

  auto finish_loads = [&](const int c, const int sweep) {
    if (SSD) {
      if (w < 2) {
        const int ol = otid() & 63;
        const int sj0 = (w & 1) ? 127 - 2 * ol : 2 * ol, sj1 = (w & 1) ? 126 - 2 * ol : 2 * ol + 1;
        const float raw0 = rd0 + bias_d, raw1 = rd1 + bias_d;
        const float dt0 = fmaxf(raw0, 0.f) + __logf(1.f + __expf(-fabsf(raw0)));
        const float dt1 = fmaxf(raw1, 0.f) + __logf(1.f + __expf(-fabsf(raw1)));
        const float la0 = -dt0 * A_d, la1 = -dt1 * A_d;
        float s = la0 + la1;
#pragma unroll
        for (int d = 1; d < 64; d <<= 1) {
          const float t = __shfl_up(s, d);
          if (lane >= d) s += t;
        }
        const float tot = __shfl(s, 63);
        const float c1 = s, c0 = s - la1;
        float* dta = w ? dtb : dtf;
        float* cua = w ? cumb : cumf;
        float* eca = w ? ecb : ecf;
        dta[sj0] = dt0; dta[sj1] = dt1;
        cua[sj0] = c0; cua[sj1] = c1;
        eca[sj0] = __expf(c0); eca[sj1] = __expf(c1);
        if (w == sweep) {
          wgt[sj0] = dt0 * __expf(tot - c0);
          wgt[sj1] = dt1 * __expf(tot - c1);
        }
      }
    } else {
      if (tid < 128) {
        const float cf = (float)(tid + 1) * lamf, cb = (float)(128 - tid) * lamb;
        dtf[tid] = 1.f; dtb[tid] = 1.f;
        cumf[tid] = cf; cumb[tid] = cb;
        ecf[tid] = __expf(cf); ecb[tid] = __expf(cb);
        wgt[tid] = sweep ? __expf((float)tid * lamb) : __expf((float)(127 - tid) * lamf);
      }
    }
    __syncthreads();
    if (sweep) {
      const int ot = otid();
      const int s = ot >> 7, j = ot & 127;
      float val = 0.f;
      if (j < s * 32) val = dtf[j] * __expf(cumf[s * 32 - 1] - cumf[j]);
      else if (j >= s * 32 + 32) val = dtb[j] * __expf(cumb[s * 32 + 32] - cumb[j]);
      fct[ot] = val;
    }
    if (SSD) {
      if (sweep) finish_rows<128, true, false>(rq, Qs, nullptr, LQ, nullptr);
      finish_rows<128, true, false>(rk, Ks, nullptr, LQ, nullptr);
      if (sweep) finish_rows<64, true, true>(rx, Vs, Vw, LV, wgt);
      else finish_rows<64, false, true>(rx, Vs, Vw, LV, wgt);
    } else {
      if (sweep) finish_qk(rq, rt, Qs, LQ, stream != 0, 1.f);
      finish_qk(rk, rt, Ks, LQ, stream != 0, 0.125f);
      if (sweep) finish_rows<128, true, true>(rx, Vs, Vw, LV, wgt);
      else finish_rows<128, false, true>(rx, Vs, Vw, LV, wgt);
    }
    if (sweep) {
#pragma unroll
      for (int g = 0; g < 4; ++g) *(uint2*)(SfT + (ptile * 32 + l31) * LQ + ntile * 32 + 8 * g + 4 * h) = rdump[g];
    }
    __syncthreads();
  };

  auto state_update = [&](f32x16& S, const float dec) {
#pragma unroll
    for (int r = 0; r < 16; ++r) S[r] *= dec;
    const u16* ka0 = Ks + (8 * h + q4) * LQ + ntile * 32 + 16 * blk + 4 * p4;
    const u16* vb0 = Vw + (8 * h + q4) * LV + ptile * 32 + 16 * blk + 4 * p4;
    s16x4 ta[8][2], tb[8][2];
#pragma unroll
    for (int ks = 0; ks < 8; ++ks) {
      ta[ks][0] = tr_read(ka0 + ks * 16 * LQ);
      ta[ks][1] = tr_read(ka0 + ks * 16 * LQ + 4 * LQ);
      tb[ks][0] = tr_read(vb0 + ks * 16 * LV);
      tb[ks][1] = tr_read(vb0 + ks * 16 * LV + 4 * LV);
    }
    __builtin_amdgcn_sched_barrier(0);
#pragma unroll
    for (int ks = 0; ks < 8; ++ks) S = MFMA32(cat8(ta[ks][0], ta[ks][1]), cat8(tb[ks][0], tb[ks][1]), S);
    __builtin_amdgcn_sched_barrier(0);
  };

  auto load_state = [&](f32x16& S, const int dir) {
    if (stream) {
      const float* sp = SSD ? p.state_ssd + ((size_t)((b * 2 + dir) * 16 + hd)) * 128 * 64
                            : p.state_ret + ((size_t)((b * 2 + dir) * 8 + hd)) * 64 * 128;
#pragma unroll
      for (int r = 0; r < 16; ++r) S[r] = sp[(ntile * 32 + crow(r, h)) * P + ptile * 32 + l31];
    } else {
#pragma unroll
      for (int r = 0; r < 16; ++r) S[r] = 0.f;
    }
  };
  auto store_state = [&](const f32x16& S, const int dir) {
    if (!stream) {
      float* op = SSD ? p.out + (size_t)NTOK * DM + ((size_t)((b * 2 + dir) * 16 + hd)) * 128 * 64
                      : p.out + (size_t)NTOK * DM + (size_t)16 * 2 * 16 * 128 * 64 + ((size_t)((b * 2 + dir) * 8 + hd)) * 64 * 128;
#pragma unroll
      for (int r = 0; r < 16; ++r) op[(ntile * 32 + crow(r, h)) * P + ptile * 32 + l31] = S[r];
    }
  };

  f32x16 S;
  issue_loads(0, 0);
  load_state(S, 0);
#pragma unroll 1
  for (int c = 0; c < nc; ++c) {
    finish_loads(c, 0);
    {
      uint2* dp = dump + ((size_t)(unit0 + c) * 8 + w) * 256;
#pragma unroll
      for (int g = 0; g < 4; ++g) dp[g * 64 + lane] = make_uint2(pack2(S[4 * g], S[4 * g + 1]), pack2(S[4 * g + 2], S[4 * g + 3]));
    }
    if (c + 1 < nc) issue_loads(c + 1, 0);
    else {
      issue_loads(nc - 1, 1);
#pragma unroll
      for (int g = 0; g < 4; ++g) rdump[g] = make_uint2(pack2(S[4 * g], S[4 * g + 1]), pack2(S[4 * g + 2], S[4 * g + 3]));
    }
    state_update(S, __expf(cumf[127]));
    __syncthreads();
  }
  store_state(S, 0);

  load_state(S, 1);
#pragma unroll
  for (int g = 0; g < 4; ++g)
    *(uint2*)(SbT + (ptile * 32 + l31) * LQ + ntile * 32 + 8 * g + 4 * h) =
        make_uint2(pack2(S[4 * g], S[4 * g + 1]), pack2(S[4 * g + 2], S[4 * g + 3]));
  int nextq = 0;
#pragma unroll 1
  for (int c = nc - 1; c >= 0; --c) {
    const int tok0 = seqbase + c * 128;
    finish_loads(c, 1);
    if (c == 0 && threadIdx.x == 0) nextq = atomicAdd(qctr, 1);
    if (c > 0) issue_loads(c - 1, 1);

    const u16* qrow = Qs + (strip * 32 + l31) * LQ + h * 8;
    constexpr bool SJ = SSD;
    constexpr int YT = SJ ? 2 : PT;
    f32x16 Y[YT];
    if constexpr (SJ) {
      const u16* Sx = half ? SbT : SfT;
      const float* ex = half ? ecb : ecf;
#pragma unroll
      for (int pt = 0; pt < 2; ++pt) {
        const int prow = pt * 32 + l31;
        bf16x8 fq[NKS], fs[NKS];
#pragma unroll
        for (int ks = 0; ks < NKS; ++ks) {
          fq[ks] = *(const bf16x8*)(qrow + ks * 16);
          fs[ks] = *(const bf16x8*)(Sx + prow * LQ + ks * 16 + h * 8);
        }
        __builtin_amdgcn_sched_barrier(0);
        f32x16 a1;
#pragma unroll
        for (int r = 0; r < 16; ++r) a1[r] = 0.f;
#pragma unroll
        for (int ks = 0; ks < NKS; ++ks) a1 = MFMA32(fq[ks], fs[ks], a1);
        __builtin_amdgcn_sched_barrier(0);
#pragma unroll
        for (int g = 0; g < 4; ++g) {
          const float4 ef = *(const float4*)(ex + strip * 32 + 8 * g + 4 * h);
          Y[pt][4 * g + 0] = ef.x * a1[4 * g + 0];
          Y[pt][4 * g + 1] = ef.y * a1[4 * g + 1];
          Y[pt][4 * g + 2] = ef.z * a1[4 * g + 2];
          Y[pt][4 * g + 3] = ef.w * a1[4 * g + 3];
        }
      }
    } else {
#pragma unroll
    for (int pt = 0; pt < PT; ++pt) {
      const int prow = (half * PT + pt) * 32 + l31;
      bf16x8 fq[NKS], fs[NKS];
      {
#pragma unroll
        for (int ks = 0; ks < NKS; ++ks) {
          fq[ks] = *(const bf16x8*)(qrow + ks * 16);
          fs[ks] = *(const bf16x8*)(SfT + prow * LQ + ks * 16 + h * 8);
        }
        __builtin_amdgcn_sched_barrier(0);
        f32x16 a1;
#pragma unroll
        for (int r = 0; r < 16; ++r) a1[r] = 0.f;
#pragma unroll
        for (int ks = 0; ks < NKS; ++ks) a1 = MFMA32(fq[ks], fs[ks], a1);
        __builtin_amdgcn_sched_barrier(0);
#pragma unroll
        for (int ks = 0; ks < NKS; ++ks) fs[ks] = *(const bf16x8*)(SbT + prow * LQ + ks * 16 + h * 8);
#pragma unroll
        for (int g = 0; g < 4; ++g) {
          const float4 ef = *(const float4*)(ecf + strip * 32 + 8 * g + 4 * h);
          Y[pt][4 * g + 0] = ef.x * a1[4 * g + 0];
          Y[pt][4 * g + 1] = ef.y * a1[4 * g + 1];
          Y[pt][4 * g + 2] = ef.z * a1[4 * g + 2];
          Y[pt][4 * g + 3] = ef.w * a1[4 * g + 3];
        }
      }
      {
        __builtin_amdgcn_sched_barrier(0);
        f32x16 a2;
#pragma unroll
        for (int r = 0; r < 16; ++r) a2[r] = 0.f;
#pragma unroll
        for (int ks = 0; ks < NKS; ++ks) a2 = MFMA32(fq[ks], fs[ks], a2);
        __builtin_amdgcn_sched_barrier(0);
#pragma unroll
        for (int g = 0; g < 4; ++g) {
          const float4 eb = *(const float4*)(ecb + strip * 32 + 8 * g + 4 * h);
          Y[pt][4 * g + 0] += eb.x * a2[4 * g + 0];
          Y[pt][4 * g + 1] += eb.y * a2[4 * g + 1];
          Y[pt][4 * g + 2] += eb.z * a2[4 * g + 2];
          Y[pt][4 * g + 3] += eb.w * a2[4 * g + 3];
        }
      }
    }
    }
    const int ii = strip * 32 + l31;
    const float cfi = cumf[ii], cbi = cumb[ii];

#pragma unroll 1
    for (int jj = 0; jj < (SJ ? 2 : 4); ++jj) {
      const int jt = SJ ? half * 2 + jj : jj;
      f32x16 G;
#pragma unroll
      for (int r = 0; r < 16; ++r) G[r] = 0.f;
      s16x4 tv[YT][4];
      {
        bf16x8 fk[NKS], fq[NKS];
#pragma unroll
        for (int ks = 0; ks < NKS; ++ks) {
          fk[ks] = *(const bf16x8*)(Ks + (jt * 32 + l31) * LQ + ks * 16 + h * 8);
          fq[ks] = *(const bf16x8*)(qrow + ks * 16);
        }
        __builtin_amdgcn_sched_barrier(0);
#pragma unroll
        for (int ks = 0; ks < NKS; ++ks) G = MFMA32(fk[ks], fq[ks], G);
        __builtin_amdgcn_sched_barrier(0);
#pragma unroll
        for (int pt = 0; pt < YT; ++pt) {
          const u16* vp = Vs + (jt * 32 + 4 * h + q4) * LV + (SJ ? pt : half * PT + pt) * 32 + 16 * blk + 4 * p4;
          tv[pt][0] = tr_read(vp);
          tv[pt][1] = tr_read(vp + 8 * LV);
          tv[pt][2] = tr_read(vp + 16 * LV);
          tv[pt][3] = tr_read(vp + 24 * LV);
        }
        __builtin_amdgcn_sched_barrier(0);
      }
      if (jt == strip) {
#pragma unroll
        for (int g = 0; g < 4; ++g) {
          const int jb = jt * 32 + 8 * g + 4 * h;
          const float4 cf4 = *(const float4*)(cumf + jb), cb4 = *(const float4*)(cumb + jb);
          const float4 df4 = *(const float4*)(dtf + jb), db4 = *(const float4*)(dtb + jb);
          const float cfa[4] = {cf4.x, cf4.y, cf4.z, cf4.w}, cba[4] = {cb4.x, cb4.y, cb4.z, cb4.w};
          const float dfa[4] = {df4.x, df4.y, df4.z, df4.w}, dba[4] = {db4.x, db4.y, db4.z, db4.w};
#pragma unroll
          for (int e = 0; e < 4; ++e) {
            const int j = jb + e;
            const float tf = __expf(cfi - cfa[e]) * dfa[e];
            const float tb = __expf(cbi - cba[e]) * dba[e];
            const float m = ((ii >= j) ? tf : 0.f) + ((ii <= j) ? tb : 0.f);
            float pv = G[4 * g + e] * m;
            if (SSD && ii == j) pv += Dh;
            G[4 * g + e] = pv;
          }
        }
      } else {
        const float ei = (jt < strip) ? __expf(cfi - cumf[strip * 32 - 1]) : __expf(cbi - cumb[strip * 32 + 32]);
#pragma unroll
        for (int g = 0; g < 4; ++g) {
          const float4 f4 = *(const float4*)(fct + strip * 128 + jt * 32 + 8 * g + 4 * h);
          G[4 * g + 0] *= ei * f4.x;
          G[4 * g + 1] *= ei * f4.y;
          G[4 * g + 2] *= ei * f4.z;
          G[4 * g + 3] *= ei * f4.w;
        }
      }
      const bf16x8 pf0 = pack8(G[0], G[1], G[2], G[3], G[4], G[5], G[6], G[7]);
      const bf16x8 pf1 = pack8(G[8], G[9], G[10], G[11], G[12], G[13], G[14], G[15]);
#pragma unroll
      for (int pt = 0; pt < YT; ++pt) {
        Y[pt] = MFMA32(pf0, cat8(tv[pt][0], tv[pt][1]), Y[pt]);
        Y[pt] = MFMA32(pf1, cat8(tv[pt][2], tv[pt][3]), Y[pt]);
      }
    }
    state_update(S, __expf(cumb[0]));
    constexpr int CPR = P / 8, NIT = 128 * CPR / THREADS;
    const int ec8 = tid % CPR, er0 = tid / CPR;
    const int ecol = SSD ? hd * 64 + ec8 * 8 : hd * 128 + ec8 * 8;
    uint4 gz[NIT];
#pragma unroll
    for (int i = 0; i < NIT; ++i)
      gz[i] = *(const uint4*)(u + (size_t)(tok0 + er0 + i * (THREADS / CPR)) * UC + (SSD ? 0 : 5120) + ecol);
    const float* nwp = SSD ? p.ssd_norm_w + ecol : p.ret_norm_w + ecol;
    const float4 n0 = *(const float4*)nwp, n1 = *(const float4*)(nwp + 4);
    const float nw[8] = {n0.x, n0.y, n0.z, n0.w, n1.x, n1.y, n1.z, n1.w};
    __syncthreads();
#pragma unroll
    for (int g = 0; g < 4; ++g)
      *(uint2*)(SbT + (ptile * 32 + l31) * LQ + ntile * 32 + 8 * g + 4 * h) =
          make_uint2(pack2(S[4 * g], S[4 * g + 1]), pack2(S[4 * g + 2], S[4 * g + 3]));
    constexpr int LY = P + 4;
    float* Yst = (float*)smem;
#pragma unroll
    for (int pt = 0; pt < YT; ++pt)
#pragma unroll
      for (int r = 0; r < 16; ++r)
        Yst[(SJ ? half * (128 * LY) : 0) + (strip * 32 + crow(r, h)) * LY + (SJ ? pt : half * PT + pt) * 32 + l31] = Y[pt][r];
    __syncthreads();
#pragma unroll
    for (int i = 0; i < NIT; ++i) {
      const int row = er0 + i * (THREADS / CPR);
      const float* yp = Yst + row * LY + ec8 * 8;
      const float4 y0 = *(const float4*)yp, y1 = *(const float4*)(yp + 4);
      float v[8] = {y0.x, y0.y, y0.z, y0.w, y1.x, y1.y, y1.z, y1.w};
      if constexpr (SJ) {
        const float4 z0 = *(const float4*)(yp + 128 * LY), z1 = *(const float4*)(yp + 128 * LY + 4);
        v[0] += z0.x; v[1] += z0.y; v[2] += z0.z; v[3] += z0.w;
        v[4] += z1.x; v[5] += z1.y; v[6] += z1.z; v[7] += z1.w;
      }
      const size_t tok = (size_t)(tok0 + row);
      const unsigned zu[4] = {gz[i].x, gz[i].y, gz[i].z, gz[i].w};
      if (SSD) {
        float sq = 0.f;
#pragma unroll
        for (int e = 0; e < 8; ++e) {
          const float z = (e & 1) ? hi_bf(zu[e >> 1]) : lo_bf(zu[e >> 1]);
          v[e] *= silu_f(z);
          sq += v[e] * v[e];
        }
        sq += __shfl_xor(sq, 1);
        sq += __shfl_xor(sq, 2);
        sq += __shfl_xor(sq, 4);
        if (ec8 == 0) ssq[tok * 16 + hd] = sq;
        *(uint4*)(mix + tok * 2048 + ecol) = make_uint4(pack2(v[0] * nw[0], v[1] * nw[1]), pack2(v[2] * nw[2], v[3] * nw[3]),
                                                        pack2(v[4] * nw[4], v[5] * nw[5]), pack2(v[6] * nw[6], v[7] * nw[7]));
      } else {
        float s = 0.f;
#pragma unroll
        for (int e = 0; e < 8; ++e) s += v[e];
        s += __shfl_xor(s, 1);
        s += __shfl_xor(s, 2);
        s += __shfl_xor(s, 4);
        s += __shfl_xor(s, 8);
        const float mean = s * (1.f / 128.f);
        float s2 = 0.f;
#pragma unroll
        for (int e = 0; e < 8; ++e) {
          v[e] -= mean;
          s2 += v[e] * v[e];
        }
        s2 += __shfl_xor(s2, 1);
        s2 += __shfl_xor(s2, 2);
        s2 += __shfl_xor(s2, 4);
        s2 += __shfl_xor(s2, 8);
        const float rstd = rsqrtf(s2 * (1.f / 128.f) + 1e-6f);
#pragma unroll
        for (int e = 0; e < 8; ++e) {
          const float gv = (e & 1) ? hi_bf(zu[e >> 1]) : lo_bf(zu[e >> 1]);
          v[e] = v[e] * rstd * nw[e] * silu_f(gv);
        }
        *(uint4*)(mix + tok * 2048 + 1024 + ecol) =
            make_uint4(pack2(v[0], v[1]), pack2(v[2], v[3]), pack2(v[4], v[5]), pack2(v[6], v[7]));
      }
    }
  }
  store_state(S, 1);
  if (threadIdx.x == 0) *s_item = nextq;
}

__device__ __forceinline__ void phase3(const Params& p, char* smem, const int ctr_idx) {
  int* s_item = (int*)(smem + SC_ITEM);
  int* ctr = (int*)(p.ws + OFF_CTR) + ctr_idx;
  if (threadIdx.x == 0) *s_item = atomicAdd(ctr, 1);
  __syncthreads();
#pragma unroll 1
  for (;;) {
    const int q = *s_item;
    __syncthreads();
    if (q >= 576) break;
    int kind, stream, bb, hd, unit0;
    if (q < 128) { kind = 0; stream = 1; bb = q >> 4; hd = q & 15; unit0 = q * 8; }
    else if (q < 192) { kind = 1; stream = 1; bb = (q - 128) >> 3; hd = (q - 128) & 7; unit0 = 1024 + (q - 128) * 8; }
    else if (q < 448) { kind = 0; stream = 0; bb = (q - 192) >> 4; hd = (q - 192) & 15; unit0 = 1536 + (q - 192) * 2; }
    else { kind = 1; stream = 0; bb = (q - 448) >> 3; hd = (q - 448) & 7; unit0 = 2048 + (q - 448) * 2; }
    if (kind == 0) scan_item<128, 64, true>(p, smem, stream, bb, hd, unit0, ctr, s_item);
    else scan_item<64, 128, false>(p, smem, stream, bb, hd, unit0, ctr, s_item);
    __syncthreads();
  }
}

__device__ __forceinline__ void phase5(const Params& p) {
  const int tid = otid(), lane = tid & 63, w = tid >> 6;
  const float* mod = (const float*)(p.ws + OFF_MOD);
  const float* ob = (const float*)(p.ws + OFF_OUTB);
  const float* ssq2 = (const float*)(p.ws + OFF_SSQ2);
  for (int row = blockIdx.x * 8 + w; row < NTOK; row += gridDim.x * 8) {
    const float* xr = (row < NPR) ? p.x_prompt + (size_t)row * DM : p.x_sample + (size_t)(row - NPR) * DM;
    const int mr = (row < NPR) ? 0 : 1 + ((row - NPR) >> 10);
    float s = (lane < 16) ? ssq2[(size_t)row * 16 + lane] : 0.f;
#pragma unroll
    for (int m = 8; m >= 1; m >>= 1) s += __shfl_xor(s, m);
    s = __shfl(s, 0);
    const float rstd = rsqrtf(s * (1.f / 1024.f) + 1e-6f);
#pragma unroll
    for (int i = 0; i < 4; ++i) {
      const int k = (i * 64 + lane) * 4;
      const float4 xv = *(const float4*)(xr + k);
      const float4 ov = *(const float4*)(ob + (size_t)row * DM + k);
      const float4 nw = *(const float4*)(p.norm_post_w + k);
      const float4 gt = *(const float4*)(mod + mr * 3072 + 2048 + k);
      float4 y;
      y.x = xv.x + gt.x * ov.x * rstd * nw.x;
      y.y = xv.y + gt.y * ov.y * rstd * nw.y;
      y.z = xv.z + gt.z * ov.z * rstd * nw.z;
      y.w = xv.w + gt.w * ov.w * rstd * nw.w;
      *(float4*)(p.out + (size_t)row * DM + k) = y;
    }
  }
}

__global__ void __launch_bounds__(THREADS) fwd_megakernel(Params p) {
  extern __shared__ __attribute__((aligned(16))) char smem[];
  cg::grid_group grid = cg::this_grid();
  const int G = gridDim.x;
  const int bx = blockIdx.x;
  const int rb = (G % 8 == 0) ? (bx % 8) * (G / 8) + bx / 8 : bx;

  unsigned* gbar = (unsigned*)(p.ws + OFF_CTR + 1024);
  unsigned epoch = 0u;
  volatile LAS unsigned* xst = (volatile LAS unsigned*)(smem + 153984);
  if (threadIdx.x == 0) { xst[0] = 0u; xst[1] = 0u; xst[2] = 0u; xst[3] = 0u; }
  __syncthreads();
  const XcdBarrier xb = xcd_barrier_post((unsigned*)(p.ws + OFF_CTR + 8192), xst);
  if (p.ws == nullptr) grid.sync();
  phase0(p, smem);
  xcd_barrier(xb);
#if PROBE == 5
  phase0(p, smem);
  xcd_barrier(xb);
#endif
#if PROBE == 4
  for (int i = 0; i < 10; ++i) xcd_barrier(xb);
#endif
  phase1(p);
  xcd_barrier(xb);
#if PROBE == 6
  phase1(p);
  xcd_barrier(xb);
#endif
  {
    u32x4 sra[4], srb[4];
    bool have0 = false;
    for (int id = rb; id < 48 * 25; id += G) {
      const int band = id / 200, rem = id % 200;
      const int id2 = id + G;
      const bool has2 = id2 < 48 * 25;
      const int band2 = id2 / 200, rem2 = id2 % 200;
      gemm_tile<0, 4>(p, (const u16*)(p.ws + OFF_H), (const u16*)(p.ws + OFF_WTIN), 1024, band * 8 + (rem & 7), rem >> 3, smem, sra, srb,
                      have0, has2, band2 * 8 + (rem2 & 7), rem2 >> 3);
      have0 = has2;
    }
  }
  {
    const int nfull = (48 * 25) % G;
    const int nhelp = (nfull > 0) ? G - nfull : G;
    const int hb = (nfull > 0) ? rb - nfull : rb;
    if (hb >= 0)
      for (int q = hb; q < 512; q += nhelp)
        p0_transpose_item(p.w_out, 1024, (u16*)(p.ws + OFF_WTOUT), 2048, q / 16, q % 16, 1024, false, smem);
  }
  xcd_barrier(xb);
#if PROBE == 1
  for (int id = rb; id < 48 * 25; id += G) {
    const int band = id / 200, rem = id % 200;
    u32x4 sra[4], srb[4];
    gemm_tile<0, 4>(p, (const u16*)(p.ws + OFF_H), (const u16*)(p.ws + OFF_WTIN), 1024, band * 8 + (rem & 7), rem >> 3, smem, sra, srb, false, false, 0, 0);
  }
  xcd_barrier(xb);
#endif
  phase_conv(p);
  xcd_barrier(xb);
  phase3(p, smem, 0);
#if PROBE == 2
  phase3(p, smem, 1);
#endif
  xcd_barrier(xb);
#if PROBE == 3
  for (int id = rb; id < 64 * 4; id += G)
  {
    u32x4 sra[3], srb[4];
    gemm_tile<1, 3>(p, (const u16*)(p.ws + OFF_MIX), (const u16*)(p.ws + OFF_WTOUT), 2048, id >> 2, id & 3, smem, sra, srb, false, false, 0, 0);
  }
  xcd_barrier(xb);
#endif
  for (int id = rb; id < 64 * 4; id += G)
  {
    u32x4 sra[3], srb[4];
    gemm_tile<1, 3>(p, (const u16*)(p.ws + OFF_MIX), (const u16*)(p.ws + OFF_WTOUT), 2048, id >> 2, id & 3, smem, sra, srb, false, false, 0, 0);
  }
  xcd_barrier(xb);
  phase5(p);
#if PROBE == 7
  phase5(p);
#endif
}

extern "C" void kernel_launch(void* const* d_in, const int* in_sizes, int n_in, void* d_out, int out_size, void* d_ws,
                              size_t ws_size, hipStream_t stream) {
  static int grid_blocks = 0;
  if (!grid_blocks) {
    int dev = 0, cus = 0, per_cu = 0;
    hipGetDevice(&dev);
    hipDeviceGetAttribute(&cus, hipDeviceAttributeMultiprocessorCount, dev);
    hipFuncSetAttribute((const void*)fwd_megakernel, hipFuncAttributeMaxDynamicSharedMemorySize, SMEM_BYTES);
    hipOccupancyMaxActiveBlocksPerMultiprocessor(&per_cu, fwd_megakernel, THREADS, SMEM_BYTES);
    if (per_cu < 1) per_cu = 1;
    grid_blocks = cus * per_cu;
  }
  Params p{};
  const float* const* in = (const float* const*)d_in;
  p.x_prompt = in[0]; p.x_sample = in[1]; p.state_ssd = in[2]; p.state_ret = in[3]; p.c = in[4]; p.c_ctx = in[5];
  p.w_mod = in[6]; p.b_mod = in[7]; p.norm_pre_w = in[8]; p.norm_post_w = in[9]; p.w_in = in[10]; p.conv_w = in[11];
  p.conv_b = in[12]; p.A_log = in[13]; p.dt_bias = in[14]; p.ssd_D = in[15]; p.ssd_norm_w = in[16]; p.ret_decay = in[17];
  p.ret_norm_w = in[18]; p.w_out = in[19];
  p.out = (float*)d_out;
  p.ws = (char*)d_ws;
  hipMemsetAsync((char*)d_ws + OFF_CTR, 0, 8192 + 16384, stream);
  void* args[] = {&p};
  hipError_t e = hipLaunchCooperativeKernel((void*)fwd_megakernel, dim3(grid_blocks), dim3(THREADS), args, SMEM_BYTES, stream);
  if (e != hipSuccess) fprintf(stderr, "cooperative launch failed: %s (grid %d)\n", hipGetErrorString(e), grid_blocks);
}
```

```cpp
#include <hip/hip_runtime.h>
#include <hip/hip_cooperative_groups.h>
#include <cstdio>
namespace cg = cooperative_groups;

typedef unsigned short u16;
typedef __bf16 bf16v2 __attribute__((ext_vector_type(2)));
typedef float f32v2 __attribute__((ext_vector_type(2)));
typedef short s16x4 __attribute__((ext_vector_type(4)));
using bf16x8 = __attribute__((ext_vector_type(8))) short;
using f32x16 = __attribute__((ext_vector_type(16))) float;
using f32x4n = __attribute__((ext_vector_type(4))) float;
using u32x4 = __attribute__((ext_vector_type(4))) unsigned;
#define DI __device__ __forceinline__
#define MFMA32(a, b, c) __builtin_amdgcn_mfma_f32_32x32x16_bf16((a), (b), (c), 0, 0, 0)

constexpr int NTOK = 12288;
constexpr int NPR = 4096;
constexpr int DM = 1024;
constexpr int INC = 6176;
constexpr int UC = 6144;
#ifndef PROBE
#define PROBE 0
#endif
constexpr int THREADS = 512;
constexpr int SMEM_BYTES = 152 * 1024;

constexpr size_t OFF_MOD = 0;
constexpr size_t OFF_ROPE = 131072;
constexpr size_t OFF_CTR = 393216;
constexpr size_t OFF_H = 524288;
constexpr size_t OFF_WTIN = OFF_H + 25165824;
constexpr size_t OFF_DUMP = OFF_H;
constexpr size_t OFF_WTOUT = OFF_WTIN + 13107200;
constexpr size_t OFF_U = OFF_WTOUT + 4194304;
constexpr size_t OFF_OUTB = OFF_U;
constexpr size_t OFF_DT = OFF_U + 150994944;
constexpr size_t OFF_MIX = OFF_DT + 1572864;
constexpr size_t OFF_SSQ = OFF_MIX + 50331648;
constexpr size_t OFF_SSQ2 = OFF_SSQ + 1572864;
constexpr size_t OFF_HALO = OFF_SSQ2 + 786432;

struct Params {
  const float *x_prompt, *x_sample, *state_ssd, *state_ret, *c, *c_ctx, *w_mod, *b_mod, *norm_pre_w, *norm_post_w,
      *w_in, *conv_w, *conv_b, *A_log, *dt_bias, *ssd_D, *ssd_norm_w, *ret_decay, *ret_norm_w, *w_out;
  float* out;
  char* ws;
};

DI float bf2f(u16 v) { return __uint_as_float(((unsigned)v) << 16); }
DI unsigned pack2(float a, float b) {
  f32v2 f = {a, b};
  bf16v2 r = __builtin_convertvector(f, bf16v2);
  return __builtin_bit_cast(unsigned, r);
}
DI u16 f2bf(float a) { return (u16)(pack2(a, 0.f) & 0xffffu); }
DI float lo_bf(unsigned v) { return __uint_as_float(v << 16); }
DI float hi_bf(unsigned v) { return __uint_as_float(v & 0xffff0000u); }
DI float silu_f(float v) { return v * __builtin_amdgcn_rcpf(1.f + __expf(-v)); }
DI int crow(int r, int h) { return (r & 3) + 8 * (r >> 2) + 4 * h; }
DI int otid() {
  int t = threadIdx.x;
  asm volatile("" : "+v"(t));
  return t;
}
DI s16x4 tr_read(const u16* p) {
  return __builtin_amdgcn_ds_read_tr16_b64_v4i16((s16x4 __attribute__((address_space(3)))*)(p));
}
DI bf16x8 cat8(s16x4 lo, s16x4 hi) { return __builtin_shufflevector(lo, hi, 0, 1, 2, 3, 4, 5, 6, 7); }
DI bf16x8 pack8(float a0, float a1, float a2, float a3, float a4, float a5, float a6, float a7) {
  uint4 v = make_uint4(pack2(a0, a1), pack2(a2, a3), pack2(a4, a5), pack2(a6, a7));
  return __builtin_bit_cast(bf16x8, v);
}


DI void grid_barrier(unsigned* bar, unsigned& epoch) {
  asm volatile("s_waitcnt vmcnt(0)" ::: "memory");
  __syncthreads();
  if (threadIdx.x == 0) {
    __builtin_amdgcn_fence(__ATOMIC_RELEASE, "agent");
    asm volatile("s_waitcnt vmcnt(0)" ::: "memory");
    const unsigned G = gridDim.x;
    const unsigned ng = (G % 8u == 0u) ? 8u : 1u;
    const unsigned gs = G / ng, g = blockIdx.x % ng, e1 = epoch + 1u;
    const unsigned old = __hip_atomic_fetch_add(&bar[64u * (1u + g)], 1u, __ATOMIC_RELAXED, __HIP_MEMORY_SCOPE_AGENT);
    if (old + 1u == gs * e1) {
      const unsigned o2 = __hip_atomic_fetch_add(&bar[0], 1u, __ATOMIC_RELAXED, __HIP_MEMORY_SCOPE_AGENT);
      if (o2 + 1u == ng * e1) __hip_atomic_fetch_add(&bar[64u * 16u], 1u, __ATOMIC_RELAXED, __HIP_MEMORY_SCOPE_AGENT);
    }
    while (__hip_atomic_load(&bar[64u * 16u], __ATOMIC_RELAXED, __HIP_MEMORY_SCOPE_AGENT) < e1) __builtin_amdgcn_s_sleep(1);
    __builtin_amdgcn_fence(__ATOMIC_ACQUIRE, "agent");
    asm volatile("s_waitcnt vmcnt(0)" ::: "memory");
  }
  __syncthreads();
  ++epoch;
}


#define XB_TMO      128
#define XB_XCNT(j)  (256  + 64 * (j))
#define XB_XSUB(j)  (1280 + 64 * (j))
#define XB_XGEN(j)  (2304 + 64 * (j))
#define XB_TOP      3328
#define XB_TOPGEN   3392
#define XB_SPIN_CAP (1u << 22)
#define LAS __attribute__((address_space(3)))
DI unsigned xb_ld(unsigned* p) { return __hip_atomic_load(p, __ATOMIC_RELAXED, __HIP_MEMORY_SCOPE_AGENT); }
DI unsigned xb_add(unsigned* p, unsigned v) { return __hip_atomic_fetch_add(p, v, __ATOMIC_RELAXED, __HIP_MEMORY_SCOPE_AGENT); }
DI unsigned xb_xcc_id() { return (unsigned)__builtin_amdgcn_s_getreg((3 << 11) | 20) & 0xFu; }
#define XB_SPIN(cond, bar) do { unsigned _sp = 0; while (cond) { __builtin_amdgcn_s_sleep(1); \
    if ((++_sp & 255u) == 0u) { if (xb_ld(&(bar)[XB_TMO])) break; if (_sp > XB_SPIN_CAP) { atomicAdd(&(bar)[XB_TMO], 1u); break; } } } } while (0)
struct XcdBarrier { unsigned* bar; unsigned x; volatile LAS unsigned* st; };
DI XcdBarrier xcd_barrier_post(unsigned* bar, volatile LAS unsigned* st) {
  XcdBarrier b; b.bar = bar; b.x = xb_xcc_id(); b.st = st;
  if (threadIdx.x == 0) (void)xb_add(&bar[XB_XCNT(b.x)], 1u);
  return b;
}
DI void xcd_barrier_complete(unsigned* bar, unsigned x, unsigned& nloc, unsigned& nx) {
  const unsigned G = gridDim.x;
  unsigned sum, cnt, mine, sp = 0u;
  for (;;) {
    sum = 0u; cnt = 0u; mine = 0u;
#pragma unroll
    for (unsigned j = 0; j < 16; ++j) { const unsigned c = xb_ld(&bar[XB_XCNT(j)]); sum += c; cnt += (c > 0u) ? 1u : 0u; mine = (j == x) ? c : mine; }
    if (sum == G) break;
    __builtin_amdgcn_s_sleep(1);
    if ((++sp & 255u) == 0u) { if (xb_ld(&bar[XB_TMO])) break; if (sp > XB_SPIN_CAP) { atomicAdd(&bar[XB_TMO], 1u); break; } }
  }
  nloc = mine > 0u ? mine : 1u; nx = cnt > 0u ? cnt : 1u;
}
DI void xcd_barrier(const XcdBarrier& b) {
  asm volatile("s_waitcnt vmcnt(0)" ::: "memory");
  __syncthreads();
  if (threadIdx.x == 0) {
    unsigned* bar = b.bar;
    __builtin_amdgcn_s_waitcnt(0);
    unsigned nloc = b.st[0], nx = b.st[1];
    if (nloc == 0u) { xcd_barrier_complete(bar, b.x, nloc, nx); b.st[0] = nloc; b.st[1] = nx; }
    const unsigned old = xb_add(&bar[XB_XSUB(b.x)], 1u);
    const unsigned gen = old / nloc;
    if (old + 1u == (gen + 1u) * nloc) {
      __builtin_amdgcn_fence(__ATOMIC_RELEASE, "agent");
      asm volatile("s_waitcnt vmcnt(0)" ::: "memory");
      const unsigned og = xb_add(&bar[XB_TOP], 1u);
      const unsigned tg = og / nx;
      if (og + 1u == (tg + 1u) * nx) xb_add(&bar[XB_TOPGEN], 1u);
      else XB_SPIN(xb_ld(&bar[XB_TOPGEN]) == tg, bar);
      __builtin_amdgcn_fence(__ATOMIC_ACQUIRE, "agent");
      xb_add(&bar[XB_XGEN(b.x)], 1u);
      asm volatile("s_waitcnt vmcnt(0)" ::: "memory");
    } else {
      XB_SPIN(xb_ld(&bar[XB_XGEN(b.x)]) == gen, bar);
      __builtin_amdgcn_fence(__ATOMIC_ACQUIRE, "agent");
      asm volatile("s_waitcnt vmcnt(0)" ::: "memory");
    }
  }
  __syncthreads();
}

__device__ __forceinline__ void p0_mod_item(const Params& p, char* smem, int it) {
  float* sc = (float*)smem;
  float* red = sc + 9 * 1024;
  const int tid = threadIdx.x, lane = tid & 63, w = tid >> 6;
  for (int idx = tid; idx < 9 * 1024; idx += THREADS) {
    int r = idx >> 10, k = idx & 1023;
    float v = (r == 0) ? p.c_ctx[k] : p.c[(r - 1) * 1024 + k];
    sc[idx] = v / (1.f + expf(-v));
  }
  __syncthreads();
  const int cg4 = tid & 7, kg = tid >> 3, n0 = it * 32;
  float acc[9][4];
#pragma unroll
  for (int r = 0; r < 9; ++r)
#pragma unroll
    for (int e = 0; e < 4; ++e) acc[r][e] = 0.f;
  float4 wv[16];
#pragma unroll
  for (int i = 0; i < 16; ++i) { const f32x4n t_ = __builtin_nontemporal_load((const f32x4n*)(p.w_mod + (size_t)(kg * 16 + i) * 3072 + n0 + cg4 * 4)); wv[i] = make_float4(t_[0], t_[1], t_[2], t_[3]); }
#pragma unroll
  for (int i = 0; i < 16; ++i) {
#pragma unroll
    for (int r = 0; r < 9; ++r) {
      const float s = sc[r * 1024 + kg * 16 + i];
      acc[r][0] += s * wv[i].x; acc[r][1] += s * wv[i].y; acc[r][2] += s * wv[i].z; acc[r][3] += s * wv[i].w;
    }
  }
#pragma unroll
  for (int r = 0; r < 9; ++r)
#pragma unroll
    for (int e = 0; e < 4; ++e) {
      float v = acc[r][e];
      v += __shfl_xor(v, 8);
      v += __shfl_xor(v, 16);
      v += __shfl_xor(v, 32);
      acc[r][e] = v;
    }
  if (lane < 8) {
#pragma unroll
    for (int r = 0; r < 9; ++r)
#pragma unroll
      for (int e = 0; e < 4; ++e) red[(w * 9 + r) * 32 + lane * 4 + e] = acc[r][e];
  }
  __syncthreads();
  float* mod = (float*)(p.ws + OFF_MOD);
  if (tid < 9 * 32) {
    int r = tid >> 5, c2 = tid & 31;
    float s = p.b_mod[n0 + c2];
#pragma unroll
    for (int g = 0; g < 8; ++g) s += red[(g * 9 + r) * 32 + c2];
    mod[r * 3072 + n0 + c2] = s;
  }
  __syncthreads();
}

__device__ __forceinline__ void p0_transpose_item(const float* __restrict__ src, int lds_src, u16* __restrict__ dst, int ldk, int kt, int nt,
                                  int nvalid, bool permute, char* smem) {
  u16* T = (u16*)smem;
  const int tid = threadIdx.x, cc = tid & 63, kr = tid >> 6;
  const int n = nt * 64 + cc;
  int on = n;
  if (permute) on = (n < 3072) ? n : (n < 6144 ? n + 32 : n - 3072);
#pragma unroll
  for (int i = 0; i < 8; ++i) {
    int kk = kr + i * 8;
    float v = (n < nvalid) ? __builtin_nontemporal_load(src + (size_t)(kt * 64 + kk) * lds_src + on) : 0.f;
    T[cc * 72 + kk] = f2bf(v);
  }
  __syncthreads();
  const int row = tid >> 3, c8 = tid & 7;
  uint4 v = *(const uint4*)(T + row * 72 + c8 * 8);
  *(uint4*)(dst + (size_t)(nt * 64 + row) * ldk + kt * 64 + c8 * 8) = v;
  __syncthreads();
}

__device__ __forceinline__ void phase0(const Params& p, char* smem) {
  const int tid = threadIdx.x;

  constexpr int N_MOD = 96, N_WIN = 1600, N_ROPE = 64;
  for (int it = blockIdx.x; it < N_MOD + N_WIN + N_ROPE; it += gridDim.x) {
    if (it < N_MOD) {
      p0_mod_item(p, smem, it);
    } else if (it < N_MOD + N_WIN) {
      int q = it - N_MOD;
      p0_transpose_item(p.w_in, INC, (u16*)(p.ws + OFF_WTIN), 1024, q / 100, q % 100, INC, true, smem);
    } else {
      int q = it - N_MOD - N_WIN;
      int idx = q * 512 + tid;
      int pos = idx >> 5, m = idx & 31, fm = m & 15;
      float inv = exp2f(-(float)(2 * fm) / 32.f * 13.287712379549449f);
      float coord = (float)((m < 16) ? (pos >> 6) : (pos & 63));
      float ang = coord * inv;
      float* tab = (float*)(p.ws + OFF_ROPE);
      tab[idx * 2] = __cosf(ang);
      tab[idx * 2 + 1] = __sinf(ang);
    }
  }
}

__device__ __forceinline__ void phase1(const Params& p) {
  const int tid = otid(), lane = tid & 63, w = tid >> 6;
  const float* mod = (const float*)(p.ws + OFF_MOD);
  u16* hb = (u16*)(p.ws + OFF_H);
  float4 nw[4];
#pragma unroll
  for (int i = 0; i < 4; ++i) nw[i] = *(const float4*)(p.norm_pre_w + (i * 64 + lane) * 4);
  const int rstep = gridDim.x * 8;
#pragma unroll 1
  for (int row0 = blockIdx.x * 8 + w; row0 < NTOK; row0 += 2 * rstep) {
    float4 v[2][4], sh[2][4], sc[2][4];
    int rows[2];
#pragma unroll
    for (int j = 0; j < 2; ++j) {
      const int row = row0 + j * rstep;
      rows[j] = row;
      if (row < NTOK) {
        const float* xr = (row < NPR) ? p.x_prompt + (size_t)row * DM : p.x_sample + (size_t)(row - NPR) * DM;
        const int mr = (row < NPR) ? 0 : 1 + ((row - NPR) >> 10);
#pragma unroll
        for (int i = 0; i < 4; ++i) {
          const int k = (i * 64 + lane) * 4;
          { const f32x4n t_ = __builtin_nontemporal_load((const f32x4n*)(xr + k)); v[j][i] = make_float4(t_[0], t_[1], t_[2], t_[3]); }
          sh[j][i] = *(const float4*)(mod + mr * 3072 + k);
          sc[j][i] = *(const float4*)(mod + mr * 3072 + 1024 + k);
        }
      }
    }
#pragma unroll
    for (int j = 0; j < 2; ++j) {
      if (rows[j] < NTOK) {
        float ss = 0.f;
#pragma unroll
        for (int i = 0; i < 4; ++i) ss += v[j][i].x * v[j][i].x + v[j][i].y * v[j][i].y + v[j][i].z * v[j][i].z + v[j][i].w * v[j][i].w;
#pragma unroll
        for (int m = 32; m >= 1; m >>= 1) ss += __shfl_xor(ss, m);
        const float rstd = rsqrtf(ss * (1.f / 1024.f) + 1e-6f);
#pragma unroll
        for (int i = 0; i < 4; ++i) {
          const int k = (i * 64 + lane) * 4;
          const float h0 = v[j][i].x * rstd * nw[i].x * (1.f + sc[j][i].x) + sh[j][i].x;
          const float h1 = v[j][i].y * rstd * nw[i].y * (1.f + sc[j][i].y) + sh[j][i].y;
          const float h2 = v[j][i].z * rstd * nw[i].z * (1.f + sc[j][i].z) + sh[j][i].z;
          const float h3 = v[j][i].w * rstd * nw[i].w * (1.f + sc[j][i].w) + sh[j][i].w;
          *(uint2*)(hb + (size_t)rows[j] * DM + k) = make_uint2(pack2(h0, h1), pack2(h2, h3));
        }
      }
    }
  }
}

template <int MODE, int MT>
__device__ __forceinline__ void gemm_tile(const Params& p, const u16* __restrict__ A, const u16* __restrict__ B, const int K, const int mt,
                          const int nt, char* smem, u32x4 (&ra0)[MT], u32x4 (&rb0)[4], const bool have0, const bool has_next,
                          const int mt_next, const int nt_next) {
  constexpr int LDT = 72;
  constexpr int STAGE = 2 * 256 * LDT;
  u16* sm = (u16*)smem;
  int tid_ = threadIdx.x;
  asm volatile("" : "+v"(tid_));
  const int tid = tid_, lane = tid & 63, w = tid >> 6, wm = w >> 2, wn = w & 3, l31 = lane & 31, h = lane >> 5;
  constexpr int AROWS = 64 * MT;
  f32x16 acc[MT][2];
#pragma unroll
  for (int mi = 0; mi < MT; ++mi)
#pragma unroll
    for (int ni = 0; ni < 2; ++ni)
#pragma unroll
      for (int r = 0; r < 16; ++r) acc[mi][ni][r] = 0.f;
  const int srow = tid >> 3, sc8 = tid & 7;
  const u16* Ag = A + (size_t)(mt * AROWS + srow) * K + sc8 * 8;
  const u16* Bg = B + (size_t)(nt * 256 + srow) * K + sc8 * 8;
  const int nk = K / 64;
#define GLOAD(RA, RB, KT)                                                                                   \
  do {                                                                                                      \
    _Pragma("unroll") for (int i = 0; i < MT; ++i) RA[i] = *(const u32x4*)(Ag + (size_t)(i * 64) * K + (KT) * 64); \
    _Pragma("unroll") for (int i = 0; i < 4; ++i) RB[i] = *(const u32x4*)(Bg + (size_t)(i * 64) * K + (KT) * 64);  \
  } while (0)
#define SSTORE(RA, RB, ST)                                                                                  \
  do {                                                                                                      \
    u16* Ad = sm + (ST) * STAGE;                                                                            \
    _Pragma("unroll") for (int i = 0; i < MT; ++i) *(u32x4*)(Ad + (srow + i * 64) * LDT + sc8 * 8) = RA[i]; \
    _Pragma("unroll") for (int i = 0; i < 4; ++i) *(u32x4*)(Ad + 256 * LDT + (srow + i * 64) * LDT + sc8 * 8) = RB[i]; \
  } while (0)
#define LDFRAG(AF, BF, KS)                                                                                  \
  do {                                                                                                      \
    _Pragma("unroll") for (int mi = 0; mi < MT; ++mi) AF[mi] = *(const bf16x8*)(Abase + mi * 32 * LDT + (KS) * 16); \
    _Pragma("unroll") for (int ni = 0; ni < 2; ++ni) BF[ni] = *(const bf16x8*)(Bbase + ni * 32 * LDT + (KS) * 16);  \
  } while (0)
#define MMA(AF, BF)                                                                                         \
  do {                                                                                                      \
    _Pragma("unroll") for (int mi = 0; mi < MT; ++mi)                                                       \
    _Pragma("unroll") for (int ni = 0; ni < 2; ++ni) acc[mi][ni] = MFMA32(BF[ni], AF[mi], acc[mi][ni]);     \
  } while (0)
  auto compute = [&](const int st, const int kt) {
    const u16* Abase = sm + st * STAGE + (wm * (MT * 32) + l31) * LDT + h * 8;
    const u16* Bbase = sm + st * STAGE + 256 * LDT + (wn * 64 + l31) * LDT + h * 8;
    bf16x8 af0[MT], bf0[2], af1[MT], bf1[2];
    LDFRAG(af0, bf0, 0);
    __builtin_amdgcn_sched_barrier(0);
    LDFRAG(af1, bf1, 1);
    __builtin_amdgcn_sched_barrier(0);
    MMA(af0, bf0);
    __builtin_amdgcn_sched_barrier(0);
    LDFRAG(af0, bf0, 2);
    __builtin_amdgcn_sched_barrier(0);
    if (kt + 1 < nk) SSTORE(ra0, rb0, st ^ 1);
    __builtin_amdgcn_sched_barrier(0);
    MMA(af1, bf1);
    __builtin_amdgcn_sched_barrier(0);
    if (kt + 2 < nk) GLOAD(ra0, rb0, kt + 2);
    __builtin_amdgcn_sched_barrier(0);
    LDFRAG(af1, bf1, 3);
    __builtin_amdgcn_sched_barrier(0);
    MMA(af0, bf0);
    __builtin_amdgcn_sched_barrier(0);
    MMA(af1, bf1);
  };
  auto rowscale = [&]() {
    const float* ssq = (const float*)(p.ws + OFF_SSQ);
#pragma unroll
    for (int mi = 0; mi < MT; ++mi) {
      const int m = mt * AROWS + wm * (MT * 32) + mi * 32 + l31;
      float s = 0.f;
#pragma unroll
      for (int q = 0; q < 4; ++q) {
        float4 t = *(const float4*)(ssq + (size_t)m * 16 + q * 4);
        s += t.x + t.y + t.z + t.w;
      }
      const float rs = rsqrtf(s * (1.f / 1024.f) + 1e-6f);
#pragma unroll
      for (int ni = 0; ni < 2; ++ni)
#pragma unroll
        for (int r = 0; r < 16; ++r) acc[mi][ni][r] *= rs;
    }
  };
  if (!have0) GLOAD(ra0, rb0, 0);
  SSTORE(ra0, rb0, 0);
  GLOAD(ra0, rb0, 1);
  __syncthreads();
#pragma unroll 1
  for (int kt = 0; kt < nk; ++kt) {
    compute(kt & 1, kt);
    if (MODE == 1 && kt == 15) rowscale();
    __syncthreads();
  }
  if (has_next) {
    const u16* Ag2 = A + (size_t)(mt_next * AROWS + srow) * K + sc8 * 8;
    const u16* Bg2 = B + (size_t)(nt_next * 256 + srow) * K + sc8 * 8;
#pragma unroll
    for (int i = 0; i < MT; ++i) ra0[i] = *(const u32x4*)(Ag2 + (size_t)(i * 64) * K);
#pragma unroll
    for (int i = 0; i < 4; ++i) rb0[i] = *(const u32x4*)(Bg2 + (size_t)(i * 64) * K);
  }
#undef GLOAD
#undef SSTORE
#undef LDFRAG
#undef MMA
  if (MODE == 0) {
    if (nt < 24) {
      u16* u = (u16*)(p.ws + OFF_U);
      u16* cst = sm + w * (128 * 72);
#pragma unroll
      for (int mi = 0; mi < MT; ++mi) {
        const int m = mt * AROWS + wm * (MT * 32) + mi * 32 + l31;
#pragma unroll
        for (int ni = 0; ni < 2; ++ni)
#pragma unroll
          for (int g = 0; g < 4; ++g) {
            const int n = nt * 256 + wn * 64 + ni * 32 + 8 * g + 4 * h;
            const uint2 pk =
                make_uint2(pack2(acc[mi][ni][4 * g], acc[mi][ni][4 * g + 1]), pack2(acc[mi][ni][4 * g + 2], acc[mi][ni][4 * g + 3]));
            *(uint2*)(cst + (mi * 32 + l31) * 72 + ni * 32 + 8 * g + 4 * h) = pk;
            if (MT == 4 && nt >= 4 && nt < 12 && ((mi == 0 && l31 == 0) || (mi == 3 && l31 == 31)))
              *(uint2*)((u16*)(p.ws + OFF_HALO) + ((size_t)(m >> 7) * 2 + (mi == 3 ? 1 : 0)) * 2048 + (n - 1024)) = pk;
          }
      }
      {
        const int rr = lane >> 3, c8 = lane & 7;
        u16* ug = u + (size_t)(mt * AROWS + wm * (MT * 32) + rr) * UC + nt * 256 + wn * 64 + c8 * 8;
#pragma unroll
        for (int i = 0; i < MT * 4; ++i) {
          const u32x4 v = *(const u32x4*)(cst + (i * 8 + rr) * 72 + c8 * 8);
          *(u32x4*)(ug + (size_t)(i * 8) * UC) = v;
        }
      }
      __syncthreads();
    } else if (wn == 0) {
      float* dt = (float*)(p.ws + OFF_DT);
#pragma unroll
      for (int mi = 0; mi < MT; ++mi) {
        const int m = mt * AROWS + wm * (MT * 32) + mi * 32 + l31;
#pragma unroll
        for (int g = 0; g < 4; ++g)
          *(float4*)(dt + (size_t)m * 32 + 8 * g + 4 * h) =
              make_float4(acc[mi][0][4 * g], acc[mi][0][4 * g + 1], acc[mi][0][4 * g + 2], acc[mi][0][4 * g + 3]);
      }
    }
  } else {
    float* ob = (float*)(p.ws + OFF_OUTB);
    float* ssq2 = (float*)(p.ws + OFF_SSQ2);
    float* cst = (float*)smem + w * (MT * 32 * 36);
    float ssum[MT];
#pragma unroll
    for (int mi = 0; mi < MT; ++mi) ssum[mi] = 0.f;
#pragma unroll
    for (int ni = 0; ni < 2; ++ni) {
#pragma unroll
      for (int mi = 0; mi < MT; ++mi)
#pragma unroll
        for (int g = 0; g < 4; ++g) {
          const float4 v = make_float4(acc[mi][ni][4 * g], acc[mi][ni][4 * g + 1], acc[mi][ni][4 * g + 2], acc[mi][ni][4 * g + 3]);
          ssum[mi] += v.x * v.x + v.y * v.y + v.z * v.z + v.w * v.w;
          *(float4*)(cst + (mi * 32 + l31) * 36 + 8 * g + 4 * h) = v;
        }
      const int rr = lane >> 3, c4 = lane & 7;
      float* og = ob + (size_t)(mt * AROWS + wm * (MT * 32) + rr) * DM + nt * 256 + wn * 64 + ni * 32 + c4 * 4;
#pragma unroll
      for (int i = 0; i < MT * 4; ++i) {
        const float4 v = *(const float4*)(cst + (i * 8 + rr) * 36 + c4 * 4);
        *(float4*)(og + (size_t)(i * 8) * DM) = v;
      }
    }
#pragma unroll
    for (int mi = 0; mi < MT; ++mi) {
      const int m = mt * AROWS + wm * (MT * 32) + mi * 32 + l31;
      float s = ssum[mi];
      s += __shfl_xor(s, 32);
      if (h == 0) ssq2[(size_t)m * 16 + nt * 4 + wn] = s;
    }
    __syncthreads();
  }
}

__device__ __forceinline__ void phase_conv(const Params& p) {
  const int tid = otid();
  const int c8 = tid & 15, rg = tid >> 4;
  u16* u = (u16*)(p.ws + OFF_U);
  const u16* halo = (const u16*)(p.ws + OFF_HALO);
#pragma unroll 1
  for (int id = blockIdx.x; id < 96 * 16; id += gridDim.x) {
    const int c = id >> 4, strip = id & 15;
    const bool first = (c < 32) ? ((c & 1) == 0) : (((c - 32) & 7) == 0);
    const bool last = (c < 32) ? ((c & 1) == 1) : (((c - 32) & 7) == 7);
    const int ch = strip * 128 + c8 * 8;
    u16* up = u + (size_t)(c * 128 + rg * 4) * UC + 1024 + ch;
    u32x4 r[6];
    const u32x4 z4 = {0u, 0u, 0u, 0u};
#pragma unroll
    for (int i = 1; i < 5; ++i) r[i] = *(const u32x4*)(up + (ptrdiff_t)(i - 1) * UC);
    if (rg > 0) r[0] = *(const u32x4*)(up - UC);
    else r[0] = first ? z4 : *(const u32x4*)(halo + ((size_t)(c - 1) * 2 + 1) * 2048 + ch);
    if (rg < 31) r[5] = *(const u32x4*)(up + 4 * UC);
    else r[5] = last ? z4 : *(const u32x4*)(halo + ((size_t)(c + 1) * 2) * 2048 + ch);
    float w0[8], w1[8], w2[8], bs[8];
#pragma unroll
    for (int e = 0; e < 8; e += 4) {
      const float4 a = *(const float4*)(p.conv_w + ch + e), b = *(const float4*)(p.conv_w + 2048 + ch + e),
                   cc = *(const float4*)(p.conv_w + 4096 + ch + e), d = *(const float4*)(p.conv_b + ch + e);
      w0[e] = a.x; w0[e + 1] = a.y; w0[e + 2] = a.z; w0[e + 3] = a.w;
      w1[e] = b.x; w1[e + 1] = b.y; w1[e + 2] = b.z; w1[e + 3] = b.w;
      w2[e] = cc.x; w2[e + 1] = cc.y; w2[e + 2] = cc.z; w2[e + 3] = cc.w;
      bs[e] = d.x; bs[e + 1] = d.y; bs[e + 2] = d.z; bs[e + 3] = d.w;
    }
    u32x4 o[4];
#pragma unroll
    for (int i = 0; i < 4; ++i) {
      const unsigned pu[4] = {r[i][0], r[i][1], r[i][2], r[i][3]}, cu[4] = {r[i + 1][0], r[i + 1][1], r[i + 1][2], r[i + 1][3]},
                     nu[4] = {r[i + 2][0], r[i + 2][1], r[i + 2][2], r[i + 2][3]};
      unsigned ov[4];
#pragma unroll
      for (int e2 = 0; e2 < 4; ++e2) {
        const float v0 = w0[2 * e2] * lo_bf(pu[e2]) + w1[2 * e2] * lo_bf(cu[e2]) + w2[2 * e2] * lo_bf(nu[e2]) + bs[2 * e2];
        const float v1 = w0[2 * e2 + 1] * hi_bf(pu[e2]) + w1[2 * e2 + 1] * hi_bf(cu[e2]) + w2[2 * e2 + 1] * hi_bf(nu[e2]) + bs[2 * e2 + 1];
        ov[e2] = pack2(silu_f(v0), silu_f(v1));
      }
      o[i] = u32x4{ov[0], ov[1], ov[2], ov[3]};
    }
    __syncthreads();
#pragma unroll
    for (int i = 0; i < 4; ++i) *(u32x4*)(up + (ptrdiff_t)i * UC) = o[i];
  }
}

constexpr int SC_ARR = 143360;
constexpr int SC_ITEM = SC_ARR + 5632;
constexpr int SC_CW = SC_ARR + 6144;

template <int W>
DI void issue_rows(const u16* __restrict__ u, u32x4* r, const int ucol, const int tok0) {
  constexpr int PC = W / 8, RS = THREADS / PC, NI = 128 / RS;
  const int tid = otid();
  const int c8 = tid % PC, r0 = tid / PC;
  const u16* base = u + (size_t)(tok0 + r0) * UC + ucol + c8 * 8;
#pragma unroll
  for (int i = 0; i < NI; ++i) r[i] = *(const u32x4*)(base + (size_t)i * (RS * UC));
}
template <int W, bool WITHV, bool WITHW>
DI void finish_rows(const u32x4* r, u16* dst, u16* dstw, const int ld, const float* wgt) {
  constexpr int PC = W / 8, RS = THREADS / PC, NI = 128 / RS;
  const int tid = otid();
  const int c8 = tid % PC, r0 = tid / PC;
#pragma unroll
  for (int i = 0; i < NI; ++i) {
    const int row = r0 + RS * i;
    if (WITHV) *(u32x4*)(dst + row * ld + c8 * 8) = r[i];
    if (WITHW) {
      const float wg = wgt[row];
      const unsigned xu[4] = {r[i][0], r[i][1], r[i][2], r[i][3]};
      unsigned o[4];
#pragma unroll
      for (int e = 0; e < 4; ++e) o[e] = pack2(lo_bf(xu[e]) * wg, hi_bf(xu[e]) * wg);
      *(uint4*)(dstw + row * ld + c8 * 8) = make_uint4(o[0], o[1], o[2], o[3]);
    }
  }
}
DI void issue_qk(const u16* __restrict__ u, u32x4* r, const int ucol, const int tok0) {
  const int tid = otid();
  const int row = tid >> 2, pp = tid & 3;
  const int pa = (pp & 1) + (pp >> 1) * 4;
  const u16* up = u + (size_t)(tok0 + row) * UC + ucol;
  r[0] = *(const u32x4*)(up + pa * 8);
  r[1] = *(const u32x4*)(up + pa * 8 + 16);
}
DI void finish_qk(const u32x4* r, const float4* tb, u16* dst, const int ld, const bool rope, const float scale) {
  const int tid = otid();
  const int row = tid >> 2, pp = tid & 3;
  const int pa = (pp & 1) + (pp >> 1) * 4, pb = pa + 2;
  const unsigned au[4] = {r[0][0], r[0][1], r[0][2], r[0][3]}, bu[4] = {r[1][0], r[1][1], r[1][2], r[1][3]};
  const float tf[16] = {tb[0].x, tb[0].y, tb[0].z, tb[0].w, tb[1].x, tb[1].y, tb[1].z, tb[1].w,
                        tb[2].x, tb[2].y, tb[2].z, tb[2].w, tb[3].x, tb[3].y, tb[3].z, tb[3].w};
  float o1[8], o2[8];
#pragma unroll
  for (int e = 0; e < 8; ++e) {
    const float x1 = (e & 1) ? hi_bf(au[e >> 1]) : lo_bf(au[e >> 1]);
    const float x2 = (e & 1) ? hi_bf(bu[e >> 1]) : lo_bf(bu[e >> 1]);
    const float cs = rope ? tf[2 * e] : 1.f, sn = rope ? tf[2 * e + 1] : 0.f;
    o1[e] = (x1 * cs - x2 * sn) * scale;
    o2[e] = (x2 * cs + x1 * sn) * scale;
  }
  *(uint4*)(dst + row * ld + pa * 8) = make_uint4(pack2(o1[0], o1[1]), pack2(o1[2], o1[3]), pack2(o1[4], o1[5]), pack2(o1[6], o1[7]));
  *(uint4*)(dst + row * ld + pb * 8) = make_uint4(pack2(o2[0], o2[1]), pack2(o2[2], o2[3]), pack2(o2[4], o2[5]), pack2(o2[6], o2[7]));
}
template <int N, int P, bool SSD>
__device__ __forceinline__ void scan_item(const Params& p, char* smem, const int stream, const int b, const int hd, const int unit0, int* qctr, int* s_item) {
  constexpr int LQ = N + 8, LV = P + 8;
  constexpr int PT = P / 64, NKS = N / 16, NT = N / 32;
  constexpr int NQ = SSD ? 4 : 2;
  u16* Qs = (u16*)smem;
  u16* Ks = Qs + 128 * LQ;
  u16* Vs = Ks + 128 * LQ;
  u16* Vw = Vs + 128 * LV;
  u16* SfT = Vw + 128 * LV;
  u16* SbT = SfT + P * LQ;
  float* dtf = (float*)(smem + SC_ARR);
  float* dtb = dtf + 128;
  float* cumf = dtb + 128;
  float* cumb = cumf + 128;
  float* ecf = cumb + 128;
  float* ecb = ecf + 128;
  float* wgt = ecb + 128;
  float* fct = (float*)(smem + SC_CW);

  int tid_ = threadIdx.x;
  asm volatile("" : "+v"(tid_));
  const int tid = tid_, lane = tid & 63, w = __builtin_amdgcn_readfirstlane(tid >> 6), l31 = lane & 31, h = lane >> 5;
  const int strip = w & 3, half = w >> 2;
  const int ntile = w % NT, ptile = w / NT;
  const int q4 = (lane & 15) >> 2, p4 = lane & 3, blk = (lane >> 4) & 1;
  const int L = stream ? 1024 : 256, nc = L / 128;
  const int seqbase = stream ? NPR + b * 1024 : b * 256;
  char* wsb = p.ws;
  asm volatile("" : "+s"(wsb));
  const u16* u = (const u16*)(wsb + OFF_U);
  const float* dtraw = (const float*)(wsb + OFF_DT);
  u16* mix = (u16*)(wsb + OFF_MIX);
  float* ssq = (float*)(wsb + OFF_SSQ);
  uint2* dump = (uint2*)(wsb + OFF_DUMP);
  const float4* ropetab = (const float4*)(wsb + OFF_ROPE);

  float Dh = 0.f, lamf = 0.f, lamb = 0.f, bias_d = 0.f, A_d = 0.f;
  const int grp = hd >> 2;
  if (SSD) {
    Dh = p.ssd_D[hd];
    const int d = w & 1;
    bias_d = p.dt_bias[d * 16 + hd];
    A_d = expf(p.A_log[d * 16 + hd]);
  } else {
    lamf = -expf(p.ret_decay[hd]);
    lamb = -expf(p.ret_decay[8 + hd]);
  }

  u32x4 rq[NQ], rk[NQ], rx[4];
  uint2 rdump[4];
  float4 rt[4];
  float rd0 = 0.f, rd1 = 0.f;

  auto issue_loads = [&](const int c, const int sweep) {
    const int tok0 = seqbase + c * 128, t0 = c * 128;
    if (sweep) {
      const uint2* dp = dump + ((size_t)(unit0 + c) * 8 + w) * 256;
#pragma unroll
      for (int g = 0; g < 4; ++g) rdump[g] = dp[g * 64 + lane];
    }
    if (SSD) {
      if (sweep) issue_rows<128>(u, rq, 2560 + grp * 128, tok0);
      issue_rows<128>(u, rk, 2048 + grp * 128, tok0);
      issue_rows<64>(u, rx, 1024 + hd * 64, tok0);
      if (w < 2) {
        const int ol = otid() & 63;
        const int sj0 = (w & 1) ? 127 - 2 * ol : 2 * ol, sj1 = (w & 1) ? 126 - 2 * ol : 2 * ol + 1;
        rd0 = dtraw[(size_t)(tok0 + sj0) * 32 + w * 16 + hd];
        rd1 = dtraw[(size_t)(tok0 + sj1) * 32 + w * 16 + hd];
      }
    } else {
      if (sweep) issue_qk(u, rq, 3072 + hd * 64, tok0);
      issue_qk(u, rk, 3584 + hd * 64, tok0);
      issue_rows<128>(u, rx, 4096 + hd * 128, tok0);
      if (stream) {
        const int ot = otid();
        const int row = ot >> 2, pp = ot & 3;
        const float4* tp = ropetab + ((size_t)(t0 + row) * 32 + (pp >> 1) * 16 + (pp & 1) * 8) / 2;
#pragma unroll
        for (int i = 0; i < 4; ++i) rt[i] = tp[i];
      }
    }
  };

  auto finish_loads = [&](const int c, const int sweep) {
    if (SSD) {
      if (w < 2) {
        const int ol = otid() & 63;
        const int sj0 = (w & 1) ? 127 - 2 * ol : 2 * ol, sj1 = (w & 1) ? 126 - 2 * ol : 2 * ol + 1;
        const float raw0 = rd0 + bias_d, raw1 = rd1 + bias_d;
        const float dt0 = fmaxf(raw0, 0.f) + __logf(1.f + __expf(-fabsf(raw0)));
        const float dt1 = fmaxf(raw1, 0.f) + __logf(1.f + __expf(-fabsf(raw1)));
        const float la0 = -dt0 * A_d, la1 = -dt1 * A_d;
        float s = la0 + la1;
#pragma unroll
        for (int d = 1; d < 64; d <<= 1) {
          const float t = __shfl_up(s, d);
          if (lane >= d) s += t;
        }
        const float tot = __shfl(s, 63);
        const float c1 = s, c0 = s - la1;
        float* dta = w ? dtb : dtf;
        float* cua = w ? cumb : cumf;
        float* eca = w ? ecb : ecf;
        dta[sj0] = dt0; dta[sj1] = dt1;
        cua[sj0] = c0; cua[sj1] = c1;
        eca[sj0] = __expf(c0); eca[sj1] = __expf(c1);
        if (w == sweep) {
          wgt[sj0] = dt0 * __expf(tot - c0);
          wgt[sj1] = dt1 * __expf(tot - c1);
        }
      }
    } else {
      if (tid < 128) {
        const float cf = (float)(tid + 1) * lamf, cb = (float)(128 - tid) * lamb;
        dtf[tid] = 1.f; dtb[tid] = 1.f;
        cumf[tid] = cf; cumb[tid] = cb;
        ecf[tid] = __expf(cf); ecb[tid] = __expf(cb);
        wgt[tid] = sweep ? __expf((float)tid * lamb) : __expf((float)(127 - tid) * lamf);
      }
    }
    __syncthreads();
    if (sweep) {
      const int ot = otid();
      const int s = ot >> 7, j = ot & 127;
      float val = 0.f;
      if (j < s * 32) val = dtf[j] * __expf(cumf[s * 32 - 1] - cumf[j]);
      else if (j >= s * 32 + 32) val = dtb[j] * __expf(cumb[s * 32 + 32] - cumb[j]);
      fct[ot] = val;
    }
    if (SSD) {
      if (sweep) finish_rows<128, true, false>(rq, Qs, nullptr, LQ, nullptr);
      finish_rows<128, true, false>(rk, Ks, nullptr, LQ, nullptr);
      if (sweep) finish_rows<64, true, true>(rx, Vs, Vw, LV, wgt);
      else finish_rows<64, false, true>(rx, Vs, Vw, LV, wgt);
    } else {
      if (sweep) finish_qk(rq, rt, Qs, LQ, stream != 0, 1.f);
      finish_qk(rk, rt, Ks, LQ, stream != 0, 0.125f);
      if (sweep) finish_rows<128, true, true>(rx, Vs, Vw, LV, wgt);
      else finish_rows<128, false, true>(rx, Vs, Vw, LV, wgt);
    }
    if (sweep) {
#pragma unroll
      for (int g = 0; g < 4; ++g) *(uint2*)(SfT + (ptile * 32 + l31) * LQ + ntile * 32 + 8 * g + 4 * h) = rdump[g];
    }
    __syncthreads();
  };

  auto state_update = [&](f32x16& S, const float dec) {
#pragma unroll
    for (int r = 0; r < 16; ++r) S[r] *= dec;
    const u16* ka0 = Ks + (8 * h + q4) * LQ + ntile * 32 + 16 * blk + 4 * p4;
    const u16* vb0 = Vw + (8 * h + q4) * LV + ptile * 32 + 16 * blk + 4 * p4;
    s16x4 ta[8][2], tb[8][2];
#pragma unroll
    for (int ks = 0; ks < 8; ++ks) {
      ta[ks][0] = tr_read(ka0 + ks * 16 * LQ);
      ta[ks][1] = tr_read(ka0 + ks * 16 * LQ + 4 * LQ);
      tb[ks][0] = tr_read(vb0 + ks * 16 * LV);
      tb[ks][1] = tr_read(vb0 + ks * 16 * LV + 4 * LV);
    }
    __builtin_amdgcn_sched_barrier(0);
#pragma unroll
    for (int ks = 0; ks < 8; ++ks) S = MFMA32(cat8(ta[ks][0], ta[ks][1]), cat8(tb[ks][0], tb[ks][1]), S);
    __builtin_amdgcn_sched_barrier(0);
  };

  auto load_state = [&](f32x16& S, const int dir) {
    if (stream) {
      const float* sp = SSD ? p.state_ssd + ((size_t)((b * 2 + dir) * 16 + hd)) * 128 * 64
                            : p.state_ret + ((size_t)((b * 2 + dir) * 8 + hd)) * 64 * 128;
#pragma unroll
      for (int r = 0; r < 16; ++r) S[r] = __builtin_nontemporal_load(sp + (ntile * 32 + crow(r, h)) * P + ptile * 32 + l31);
    } else {
#pragma unroll
      for (int r = 0; r < 16; ++r) S[r] = 0.f;
    }
  };
  auto store_state = [&](const f32x16& S, const int dir) {
    if (!stream) {
      float* op = SSD ? p.out + (size_t)NTOK * DM + ((size_t)((b * 2 + dir) * 16 + hd)) * 128 * 64
                      : p.out + (size_t)NTOK * DM + (size_t)16 * 2 * 16 * 128 * 64 + ((size_t)((b * 2 + dir) * 8 + hd)) * 64 * 128;
#pragma unroll
      for (int r = 0; r < 16; ++r) __builtin_nontemporal_store(S[r], op + (ntile * 32 + crow(r, h)) * P + ptile * 32 + l31);
    }
  };

  f32x16 S;
  issue_loads(0, 0);
  load_state(S, 0);
#pragma unroll 1
  for (int c = 0; c < nc; ++c) {
    finish_loads(c, 0);
    {
      uint2* dp = dump + ((size_t)(unit0 + c) * 8 + w) * 256;
#pragma unroll
      for (int g = 0; g < 4; ++g) dp[g * 64 + lane] = make_uint2(pack2(S[4 * g], S[4 * g + 1]), pack2(S[4 * g + 2], S[4 * g + 3]));
    }
    if (c + 1 < nc) issue_loads(c + 1, 0);
    else {
      issue_loads(nc - 1, 1);
#pragma unroll
      for (int g = 0; g < 4; ++g) rdump[g] = make_uint2(pack2(S[4 * g], S[4 * g + 1]), pack2(S[4 * g + 2], S[4 * g + 3]));
    }
    state_update(S, __expf(cumf[127]));
    __syncthreads();
  }
  store_state(S, 0);

  load_state(S, 1);
#pragma unroll
  for (int g = 0; g < 4; ++g)
    *(uint2*)(SbT + (ptile * 32 + l31) * LQ + ntile * 32 + 8 * g + 4 * h) =
        make_uint2(pack2(S[4 * g], S[4 * g + 1]), pack2(S[4 * g + 2], S[4 * g + 3]));
  int nextq = 0;
#pragma unroll 1
  for (int c = nc - 1; c >= 0; --c) {
    const int tok0 = seqbase + c * 128;
    finish_loads(c, 1);
    if (c == 0 && threadIdx.x == 0) nextq = atomicAdd(qctr, 1);
    if (c > 0) issue_loads(c - 1, 1);

    const u16* qrow = Qs + (strip * 32 + l31) * LQ + h * 8;
    constexpr bool SJ = SSD;
    constexpr int YT = SJ ? 2 : PT;
    f32x16 Y[YT];
    if constexpr (SJ) {
      const u16* Sx = half ? SbT : SfT;
      const float* ex = half ? ecb : ecf;
#pragma unroll
      for (int pt = 0; pt < 2; ++pt) {
        const int prow = pt * 32 + l31;
        bf16x8 fq[NKS], fs[NKS];
#pragma unroll
        for (int ks = 0; ks < NKS; ++ks) {
          fq[ks] = *(const bf16x8*)(qrow + ks * 16);
          fs[ks] = *(const bf16x8*)(Sx + prow * LQ + ks * 16 + h * 8);
        }
        __builtin_amdgcn_sched_barrier(0);
        f32x16 a1;
#pragma unroll
        for (int r = 0; r < 16; ++r) a1[r] = 0.f;
#pragma unroll
        for (int ks = 0; ks < NKS; ++ks) a1 = MFMA32(fq[ks], fs[ks], a1);
        __builtin_amdgcn_sched_barrier(0);
#pragma unroll
        for (int g = 0; g < 4; ++g) {
          const float4 ef = *(const float4*)(ex + strip * 32 + 8 * g + 4 * h);
          Y[pt][4 * g + 0] = ef.x * a1[4 * g + 0];
          Y[pt][4 * g + 1] = ef.y * a1[4 * g + 1];
          Y[pt][4 * g + 2] = ef.z * a1[4 * g + 2];
          Y[pt][4 * g + 3] = ef.w * a1[4 * g + 3];
        }
      }
    } else {
#pragma unroll
    for (int pt = 0; pt < PT; ++pt) {
      const int prow = (half * PT + pt) * 32 + l31;
      bf16x8 fq[NKS], fs[NKS];
      {
#pragma unroll
        for (int ks = 0; ks < NKS; ++ks) {
          fq[ks] = *(const bf16x8*)(qrow + ks * 16);
          fs[ks] = *(const bf16x8*)(SfT + prow * LQ + ks * 16 + h * 8);
        }
        __builtin_amdgcn_sched_barrier(0);
        f32x16 a1;
#pragma unroll
        for (int r = 0; r < 16; ++r) a1[r] = 0.f;
#pragma unroll
        for (int ks = 0; ks < NKS; ++ks) a1 = MFMA32(fq[ks], fs[ks], a1);
        __builtin_amdgcn_sched_barrier(0);
#pragma unroll
        for (int ks = 0; ks < NKS; ++ks) fs[ks] = *(const bf16x8*)(SbT + prow * LQ + ks * 16 + h * 8);
#pragma unroll
        for (int g = 0; g < 4; ++g) {
          const float4 ef = *(const float4*)(ecf + strip * 32 + 8 * g + 4 * h);
          Y[pt][4 * g + 0] = ef.x * a1[4 * g + 0];
          Y[pt][4 * g + 1] = ef.y * a1[4 * g + 1];
          Y[pt][4 * g + 2] = ef.z * a1[4 * g + 2];
          Y[pt][4 * g + 3] = ef.w * a1[4 * g + 3];
        }
      }
      {
        __builtin_amdgcn_sched_barrier(0);
        f32x16 a2;
#pragma unroll
        for (int r = 0; r < 16; ++r) a2[r] = 0.f;
#pragma unroll
        for (int ks = 0; ks < NKS; ++ks) a2 = MFMA32(fq[ks], fs[ks], a2);
        __builtin_amdgcn_sched_barrier(0);
#pragma unroll
        for (int g = 0; g < 4; ++g) {
          const float4 eb = *(const float4*)(ecb + strip * 32 + 8 * g + 4 * h);
          Y[pt][4 * g + 0] += eb.x * a2[4 * g + 0];
          Y[pt][4 * g + 1] += eb.y * a2[4 * g + 1];
          Y[pt][4 * g + 2] += eb.z * a2[4 * g + 2];
          Y[pt][4 * g + 3] += eb.w * a2[4 * g + 3];
        }
      }
    }
    }
    const int ii = strip * 32 + l31;
    const float cfi = cumf[ii], cbi = cumb[ii];

#pragma unroll 1
    for (int jj = 0; jj < (SJ ? 2 : 4); ++jj) {
      const int jt = SJ ? half * 2 + jj : jj;
      f32x16 G;
#pragma unroll
      for (int r = 0; r < 16; ++r) G[r] = 0.f;
      s16x4 tv[YT][4];
      {
        bf16x8 fk[NKS], fq[NKS];
#pragma unroll
        for (int ks = 0; ks < NKS; ++ks) {
          fk[ks] = *(const bf16x8*)(Ks + (jt * 32 + l31) * LQ + ks * 16 + h * 8);
          fq[ks] = *(const bf16x8*)(qrow + ks * 16);
        }
        __builtin_amdgcn_sched_barrier(0);
#pragma unroll
        for (int ks = 0; ks < NKS; ++ks) G = MFMA32(fk[ks], fq[ks], G);
        __builtin_amdgcn_sched_barrier(0);
#pragma unroll
        for (int pt = 0; pt < YT; ++pt) {
          const u16* vp = Vs + (jt * 32 + 4 * h + q4) * LV + (SJ ? pt : half * PT + pt) * 32 + 16 * blk + 4 * p4;
          tv[pt][0] = tr_read(vp);
          tv[pt][1] = tr_read(vp + 8 * LV);
          tv[pt][2] = tr_read(vp + 16 * LV);
          tv[pt][3] = tr_read(vp + 24 * LV);
        }
        __builtin_amdgcn_sched_barrier(0);
      }
      if (jt == strip) {
#pragma unroll
        for (int g = 0; g < 4; ++g) {
          const int jb = jt * 32 + 8 * g + 4 * h;
          const float4 cf4 = *(const float4*)(cumf + jb), cb4 = *(const float4*)(cumb + jb);
          const float4 df4 = *(const float4*)(dtf + jb), db4 = *(const float4*)(dtb + jb);
          const float cfa[4] = {cf4.x, cf4.y, cf4.z, cf4.w}, cba[4] = {cb4.x, cb4.y, cb4.z, cb4.w};
          const float dfa[4] = {df4.x, df4.y, df4.z, df4.w}, dba[4] = {db4.x, db4.y, db4.z, db4.w};
#pragma unroll
          for (int e = 0; e < 4; ++e) {
            const int j = jb + e;
            const float tf = __expf(cfi - cfa[e]) * dfa[e];
            const float tb = __expf(cbi - cba[e]) * dba[e];
            const float m = ((ii >= j) ? tf : 0.f) + ((ii <= j) ? tb : 0.f);
            float pv = G[4 * g + e] * m;
            if (SSD && ii == j) pv += Dh;
            G[4 * g + e] = pv;
          }
        }
      } else {
        const float ei = (jt < strip) ? __expf(cfi - cumf[strip * 32 - 1]) : __expf(cbi - cumb[strip * 32 + 32]);
#pragma unroll
        for (int g = 0; g < 4; ++g) {
          const float4 f4 = *(const float4*)(fct + strip * 128 + jt * 32 + 8 * g + 4 * h);
          G[4 * g + 0] *= ei * f4.x;
          G[4 * g + 1] *= ei * f4.y;
          G[4 * g + 2] *= ei * f4.z;
          G[4 * g + 3] *= ei * f4.w;
        }
      }
      const bf16x8 pf0 = pack8(G[0], G[1], G[2], G[3], G[4], G[5], G[6], G[7]);
      const bf16x8 pf1 = pack8(G[8], G[9], G[10], G[11], G[12], G[13], G[14], G[15]);
#pragma unroll
      for (int pt = 0; pt < YT; ++pt) {
        Y[pt] = MFMA32(pf0, cat8(tv[pt][0], tv[pt][1]), Y[pt]);
        Y[pt] = MFMA32(pf1, cat8(tv[pt][2], tv[pt][3]), Y[pt]);
      }
    }
    state_update(S, __expf(cumb[0]));
    constexpr int CPR = P / 8, NIT = 128 * CPR / THREADS;
    const int ec8 = tid % CPR, er0 = tid / CPR;
    const int ecol = SSD ? hd * 64 + ec8 * 8 : hd * 128 + ec8 * 8;
    uint4 gz[NIT];
#pragma unroll
    for (int i = 0; i < NIT; ++i)
      gz[i] = *(const uint4*)(u + (size_t)(tok0 + er0 + i * (THREADS / CPR)) * UC + (SSD ? 0 : 5120) + ecol);
    const float* nwp = SSD ? p.ssd_norm_w + ecol : p.ret_norm_w + ecol;
    const float4 n0 = *(const float4*)nwp, n1 = *(const float4*)(nwp + 4);
    const float nw[8] = {n0.x, n0.y, n0.z, n0.w, n1.x, n1.y, n1.z, n1.w};
    __syncthreads();
#pragma unroll
    for (int g = 0; g < 4; ++g)
      *(uint2*)(SbT + (ptile * 32 + l31) * LQ + ntile * 32 + 8 * g + 4 * h) =
          make_uint2(pack2(S[4 * g], S[4 * g + 1]), pack2(S[4 * g + 2], S[4 * g + 3]));
    constexpr int LY = P + 4;
    float* Yst = (float*)smem;
#pragma unroll
    for (int pt = 0; pt < YT; ++pt)
#pragma unroll
      for (int r = 0; r < 16; ++r)
        Yst[(SJ ? half * (128 * LY) : 0) + (strip * 32 + crow(r, h)) * LY + (SJ ? pt : half * PT + pt) * 32 + l31] = Y[pt][r];
    __syncthreads();
#pragma unroll
    for (int i = 0; i < NIT; ++i) {
      const int row = er0 + i * (THREADS / CPR);
      const float* yp = Yst + row * LY + ec8 * 8;
      const float4 y0 = *(const float4*)yp, y1 = *(const float4*)(yp + 4);
      float v[8] = {y0.x, y0.y, y0.z, y0.w, y1.x, y1.y, y1.z, y1.w};
      if constexpr (SJ) {
        const float4 z0 = *(const float4*)(yp + 128 * LY), z1 = *(const float4*)(yp + 128 * LY + 4);
        v[0] += z0.x; v[1] += z0.y; v[2] += z0.z; v[3] += z0.w;
        v[4] += z1.x; v[5] += z1.y; v[6] += z1.z; v[7] += z1.w;
      }
      const size_t tok = (size_t)(tok0 + row);
      const unsigned zu[4] = {gz[i].x, gz[i].y, gz[i].z, gz[i].w};
      if (SSD) {
        float sq = 0.f;
#pragma unroll
        for (int e = 0; e < 8; ++e) {
          const float z = (e & 1) ? hi_bf(zu[e >> 1]) : lo_bf(zu[e >> 1]);
          v[e] *= silu_f(z);
          sq += v[e] * v[e];
        }
        sq += __shfl_xor(sq, 1);
        sq += __shfl_xor(sq, 2);
        sq += __shfl_xor(sq, 4);
        if (ec8 == 0) ssq[tok * 16 + hd] = sq;
        *(uint4*)(mix + tok * 2048 + ecol) = make_uint4(pack2(v[0] * nw[0], v[1] * nw[1]), pack2(v[2] * nw[2], v[3] * nw[3]),
                                                        pack2(v[4] * nw[4], v[5] * nw[5]), pack2(v[6] * nw[6], v[7] * nw[7]));
      } else {
        float s = 0.f;
#pragma unroll
        for (int e = 0; e < 8; ++e) s += v[e];
        s += __shfl_xor(s, 1);
        s += __shfl_xor(s, 2);
        s += __shfl_xor(s, 4);
        s += __shfl_xor(s, 8);
        const float mean = s * (1.f / 128.f);
        float s2 = 0.f;
#pragma unroll
        for (int e = 0; e < 8; ++e) {
          v[e] -= mean;
          s2 += v[e] * v[e];
        }
        s2 += __shfl_xor(s2, 1);
        s2 += __shfl_xor(s2, 2);
        s2 += __shfl_xor(s2, 4);
        s2 += __shfl_xor(s2, 8);
        const float rstd = rsqrtf(s2 * (1.f / 128.f) + 1e-6f);
#pragma unroll
        for (int e = 0; e < 8; ++e) {
          const float gv = (e & 1) ? hi_bf(zu[e >> 1]) : lo_bf(zu[e >> 1]);
          v[e] = v[e] * rstd * nw[e] * silu_f(gv);
        }
        *(uint4*)(mix + tok * 2048 + 1024 + ecol) =
            make_uint4(pack2(v[0], v[1]), pack2(v[2], v[3]), pack2(v[4], v[5]), pack2(v[6], v[7]));
      }
    }
  }
  store_state(S, 1);
  if (threadIdx.x == 0) *s_item = nextq;
}

__device__ __forceinline__ void phase3(const Params& p, char* smem, const int ctr_idx) {
  int* s_item = (int*)(smem + SC_ITEM);
  int* ctr = (int*)(p.ws + OFF_CTR) + ctr_idx;
  if (threadIdx.x == 0) *s_item = atomicAdd(ctr, 1);
  __syncthreads();
#pragma unroll 1
  for (;;) {
    const int q = *s_item;
    __syncthreads();
    if (q >= 576) break;
    int kind, stream, bb, hd, unit0;
    if (q < 128) { kind = 0; stream = 1; bb = q >> 4; hd = q & 15; unit0 = q * 8; }
    else if (q < 192) { kind = 1; stream = 1; bb = (q - 128) >> 3; hd = (q - 128) & 7; unit0 = 1024 + (q - 128) * 8; }
    else if (q < 448) { kind = 0; stream = 0; bb = (q - 192) >> 4; hd = (q - 192) & 15; unit0 = 1536 + (q - 192) * 2; }
    else { kind = 1; stream = 0; bb = (q - 448) >> 3; hd = (q - 448) & 7; unit0 = 2048 + (q - 448) * 2; }
    if (kind == 0) scan_item<128, 64, true>(p, smem, stream, bb, hd, unit0, ctr, s_item);
    else scan_item<64, 128, false>(p, smem, stream, bb, hd, unit0, ctr, s_item);
    __syncthreads();
  }
}

__device__ __forceinline__ void phase5(const Params& p) {
  const int tid = otid(), lane = tid & 63, w = tid >> 6;
  const float* mod = (const float*)(p.ws + OFF_MOD);
  const float* ob = (const float*)(p.ws + OFF_OUTB);
  const float* ssq2 = (const float*)(p.ws + OFF_SSQ2);
  for (int row = blockIdx.x * 8 + w; row < NTOK; row += gridDim.x * 8) {
    const float* xr = (row < NPR) ? p.x_prompt + (size_t)row * DM : p.x_sample + (size_t)(row - NPR) * DM;
    const int mr = (row < NPR) ? 0 : 1 + ((row - NPR) >> 10);
    float s = (lane < 16) ? ssq2[(size_t)row * 16 + lane] : 0.f;
#pragma unroll
    for (int m = 8; m >= 1; m >>= 1) s += __shfl_xor(s, m);
    s = __shfl(s, 0);
    const float rstd = rsqrtf(s * (1.f / 1024.f) + 1e-6f);
#pragma unroll
    for (int i = 0; i < 4; ++i) {
      const int k = (i * 64 + lane) * 4;
      const f32x4n xn = __builtin_nontemporal_load((const f32x4n*)(xr + k));
      const float4 xv = make_float4(xn[0], xn[1], xn[2], xn[3]);
      const float4 ov = *(const float4*)(ob + (size_t)row * DM + k);
      const float4 nw = *(const float4*)(p.norm_post_w + k);
      const float4 gt = *(const float4*)(mod + mr * 3072 + 2048 + k);
      float4 y;
      y.x = xv.x + gt.x * ov.x * rstd * nw.x;
      y.y = xv.y + gt.y * ov.y * rstd * nw.y;
      y.z = xv.z + gt.z * ov.z * rstd * nw.z;
      y.w = xv.w + gt.w * ov.w * rstd * nw.w;
      __builtin_nontemporal_store(f32x4n{y.x, y.y, y.z, y.w}, (f32x4n*)(p.out + (size_t)row * DM + k));
    }
  }
}

__global__ void __launch_bounds__(THREADS) fwd_megakernel(Params p) {
  extern __shared__ __attribute__((aligned(16))) char smem[];
  cg::grid_group grid = cg::this_grid();
  const int G = gridDim.x;
  const int bx = blockIdx.x;
  const int rb = (G % 8 == 0) ? (bx % 8) * (G / 8) + bx / 8 : bx;

  unsigned* gbar = (unsigned*)(p.ws + OFF_CTR + 1024);
  unsigned epoch = 0u;
  volatile LAS unsigned* xst = (volatile LAS unsigned*)(smem + 153984);
  if (threadIdx.x == 0) { xst[0] = 0u; xst[1] = 0u; xst[2] = 0u; xst[3] = 0u; }
  __syncthreads();
  const XcdBarrier xb = xcd_barrier_post((unsigned*)(p.ws + OFF_CTR + 8192), xst);
  if (p.ws == nullptr) grid.sync();
  phase0(p, smem);
  xcd_barrier(xb);
#if PROBE == 5
  phase0(p, smem);
  xcd_barrier(xb);
#endif
#if PROBE == 4
  for (int i = 0; i < 10; ++i) xcd_barrier(xb);
#endif
  phase1(p);
  xcd_barrier(xb);
#if PROBE == 6
  phase1(p);
  xcd_barrier(xb);
#endif
  {
    u32x4 sra[4], srb[4];
    bool have0 = false;
    for (int id = rb; id < 48 * 25; id += G) {
      const int band = id / 200, rem = id % 200;
      const int id2 = id + G;
      const bool has2 = id2 < 48 * 25;
      const int band2 = id2 / 200, rem2 = id2 % 200;
      gemm_tile<0, 4>(p, (const u16*)(p.ws + OFF_H), (const u16*)(p.ws + OFF_WTIN), 1024, band * 8 + (rem & 7), rem >> 3, smem, sra, srb,
                      have0, has2, band2 * 8 + (rem2 & 7), rem2 >> 3);
      have0 = has2;
    }
  }
  {
    const int nfull = (48 * 25) % G;
    const int nhelp = (nfull > 0) ? G - nfull : G;
    const int hb = (nfull > 0) ? rb - nfull : rb;
    if (hb >= 0)
      for (int q = hb; q < 512; q += nhelp)
        p0_transpose_item(p.w_out, 1024, (u16*)(p.ws + OFF_WTOUT), 2048, q / 16, q % 16, 1024, false, smem);
  }
  xcd_barrier(xb);
#if PROBE == 1
  for (int id = rb; id < 48 * 25; id += G) {
    const int band = id / 200, rem = id % 200;
    u32x4 sra[4], srb[4];
    gemm_tile<0, 4>(p, (const u16*)(p.ws + OFF_H), (const u16*)(p.ws + OFF_WTIN), 1024, band * 8 + (rem & 7), rem >> 3, smem, sra, srb, false, false, 0, 0);
  }
  xcd_barrier(xb);
#endif
  phase_conv(p);
  xcd_barrier(xb);
  phase3(p, smem, 0);
#if PROBE == 2
  phase3(p, smem, 1);
#endif
  xcd_barrier(xb);
#if PROBE == 3
  for (int id = rb; id < 64 * 4; id += G)
  {
    u32x4 sra[3], srb[4];
    gemm_tile<1, 3>(p, (const u16*)(p.ws + OFF_MIX), (const u16*)(p.ws + OFF_WTOUT), 2048, id >> 2, id & 3, smem, sra, srb, false, false, 0, 0);
  }
  xcd_barrier(xb);
#endif
  for (int id = rb; id < 64 * 4; id += G)
  {
    u32x4 sra[3], srb[4];
    gemm_tile<1, 3>(p, (const u16*)(p.ws + OFF_MIX), (const u16*)(p.ws + OFF_WTOUT), 2048, id >> 2, id & 3, smem, sra, srb, false, false, 0, 0);
  }
  xcd_barrier(xb);
  phase5(p);
#if PROBE == 7
  phase5(p);
#endif
}

extern "C" void kernel_launch(void* const* d_in, const int* in_sizes, int n_in, void* d_out, int out_size, void* d_ws,
                              size_t ws_size, hipStream_t stream) {
  static int grid_blocks = 0;
  if (!grid_blocks) {
    int dev = 0, cus = 0, per_cu = 0;
    hipGetDevice(&dev);
    hipDeviceGetAttribute(&cus, hipDeviceAttributeMultiprocessorCount, dev);
    hipFuncSetAttribute((const void*)fwd_megakernel, hipFuncAttributeMaxDynamicSharedMemorySize, SMEM_BYTES);
    hipOccupancyMaxActiveBlocksPerMultiprocessor(&per_cu, fwd_megakernel, THREADS, SMEM_BYTES);
    if (per_cu < 1) per_cu = 1;
    grid_blocks = cus * per_cu;
  }
  Params p{};
  const float* const* in = (const float* const*)d_in;
  p.x_prompt = in[0]; p.x_sample = in[1]; p.state_ssd = in[2]; p.state_ret = in[3]; p.c = in[4]; p.c_ctx = in[5];
  p.w_mod = in[6]; p.b_mod = in[7]; p.norm_pre_w = in[8]; p.norm_post_w = in[9]; p.w_in = in[10]; p.conv_w = in[11];
  p.conv_b = in[12]; p.A_log = in[13]; p.dt_bias = in[14]; p.ssd_D = in[15]; p.ssd_norm_w = in[16]; p.ret_decay = in[17];
  p.ret_norm_w = in[18]; p.w_out = in[19];
  p.out = (float*)d_out;
  p.ws = (char*)d_ws;
  hipMemsetAsync((char*)d_ws + OFF_CTR, 0, 8192 + 16384, stream);
  void* args[] = {&p};
  hipError_t e = hipLaunchCooperativeKernel((void*)fwd_megakernel, dim3(grid_blocks), dim3(THREADS), args, SMEM_BYTES, stream);
  if (e != hipSuccess) fprintf(stderr, "cooperative launch failed: %s (grid %d)\n", hipGetErrorString(e), grid_blocks);
}
```
